# Optimizing an MI355X kernel written in HIP

```python
import math
import jax, jax.numpy as jnp
from jax import lax
import numpy as np

D_MODEL = 1024
BATCH = 8
SEQ = 4096
DEPTH = 2

N_MIXERS = 2
POOL_WINDOWS = (2, 4, 8, 16)
POOL_GROUPS = len(POOL_WINDOWS)
POOL_GROUP_DIM = D_MODEL // POOL_GROUPS
N_HEADS = 16
N_KV_GROUPS = 4
HEADS_PER_GROUP = N_HEADS // N_KV_GROUPS
HEAD_DIM = D_MODEL // N_HEADS
Q_DIM = N_HEADS * HEAD_DIM
KV_DIM = N_KV_GROUPS * HEAD_DIM
N_BRANCHES = 3
IN_PROJ_DIM = Q_DIM + 2 * N_BRANCHES * KV_DIM + N_BRANCHES * N_HEADS
CMP_STRIDE = 16
CMP_BLOCK = 2 * CMP_STRIDE
CMP_HIDDEN = 2 * HEAD_DIM
SEL_BLOCK = 64
SEL_TOP_N = 16
WINDOW = 512
Q_BLOCK = 64
FORCE_BONUS = 1.0e3
NEG_INF = -1.0e30
ROPE_THETA = 10000.0
ATTN_SCALE = HEAD_DIM ** -0.5
D_FF = 2816
N_EXPERTS = 8
TOP_K = 2
D_FF_EXPERT = 3584
LN_EPS = 1e-5
ALPHA = (2 * DEPTH) ** 0.25
BETA = (8 * DEPTH) ** -0.25

kernel_name = "hybrid_pool_nsa_moe_deepnorm"


def layer_norm(x, g, b):
    xf = x.astype(jnp.float32)
    mu = jnp.mean(xf, axis=-1, keepdims=True)
    var = jnp.mean(jnp.square(xf - mu), axis=-1, keepdims=True)
    return ((xf - mu) * lax.rsqrt(var + LN_EPS) * g.astype(jnp.float32) + b.astype(jnp.float32)).astype(x.dtype)


def rope(x, pos):
    half = x.shape[-1] // 2
    freqs = jnp.power(ROPE_THETA, -jnp.arange(half, dtype=jnp.float32) / half)
    ang = pos.astype(jnp.float32)[:, None] * freqs[None, :]
    cos = jnp.cos(ang)[None, :, None, :]
    sin = jnp.sin(ang)[None, :, None, :]
    xf = x.astype(jnp.float32)
    x1, x2 = xf[..., :half], xf[..., half:]
    return jnp.concatenate([x1 * cos - x2 * sin, x1 * sin + x2 * cos], axis=-1).astype(x.dtype)


def pool_mixer(x, w_grp, scale):
    B, S, _ = x.shape
    xg = x.reshape(B, S, POOL_GROUPS, POOL_GROUP_DIM)
    c = jnp.concatenate([jnp.zeros((B, 1, POOL_GROUPS, POOL_GROUP_DIM), jnp.float32),
                         jnp.cumsum(xg.astype(jnp.float32), axis=1)], axis=1)
    t1 = jnp.arange(1, S + 1)
    pooled = []
    for gi, w in enumerate(POOL_WINDOWS):
        cg = c[:, :, gi]
        lo = cg[:, jnp.maximum(t1 - w, 0)]
        cnt = jnp.minimum(t1, w).astype(jnp.float32)
        pooled.append((cg[:, 1:] - lo) / cnt[None, :, None])
    pooled = jnp.stack(pooled, axis=2).astype(x.dtype)
    y = jnp.einsum('bsgc,gcd->bsgd', pooled - xg, w_grp).reshape(B, S, D_MODEL)
    return y * scale


def compress(k, pe, w1, w2):
    B, S, G, D = k.shape
    ch = k.reshape(B, S // CMP_STRIDE, CMP_STRIDE, G, D)
    blk = jnp.concatenate([ch[:, :-1], ch[:, 1:]], axis=2)
    blk = blk + pe[None, None, :, None, :]
    nc = blk.shape[1]
    blk = blk.transpose(0, 1, 3, 2, 4).reshape(B, nc, G, CMP_BLOCK * D)
    return jax.nn.silu(blk @ w1) @ w2


def nsa_mixer(x, w_in, pe_k, w1_k, w2_k, pe_v, w1_v, w2_v, w_out):
    B, S, _ = x.shape
    G, HG, D = N_KV_GROUPS, HEADS_PER_GROUP, HEAD_DIM
    proj = x @ w_in
    splits = [Q_DIM + i * KV_DIM for i in range(2 * N_BRANCHES + 1)]
    q, kc_raw, vc_raw, ks, vs, kw, vw, g_logits = jnp.split(proj, splits, axis=-1)
    pos = jnp.arange(S)
    q = rope(q.reshape(B, S, N_HEADS, D), pos)
    q = q.reshape(B, S, G, HG, D).transpose(0, 2, 3, 1, 4)
    kv = lambda a: a.reshape(B, S, G, D)
    ks = rope(kv(ks), pos)
    kw = rope(kv(kw), pos)
    vs, vw = kv(vs), kv(vw)
    kc = compress(kv(kc_raw), pe_k, w1_k, w2_k)
    vc = compress(kv(vc_raw), pe_v, w1_v, w2_v)
    nc = kc.shape[1]
    cend = CMP_STRIDE * jnp.arange(nc) + CMP_BLOCK - 1
    kc = rope(kc, cend)
    gates = jax.nn.sigmoid(g_logits.astype(jnp.float32)).astype(x.dtype).reshape(B, S, N_HEADS, N_BRANCHES)

    nsel = S // SEL_BLOCK
    n_top = min(SEL_TOP_N, nsel)
    ks_blk = ks.reshape(B, nsel, SEL_BLOCK, G, D).transpose(0, 3, 1, 2, 4)
    vs_blk = vs.reshape(B, nsel, SEL_BLOCK, G, D).transpose(0, 3, 1, 2, 4)
    kw_pad = jnp.pad(kw, ((0, 0), (WINDOW, 0), (0, 0), (0, 0)))
    vw_pad = jnp.pad(vw, ((0, 0), (WINDOW, 0), (0, 0), (0, 0)))
    cstart = CMP_STRIDE * jnp.arange(nc)
    sstart = SEL_BLOCK * jnp.arange(nsel)
    overlap = ((cstart[:, None] <= sstart[None, :] + SEL_BLOCK - 1) &
               (cstart[:, None] + CMP_BLOCK - 1 >= sstart[None, :])).astype(jnp.float32)
    bi = jnp.arange(B)[:, None, None, None]
    gi = jnp.arange(G)[None, :, None, None]
    jsel = jnp.arange(nsel)

    def query_block(i):
        t0 = i * Q_BLOCK
        t = t0 + jnp.arange(Q_BLOCK)
        qb = lax.dynamic_slice_in_dim(q, t0, Q_BLOCK, axis=3)
        sc = jnp.einsum('bghtd,bngd->bghtn', qb, kc).astype(jnp.float32) * ATTN_SCALE
        cvalid = cend[None, :] <= t[:, None]
        pc = jax.nn.softmax(jnp.where(cvalid, sc, NEG_INF), axis=-1)
        pc = pc * jnp.any(cvalid, axis=-1).astype(jnp.float32)[:, None]
        o_c = jnp.einsum('bghtn,bngd->btghd', pc.astype(vc.dtype), vc)
        imp = jnp.einsum('bghtn,nj->bgtj', pc, overlap)
        blk_t = t // SEL_BLOCK
        bvalid = jsel[None, :] <= blk_t[:, None]
        forced = (jsel[None, :] == 0) | (jsel[None, :] == blk_t[:, None]) | (jsel[None, :] == blk_t[:, None] - 1)
        score = jnp.where(bvalid, imp + FORCE_BONUS * forced.astype(jnp.float32), -1.0)
        _, idx = lax.top_k(score, n_top)
        sel_valid = idx <= blk_t[None, None, :, None]
        kg = ks_blk[bi, gi, idx]
        vg = vs_blk[bi, gi, idx]
        ss = jnp.einsum('bghtd,bgtnld->bghtnl', qb, kg).astype(jnp.float32) * ATTN_SCALE
        kpos = idx[..., None] * SEL_BLOCK + jnp.arange(SEL_BLOCK)
        ms = (kpos <= t[None, None, :, None, None]) & sel_valid[..., None]
        ss = jnp.where(ms[:, :, None], ss, NEG_INF)
        ps = jax.nn.softmax(ss.reshape(ss.shape[:4] + (n_top * SEL_BLOCK,)), axis=-1).reshape(ss.shape)
        o_s = jnp.einsum('bghtnl,bgtnld->btghd', ps.astype(vg.dtype), vg)
        kwb = lax.dynamic_slice_in_dim(kw_pad, t0, Q_BLOCK + WINDOW, axis=1)
        vwb = lax.dynamic_slice_in_dim(vw_pad, t0, Q_BLOCK + WINDOW, axis=1)
        kpos_w = t0 - WINDOW + jnp.arange(Q_BLOCK + WINDOW)
        mw = (kpos_w[None, :] <= t[:, None]) & (kpos_w[None, :] > t[:, None] - WINDOW) & (kpos_w[None, :] >= 0)
        sw = jnp.einsum('bghtd,bkgd->bghtk', qb, kwb).astype(jnp.float32) * ATTN_SCALE
        pw = jax.nn.softmax(jnp.where(mw, sw, NEG_INF), axis=-1)
        o_w = jnp.einsum('bghtk,bkgd->btghd', pw.astype(vwb.dtype), vwb)
        gb = lax.dynamic_slice_in_dim(gates, t0, Q_BLOCK, axis=1).reshape(B, Q_BLOCK, G, HG, N_BRANCHES)
        return gb[..., 0:1] * o_c + gb[..., 1:2] * o_s + gb[..., 2:3] * o_w

    out = lax.map(query_block, jnp.arange(S // Q_BLOCK))
    out = out.transpose(1, 0, 2, 3, 4, 5).reshape(B, S, Q_DIM)
    return out @ w_out


def swiglu(x, w_gu, w_down):
    g, u = jnp.split(x @ w_gu, 2, axis=-1)
    return (jax.nn.silu(g) * u) @ w_down


def moe_ffn(x, router, w_gu, w_down):
    B, S, D = x.shape
    xt = x.reshape(B * S, D)
    logits = (xt @ router).astype(jnp.float32)
    top_v, top_i = lax.top_k(logits, TOP_K)
    w = jax.nn.softmax(top_v, axis=-1)
    combine = jnp.einsum('tk,tke->te', w, jax.nn.one_hot(top_i, N_EXPERTS, dtype=jnp.float32)).astype(x.dtype)
    y = jnp.zeros_like(xt)
    for e in range(N_EXPERTS):
        y = y + combine[:, e:e + 1] * swiglu(xt, w_gu[e], w_down[e])
    return y.reshape(B, S, D)


def setup_inputs(seed: int = 0) -> dict:
    key = jax.random.key(seed)
    keys = iter(jax.random.split(key, 32))
    nrm = lambda shape, s: jax.random.normal(next(keys), shape, jnp.float32) * s
    na = (DEPTH + 1) // 2
    nb = DEPTH // 2
    return {
        "x": nrm((BATCH, SEQ, D_MODEL), 1.0),
        "ln_g": 1.0 + nrm((DEPTH, 2, D_MODEL), 0.05),
        "ln_b": nrm((DEPTH, 2, D_MODEL), 0.02),
        "pool_w": nrm((na, POOL_GROUPS, POOL_GROUP_DIM, POOL_GROUP_DIM), BETA * POOL_GROUP_DIM ** -0.5),
        "pool_scale": 1.0 + nrm((na, D_MODEL), 0.1),
        "nsa_w_in": nrm((nb, D_MODEL, IN_PROJ_DIM), D_MODEL ** -0.5),
        "nsa_pe_k": nrm((nb, CMP_BLOCK, HEAD_DIM), 0.1),
        "nsa_w1_k": nrm((nb, CMP_BLOCK * HEAD_DIM, CMP_HIDDEN), (CMP_BLOCK * HEAD_DIM) ** -0.5),
        "nsa_w2_k": nrm((nb, CMP_HIDDEN, HEAD_DIM), CMP_HIDDEN ** -0.5),
        "nsa_pe_v": nrm((nb, CMP_BLOCK, HEAD_DIM), 0.1),
        "nsa_w1_v": nrm((nb, CMP_BLOCK * HEAD_DIM, CMP_HIDDEN), (CMP_BLOCK * HEAD_DIM) ** -0.5),
        "nsa_w2_v": nrm((nb, CMP_HIDDEN, HEAD_DIM), CMP_HIDDEN ** -0.5),
        "nsa_w_out": nrm((nb, Q_DIM, D_MODEL), BETA * Q_DIM ** -0.5),
        "ffn_w_gu": nrm((na, D_MODEL, 2 * D_FF), D_MODEL ** -0.5),
        "ffn_w_down": nrm((na, D_FF, D_MODEL), BETA * D_FF ** -0.5),
        "moe_router": nrm((nb, D_MODEL, N_EXPERTS), D_MODEL ** -0.5),
        "moe_w_gu": nrm((nb, N_EXPERTS, D_MODEL, 2 * D_FF_EXPERT), D_MODEL ** -0.5),
        "moe_w_down": nrm((nb, N_EXPERTS, D_FF_EXPERT, D_MODEL), BETA * D_FF_EXPERT ** -0.5),
    }


def reference(x, ln_g, ln_b, pool_w, pool_scale, nsa_w_in, nsa_pe_k, nsa_w1_k, nsa_w2_k,
              nsa_pe_v, nsa_w1_v, nsa_w2_v, nsa_w_out, ffn_w_gu, ffn_w_down,
              moe_router, moe_w_gu, moe_w_down):
    for i in range(DEPTH):
        j = i // N_MIXERS
        if i % N_MIXERS == 0:
            h = pool_mixer(x, pool_w[j], pool_scale[j])
        else:
            h = nsa_mixer(x, nsa_w_in[j], nsa_pe_k[j], nsa_w1_k[j], nsa_w2_k[j],
                          nsa_pe_v[j], nsa_w1_v[j], nsa_w2_v[j], nsa_w_out[j])
        x = layer_norm(ALPHA * x + h, ln_g[i, 0], ln_b[i, 0])
        if i % 2 == 0:
            f = swiglu(x, ffn_w_gu[j], ffn_w_down[j])
        else:
            f = moe_ffn(x, moe_router[j], moe_w_gu[j], moe_w_down[j])
        x = layer_norm(ALPHA * x + f, ln_g[i, 1], ln_b[i, 1])
    return x
```

```cpp
#include <hip/hip_runtime.h>
#include <cstdio>
#include <cstdint>

namespace pg8 {
#define PG8_LAS __attribute__((address_space(3)))
typedef unsigned short bf16_t;
typedef short bf16x8 __attribute__((ext_vector_type(8)));
typedef float f32x4 __attribute__((ext_vector_type(4)));
typedef float f32x2 __attribute__((ext_vector_type(2)));
typedef unsigned u32x4 __attribute__((ext_vector_type(4)));
typedef unsigned u32x2 __attribute__((ext_vector_type(2)));
constexpr int BM = 256, BK = 64, HALF = 128, HTB = HALF * BK * 2  , STAGE_BYTES = 8 * HTB, NXCD = 8, WGM = 8;

__host__ __device__ __forceinline__ int lds_byte(int r, int c) { const int st = (r >> 4) * 2 + (c >> 5), rr = r & 15, cc = c & 31, ob = rr * 64 + cc * 2; return st * 1024 + (ob ^ (((ob >> 9) & 1) << 5)); }
__host__ __device__ __forceinline__ void stage_rc(int b, int& R, int& C) { const int st = b / 1024, sb = b % 1024, swz = sb ^ (((sb >> 9) & 1) << 5); R = (st >> 1) * 16 + swz / 64; C = (st & 1) * 32 + (swz % 64) / 2; }
__host__ __device__ __forceinline__ int perm32(int rho) { const int n = rho >> 4, i = rho & 15; return 8 * (i >> 2) + 4 * n + (i & 3); }

struct Unit { int pm, pn; size_t aoff, boff; };
struct Gemm { const bf16_t* A; const bf16_t* Bt; int lda, ldb, K; };

__device__ __forceinline__ void order_tile(int L, int nM, int nN, int& pm, int& pn) {
    const int nwg = nM * nN; int wgid = L;
    { const int q = nwg / NXCD, r = nwg % NXCD, xcd = wgid % NXCD, off = wgid / NXCD; wgid = (xcd < r ? xcd * (q + 1) : r * (q + 1) + (xcd - r) * q) + off; }
    const int nig = WGM * nN, gid = wgid / nig, fm = gid * WGM, gsz = (nM - fm) < WGM ? (nM - fm) : WGM;
    pm = fm + ((wgid % nig) % gsz); pn = (wgid % nig) / gsz;
}

__device__ __forceinline__ unsigned cvt_pk_bf16(float lo, float hi) { unsigned r; asm volatile("v_cvt_pk_bf16_f32 %0, %1, %2" : "=v"(r) : "v"(lo), "v"(hi)); return r; }

template <class Epi, class Sched, bool ALIGN_EPI = true, bool SP2 = true>
__device__ __forceinline__ void gemm_phase(PG8_LAS unsigned char* lds, const Gemm g, const Sched& S, const Epi& E) {
    int tid = threadIdx.x; asm volatile("" : "+v"(tid));
    const int wid = __builtin_amdgcn_readfirstlane(tid >> 6), lane = tid & 63, wr = wid >> 2, wc = wid & 3, fr = lane & 15, fq = lane >> 4;
    const int K = g.K, nt = K / BK;
    unsigned voffA[2], voffB[2];
#pragma unroll
    for (int i = 0; i < 2; ++i) { int R, C; stage_rc(tid * 16 + i * 8192, R, C); const int Rb = Epi::PERM ? ((R & ~31) + perm32(R & 31)) : R;
        voffA[i] = (unsigned)(R * g.lda + C) * 2u; voffB[i] = (unsigned)(Rb * g.ldb + C) * 2u; }
    const size_t kstep = (size_t)(BK * 2);
    const size_t hstepA = (size_t)HALF * g.lda * 2, hstepB = (size_t)HALF * g.ldb * 2;
    const unsigned ldsw = (unsigned)wid * 1024u;
    const int aoff = lds_byte(wr * 64 + fr, fq * 8), boff = lds_byte(wc * 32 + fr, fq * 8);
#define PG8_SA(b, h) (((b) * 2 + (h)) * HTB)
#define PG8_SB(b, h) ((4 + (b) * 2 + (h)) * HTB)
#define PG8_STAGE(bufoff, gbase, voff) do { _Pragma("unroll") for (int _i = 0; _i < 2; ++_i) \
        __builtin_amdgcn_global_load_lds((const unsigned*)((const char*)(gbase) + (voff)[_i]), (PG8_LAS unsigned*)(lds + (bufoff) + ldsw + _i * 8192), 16, 0, 0); } while (0)
#define PG8_LDA(dst, b, h) do { _Pragma("unroll") for (int m = 0; m < 4; ++m) _Pragma("unroll") for (int k = 0; k < 2; ++k) dst[m][k] = *(const PG8_LAS bf16x8*)(lds + PG8_SA(b, h) + aoff + m * 2048 + k * 1024); } while (0)
#define PG8_LDB(dst, b, h) do { _Pragma("unroll") for (int n = 0; n < 2; ++n) _Pragma("unroll") for (int k = 0; k < 2; ++k) dst[n][k] = *(const PG8_LAS bf16x8*)(lds + PG8_SB(b, h) + boff + n * 2048 + k * 1024); } while (0)
#define PG8_MMA(ai, bj, At, Bt) do { __builtin_amdgcn_s_setprio(1); _Pragma("unroll") for (int m = 0; m < 4; ++m) _Pragma("unroll") for (int n = 0; n < 2; ++n) _Pragma("unroll") for (int k = 0; k < 2; ++k) \
        acc[ai][bj][m][n] = __builtin_amdgcn_mfma_f32_16x16x32_bf16(Bt[n][k], At[m][k], acc[ai][bj][m][n], 0, 0, 0); __builtin_amdgcn_s_setprio(0); } while (0)
#define PG8_WAIT_V(n) asm volatile("s_waitcnt vmcnt(" #n ")" ::: "memory")
#define PG8_WAIT_L(n) asm volatile("s_waitcnt lgkmcnt(" #n ")" ::: "memory")
#define PG8_BAR __builtin_amdgcn_s_barrier()
#define PG8_SCHED __builtin_amdgcn_sched_barrier(0)
    Unit cur, nxt; int ui = 0;
    if (!S.next(0, cur)) return;
    f32x4 acc[2][2][4][2];
#pragma unroll
    for (int a = 0; a < 2; ++a)
#pragma unroll
        for (int b = 0; b < 2; ++b)
#pragma unroll
            for (int m = 0; m < 4; ++m)
#pragma unroll
                for (int n = 0; n < 2; ++n) acc[a][b][m][n] = (f32x4){0.f, 0.f, 0.f, 0.f};
    bf16x8 At[4][2], B0[2][2], B1[2][2];
    const char* cA = (const char*)g.A + cur.aoff; const char* cB = (const char*)g.Bt + cur.boff;
    if constexpr (SP2) {
        PG8_STAGE(PG8_SB(0, 0), cB, voffB); PG8_STAGE(PG8_SB(0, 1), cB + hstepB, voffB); PG8_STAGE(PG8_SA(0, 0), cA, voffA); PG8_STAGE(PG8_SA(0, 1), cA + hstepA, voffA);
        if (wr == 1) PG8_BAR;
        PG8_WAIT_V(2); PG8_BAR;
        PG8_STAGE(PG8_SB(1, 0), cB + kstep, voffB); PG8_STAGE(PG8_SA(1, 0), cA + kstep, voffA); PG8_STAGE(PG8_SB(1, 1), cB + hstepB + kstep, voffB);
        PG8_WAIT_V(6); PG8_BAR;
    } else {
        PG8_STAGE(PG8_SB(0, 0), cB, voffB); PG8_STAGE(PG8_SA(0, 0), cA, voffA); PG8_STAGE(PG8_SB(0, 1), cB + hstepB, voffB); PG8_STAGE(PG8_SA(0, 1), cA + hstepA, voffA);
        if (wr == 1) PG8_BAR;
        PG8_WAIT_V(4); PG8_BAR;
        PG8_STAGE(PG8_SB(1, 0), cB + kstep, voffB); PG8_STAGE(PG8_SA(1, 0), cA + kstep, voffA); PG8_STAGE(PG8_SB(1, 1), cB + hstepB + kstep, voffB);
        PG8_WAIT_V(6); PG8_BAR;
    }
    for (;;) {
        const bool has_next = S.next(ui + 1, nxt);
        const char* nA = has_next ? (const char*)g.A + nxt.aoff : cA; const char* nB = has_next ? (const char*)g.Bt + nxt.boff : cB;
        for (int t = 0; t < nt; t += 2) {
            const bool last = (t == nt - 2);
            const char* a1 = cA + (size_t)(t + 1) * kstep;
            const char* a2 = last ? nA : cA + (size_t)(t + 2) * kstep; const char* b2 = last ? nB : cB + (size_t)(t + 2) * kstep;
            const char* a3 = a2 + kstep; const char* b3 = b2 + kstep;
            if constexpr (SP2) {
            PG8_LDB(B0, 0, 0); PG8_LDB(B1, 0, 1); PG8_SCHED; PG8_LDA(At, 0, 0); PG8_STAGE(PG8_SA(1, 1), a1 + hstepA, voffA);
            PG8_WAIT_V(8); PG8_WAIT_L(0); PG8_BAR; PG8_MMA(0, 0, At, B0); PG8_MMA(0, 1, At, B1); PG8_BAR; PG8_SCHED;
            PG8_LDA(At, 0, 1); PG8_STAGE(PG8_SB(0, 0), b2, voffB); PG8_STAGE(PG8_SB(0, 1), b2 + hstepB, voffB); PG8_STAGE(PG8_SA(0, 0), a2, voffA);
            PG8_WAIT_V(8); PG8_WAIT_L(0); PG8_BAR; PG8_MMA(1, 0, At, B0); PG8_MMA(1, 1, At, B1); PG8_BAR; PG8_SCHED;
            PG8_LDB(B0, 1, 0); PG8_LDB(B1, 1, 1); PG8_SCHED; PG8_LDA(At, 1, 0); PG8_STAGE(PG8_SA(0, 1), a2 + hstepA, voffA);
            PG8_WAIT_V(8); PG8_WAIT_L(0); PG8_BAR; PG8_MMA(0, 0, At, B0); PG8_MMA(0, 1, At, B1); PG8_BAR; PG8_SCHED;
            PG8_LDA(At, 1, 1); PG8_STAGE(PG8_SB(1, 0), b3, voffB); PG8_STAGE(PG8_SB(1, 1), b3 + hstepB, voffB); PG8_STAGE(PG8_SA(1, 0), a3, voffA);
            PG8_WAIT_V(8); PG8_WAIT_L(0); PG8_BAR; PG8_MMA(1, 0, At, B0); PG8_MMA(1, 1, At, B1); PG8_BAR; PG8_SCHED;
            } else {
            PG8_LDB(B0, 0, 0); PG8_SCHED; PG8_LDA(At, 0, 0); PG8_STAGE(PG8_SA(1, 1), a1 + hstepA, voffA);
            PG8_WAIT_L(8); PG8_BAR; PG8_WAIT_L(0); PG8_MMA(0, 0, At, B0); PG8_BAR; PG8_SCHED;
            PG8_LDB(B1, 0, 1); PG8_STAGE(PG8_SB(0, 0), b2, voffB);
            PG8_BAR; PG8_WAIT_L(0); PG8_MMA(0, 1, At, B1); PG8_BAR;
            PG8_LDA(At, 0, 1); PG8_STAGE(PG8_SA(0, 0), a2, voffA);
            PG8_BAR; PG8_WAIT_L(0); PG8_MMA(1, 0, At, B0); PG8_BAR; PG8_SCHED;
            PG8_STAGE(PG8_SB(0, 1), b2 + hstepB, voffB);
            PG8_WAIT_V(6); PG8_BAR; PG8_MMA(1, 1, At, B1); PG8_BAR;
            PG8_LDB(B0, 1, 0); PG8_SCHED; PG8_LDA(At, 1, 0); PG8_STAGE(PG8_SA(0, 1), a2 + hstepA, voffA);
            PG8_WAIT_L(8); PG8_BAR; PG8_WAIT_L(0); PG8_MMA(0, 0, At, B0); PG8_BAR; PG8_SCHED;
            PG8_LDB(B1, 1, 1); PG8_STAGE(PG8_SB(1, 0), b3, voffB);
            PG8_BAR; PG8_WAIT_L(0); PG8_MMA(0, 1, At, B1); PG8_BAR;
            PG8_LDA(At, 1, 1); PG8_STAGE(PG8_SA(1, 0), a3, voffA);
            PG8_BAR; PG8_WAIT_L(0); PG8_MMA(1, 0, At, B0); PG8_BAR; PG8_SCHED;
            PG8_STAGE(PG8_SB(1, 1), b3 + hstepB, voffB);
            PG8_WAIT_V(6); PG8_BAR; PG8_MMA(1, 1, At, B1); PG8_BAR;
            }
        }
        if constexpr (ALIGN_EPI) { if (wr == 0) PG8_BAR; }
        E(acc, cur, wr, wc, fr, fq);
        if (!has_next) break;
#pragma unroll
        for (int a = 0; a < 2; ++a)
#pragma unroll
            for (int b = 0; b < 2; ++b)
#pragma unroll
                for (int m = 0; m < 4; ++m)
#pragma unroll
                    for (int n = 0; n < 2; ++n) acc[a][b][m][n] = (f32x4){0.f, 0.f, 0.f, 0.f};
        cur = nxt; cA = nA; cB = nB; ++ui;
        if constexpr (ALIGN_EPI) { if (wr == 1) PG8_BAR; }
    }
    PG8_WAIT_V(0);
    if constexpr (!ALIGN_EPI) { if (wr == 0) PG8_BAR; }
    PG8_BAR;
#undef PG8_SA
#undef PG8_SB
#undef PG8_STAGE
#undef PG8_LDA
#undef PG8_LDB
#undef PG8_MMA
#undef PG8_WAIT_V
#undef PG8_WAIT_L
#undef PG8_BAR
#undef PG8_SCHED
}
}

constexpr int NWAVES = 8;
constexpr int BATCH = 8, SEQ = 4096, D = 1024, T = BATCH * SEQ;
constexpr int DFF = 2816, NE = 8, DFE = 3584, INP = 2608, INP_PAD = 2816;
constexpr int NH = 16, NG = 4, HD = 64;
constexpr float LN_EPS = 1e-5f;
constexpr float ALPHA = 1.4142135623730951f;
constexpr float QSCALE = 0.125f * 1.4426950408889634f;
constexpr int MOE_CH = 64;
constexpr int MOE_MAXT = 264;
constexpr int MOE_NCH = 5;

constexpr size_t MiB = 1u << 20;
constexpr size_t WS_CTL = 0, CTL_ZERO_BYTES = 1 * MiB;
constexpr size_t WS_ROPE = 1 * MiB;
constexpr size_t WS_MISC = 2 * MiB;
constexpr size_t WS_SEL = 3 * MiB;
constexpr size_t WS_SDST = 4 * MiB;
constexpr size_t WS_SW = 5 * MiB;
constexpr size_t WS_KVC = 6 * MiB;
constexpr size_t WS_CPART = 8 * MiB;
constexpr size_t WS_GATES = 40 * MiB;
constexpr size_t W_POOL = 48 * MiB, W_FGU = 49 * MiB, W_FDN = 60 * MiB, W_IN = 66 * MiB, W_C1 = 72 * MiB, W_OUT = 74 * MiB, W_MGU = 76 * MiB, W_MDN = 188 * MiB;
constexpr size_t WS_R0 = 256 * MiB;
constexpr size_t WS_XB = 384 * MiB;
constexpr size_t WS_BIG = 448 * MiB;
constexpr size_t WS_APOOL = WS_BIG, WS_H1 = 512 * MiB;
constexpr size_t WS_Q = WS_BIG, WS_KV6 = 512 * MiB, WS_AO = 616 * MiB;
constexpr size_t WS_XS = WS_BIG, WS_H2 = 580 * MiB, WS_Y = 692 * MiB;
constexpr size_t WS_END = 820 * MiB;
constexpr size_t KV6_STRIDE = (size_t)T * 256;
static_assert(W_MGU + (size_t)NE * 2 * DFE * D * 2 <= W_MDN && W_MDN + (size_t)NE * D * DFE * 2 <= WS_R0, "weights map");
static_assert(WS_H1 + (size_t)T * DFF * 2 <= WS_END && WS_XS + (size_t)MOE_MAXT * 256 * D * 2 <= WS_H2 && WS_H2 + (size_t)MOE_CH * 256 * DFE * 2 <= WS_Y && WS_Y + (size_t)T * 2 * D * 2 <= WS_END, "big map");
constexpr int CW_TMO = 0, CW_BAR = 4096;
constexpr int N_BAR_REGIONS = 28;

constexpr int RING_OFF = 0, RING_BYTES = 131072;
constexpr int LDSCTL_OFF = RING_BYTES, MISC_OFF = LDSCTL_OFF + 320;
constexpr int PTR_OFF = RING_BYTES + 512;
constexpr int MOET_OFF = RING_BYTES + 1024;
constexpr int LDS_BYTES = 147456;

#define GAS __attribute__((address_space(1)))
#define LAS __attribute__((address_space(3)))
typedef unsigned short bf16;
typedef unsigned v4u __attribute__((ext_vector_type(4)));
typedef unsigned v2u __attribute__((ext_vector_type(2)));
typedef float f32x4 __attribute__((ext_vector_type(4)));
typedef float f32x2 __attribute__((ext_vector_type(2)));
typedef short bf16x8 __attribute__((ext_vector_type(8)));
typedef GAS unsigned gu32;
#define RLX_AGENT __ATOMIC_RELAXED, __HIP_MEMORY_SCOPE_AGENT
#define LDS_WAIT() asm volatile("s_waitcnt lgkmcnt(0)" ::: "memory")
#define VM_WAIT() asm volatile("s_waitcnt vmcnt(0)" ::: "memory")
__device__ __forceinline__ unsigned f2bf(float f) { unsigned u = __builtin_bit_cast(unsigned, f); return (u + 0x7fffu + ((u >> 16) & 1u)) >> 16; }
__device__ __forceinline__ unsigned pk2(float lo, float hi) { return f2bf(lo) | (f2bf(hi) << 16); }
__device__ __forceinline__ float bf2f(unsigned h) { return __builtin_bit_cast(float, h << 16); }

#define XB_TMO      128
#define XB_XCNT(j)  (256  + 64 * (j))
#define XB_XSUB(j)  (1280 + 64 * (j))
#define XB_XGEN(j)  (2304 + 64 * (j))
#define XB_TOP      3328
#define XB_TOPGEN   3392
#define XCD_BAR_WORDS 3456
#define XB_SPIN_CAP (1u << 18)
__device__ __forceinline__ unsigned xb_ld(unsigned* p)              { return __hip_atomic_load(p, __ATOMIC_RELAXED, __HIP_MEMORY_SCOPE_AGENT); }
__device__ __forceinline__ unsigned xb_add(unsigned* p, unsigned v) { return __hip_atomic_fetch_add(p, v, __ATOMIC_RELAXED, __HIP_MEMORY_SCOPE_AGENT); }
__device__ __forceinline__ unsigned xb_xcc_id() { return (unsigned)__builtin_amdgcn_s_getreg((3 << 11) | 20) & 0xFu; }
#define XB_SPIN(cond, bar) do { unsigned _sp = 0; while (cond) { __builtin_amdgcn_s_sleep(1); \
    if ((++_sp & 255u) == 0u) { if (xb_ld(&(bar)[XB_TMO])) break; if (_sp > XB_SPIN_CAP) { atomicAdd(&(bar)[XB_TMO], 1u); break; } } } } while (0)
struct XcdBarrier { unsigned* bar; unsigned x; volatile LAS unsigned* st; };
__device__ __forceinline__ XcdBarrier xcd_barrier_post(unsigned* bar, volatile LAS unsigned* st) {
    XcdBarrier b; b.bar = bar; b.x = xb_xcc_id(); b.st = st;
    if (threadIdx.x == 0) (void)xb_add(&bar[XB_XCNT(b.x)], 1u);
    return b;
}
__device__ __forceinline__ void xcd_barrier_complete(unsigned* bar, unsigned x, unsigned& nloc, unsigned& nx) {
    const unsigned G = gridDim.x * gridDim.y * gridDim.z;
    unsigned sum, cnt, mine, sp = 0u;
    for (;;) {
        sum = 0u; cnt = 0u; mine = 0u;
#pragma unroll
        for (unsigned j = 0; j < 16; ++j) { const unsigned c = xb_ld(&bar[XB_XCNT(j)]); sum += c; cnt += (c > 0u) ? 1u : 0u; mine = (j == x) ? c : mine; }
        if (sum == G) break;
        __builtin_amdgcn_s_sleep(1);
        if ((++sp & 255u) == 0u) { if (xb_ld(&bar[XB_TMO])) break; if (sp > XB_SPIN_CAP) { atomicAdd(&bar[XB_TMO], 1u); break; } }
    }
    nloc = mine > 0u ? mine : 1u; nx = cnt > 0u ? cnt : 1u;
}
__device__ __forceinline__ void xcd_barrier(const XcdBarrier& b) {
    asm volatile("s_waitcnt vmcnt(0)" ::: "memory");
    __syncthreads();
    if (threadIdx.x == 0) {
        unsigned* bar = b.bar;
        __builtin_amdgcn_s_waitcnt(0);
        unsigned nloc = b.st[0], nx = b.st[1];
        if (nloc == 0u) { xcd_barrier_complete(bar, b.x, nloc, nx); b.st[0] = nloc; b.st[1] = nx; }
        const unsigned old = xb_add(&bar[XB_XSUB(b.x)], 1u);
        const unsigned gen = old / nloc;
        if (old + 1u == (gen + 1u) * nloc) {
            __builtin_amdgcn_fence(__ATOMIC_RELEASE, "agent");
            asm volatile("s_waitcnt vmcnt(0)" ::: "memory");
            const unsigned og = xb_add(&bar[XB_TOP], 1u);
            const unsigned tg = og / nx;
            if (og + 1u == (tg + 1u) * nx) xb_add(&bar[XB_TOPGEN], 1u);
            else XB_SPIN(xb_ld(&bar[XB_TOPGEN]) == tg, bar);
            __builtin_amdgcn_fence(__ATOMIC_ACQUIRE, "agent");
            xb_add(&bar[XB_XGEN(b.x)], 1u);
            asm volatile("s_waitcnt vmcnt(0)" ::: "memory");
        } else {
            XB_SPIN(xb_ld(&bar[XB_XGEN(b.x)]) == gen, bar);
            __builtin_amdgcn_fence(__ATOMIC_ACQUIRE, "agent");
            asm volatile("s_waitcnt vmcnt(0)" ::: "memory");
        }
    }
    __syncthreads();
}

struct Frame {
    LAS unsigned char* lds;
    volatile LAS unsigned* MISC;
    gu32* ctl;
    unsigned char* ws;
    int tid, lane, wave;
    int vcu, G;
    float* out;
    __device__ __forceinline__ const float* inp(int i) const {
        const unsigned long long v = ((const LAS unsigned long long*)(lds + PTR_OFF))[i];
        const unsigned lo = __builtin_amdgcn_readfirstlane((unsigned)v), hi = __builtin_amdgcn_readfirstlane((unsigned)(v >> 32));
        return (const float*)(((unsigned long long)hi << 32) | lo); }
};
enum { I_X = 0, I_LNG, I_LNB, I_POOLW, I_POOLS, I_WIN, I_PEK, I_W1K, I_W2K, I_PEV, I_W1V, I_W2V, I_WOUT, I_FGU, I_FDN, I_ROUTER, I_MGU, I_MDN };

__device__ __forceinline__ void refresh(Frame& F) { int t = threadIdx.x; asm volatile("" : "+v"(t)); F.tid = t; F.lane = t & 63; F.wave = __builtin_amdgcn_readfirstlane(t >> 6); }
__device__ __forceinline__ float wave_sum(float v) {
#pragma unroll
    for (int o = 1; o < 64; o <<= 1) v += __shfl_xor(v, o);
    return v;
}
__device__ __forceinline__ float silu_f(float x) { return x * __builtin_amdgcn_rcpf(1.0f + __builtin_amdgcn_exp2f(-1.4426950408889634f * x)); }

template <int MODE> __device__ __forceinline__ int wrow_map(int n, int Npad) {
    if (MODE == 0) return n;
    if (MODE == 1) { const int half = Npad >> 1; return n < half ? ((n >> 7) << 8) + (n & 127) : (((n - half) >> 7) << 8) + 128 + ((n - half) & 127); }
    const int tile = n >> 8, o = n & 255, head = o >> 6, hf = (o >> 5) & 1, i = o & 31;
    return (tile << 8) + 128 * (head >> 1) + 32 * (2 * (head & 1) + (i >> 4)) + 16 * hf + (i & 15);
}
template <int MODE> __device__ __forceinline__ void p0_transpose_item(const float* W, int K, int Nreal, int Npad, bf16* WT, LAS float* scr, int item, int lane) {
    const int nblk = Npad / 32, kb = item / nblk, nb = item % nblk, k0 = 64 * kb, n0 = 32 * nb;
    const int nn = n0 + (lane & 31); const bool ok = nn < Nreal;
#pragma unroll 8
    for (int i = 0; i < 32; ++i) { const int kk = 2 * i + (lane >> 5); scr[kk * 33 + (lane & 31)] = ok ? W[(size_t)(k0 + kk) * Nreal + nn] : 0.f; }
    LDS_WAIT(); asm volatile("" ::: "memory");
    const int c = lane & 7;
#pragma unroll
    for (int j = 0; j < 4; ++j) { const int n = (lane >> 3) + 8 * j; const LAS float* s = scr + (8 * c) * 33 + n;
        v4u o; o.x = pk2(s[0 * 33], s[1 * 33]); o.y = pk2(s[2 * 33], s[3 * 33]); o.z = pk2(s[4 * 33], s[5 * 33]); o.w = pk2(s[6 * 33], s[7 * 33]);
        *(GAS v4u*)(WT + (size_t)wrow_map<MODE>(n0 + n, Npad) * K + k0 + 8 * c) = o; }
    LDS_WAIT(); asm volatile("" ::: "memory");
}

__device__ __forceinline__ void p0_pool_operand(Frame& F) {
    const float* x = F.inp(I_X); bf16* AP = (bf16*)(F.ws + WS_APOOL);
    LAS f32x4* tile = (LAS f32x4*)(F.lds + RING_OFF);
    for (int unit = F.vcu; unit < (T / 64) * 4; unit += F.G) {
        const int rb = unit >> 2, g = unit & 3, w = 2 << g, t0 = rb * 64, s0 = t0 & (SEQ - 1);
        const int halo = (w - 1) < s0 ? (w - 1) : s0;
        __syncthreads();
        for (int idx = F.tid; idx < (64 + halo) * 64; idx += NWAVES * 64) { const int row = idx >> 6, c4 = idx & 63;
            tile[row * 64 + c4] = *(const GAS f32x4*)(x + (size_t)(t0 - halo + row) * D + g * 256 + c4 * 4); }
        __syncthreads();
#pragma unroll 2
        for (int k = 0; k < 8; ++k) { const int o = F.tid + k * 512, r = o >> 6, c4 = o & 63, s = s0 + r;
            const int cnt = (s + 1) < w ? (s + 1) : w;
            f32x4 sum = (f32x4){0.f, 0.f, 0.f, 0.f};
            for (int j = 0; j < cnt; ++j) sum += tile[(halo + r - j) * 64 + c4];
            const f32x4 cur = tile[(halo + r) * 64 + c4]; const float fc = (float)cnt;
            const f32x4 v = (f32x4){sum.x / fc, sum.y / fc, sum.z / fc, sum.w / fc} - cur;
            v2u pk; pk.x = pk2(v.x, v.y); pk.y = pk2(v.z, v.w);
            *(GAS v2u*)(AP + (size_t)(t0 + r) * D + g * 256 + c4 * 4) = pk; }
    }
    __syncthreads();
}

__device__ __forceinline__ void p0_prologue(Frame& F) {
    const int gw = F.vcu * NWAVES + F.wave, NGW = F.G * NWAVES;
    { float* rc = (float*)(F.ws + WS_ROPE); float* rs = rc + SEQ * 32;
      for (int idx = F.vcu * 512 + F.tid; idx < SEQ * 32; idx += F.G * 512) { const int pos = idx >> 5, i = idx & 31;
          const float fr = powf(10000.0f, -(float)i / 32.0f);
          const double ang = (double)((float)pos * fr);
          const double k = __builtin_rint(ang * 0.15915494309189535); const double r = ang - k * 6.283185307179586476925287, r2 = r * r;
          double sn = 1.0, cs = 1.0;
#pragma unroll
          for (int q = 12; q >= 1; --q) { sn = 1.0 - r2 / (double)((2 * q) * (2 * q + 1)) * sn; cs = 1.0 - r2 / (double)((2 * q - 1) * (2 * q)) * cs; }
          rc[idx] = (float)cs; rs[idx] = (float)(r * sn); } }
    if (F.vcu < 2) { const float* pe = F.inp(F.vcu == 0 ? I_PEK : I_PEV); const float* w1 = F.inp(F.vcu == 0 ? I_W1K : I_W1V);
        LAS float* red = (LAS float*)(F.lds + RING_OFF + 98304);
        const int c = F.tid & 127, ks = F.tid >> 7; float s = 0.f;
        for (int r = ks * 512; r < ks * 512 + 512; ++r) s += pe[r] * w1[(size_t)r * 128 + c];
        red[ks * 128 + c] = s; __syncthreads();
        if (F.tid < 128) ((float*)(F.ws + WS_MISC))[F.vcu * 128 + F.tid] = (red[F.tid] + red[128 + F.tid]) + (red[256 + F.tid] + red[384 + F.tid]);
        __syncthreads(); }
    p0_pool_operand(F);
    LAS float* scr = (LAS float*)(F.lds + RING_OFF + F.wave * 16384);
    unsigned char* ws = F.ws;
    constexpr int I_P = 4 * 8, I_FG = (D / 64) * (2 * DFF / 32), I_FD = (DFF / 64) * (D / 32), I_IN = (D / 64) * (INP_PAD / 32), I_C1 = (2048 / 64) * (256 / 32), I_WO = (D / 64) * (D / 32);
    constexpr int I_MG = (D / 64) * (2 * DFE / 32), I_MD = (DFE / 64) * (D / 32);
    constexpr int NITEMS = 4 * I_P + I_FG + I_FD + I_IN + 2 * I_C1 + I_WO + NE * I_MG + NE * I_MD;
    for (int it = gw; it < NITEMS; it += NGW) {
        int r = it;
        if (r < 4 * I_P) { const int g = r / I_P; p0_transpose_item<0>(F.inp(I_POOLW) + (size_t)g * 65536, 256, 256, 256, (bf16*)(ws + W_POOL) + (size_t)g * 65536, scr, r % I_P, F.lane); continue; } r -= 4 * I_P;
        if (r < I_FG) { p0_transpose_item<1>(F.inp(I_FGU), D, 2 * DFF, 2 * DFF, (bf16*)(ws + W_FGU), scr, r, F.lane); continue; } r -= I_FG;
        if (r < I_FD) { p0_transpose_item<0>(F.inp(I_FDN), DFF, D, D, (bf16*)(ws + W_FDN), scr, r, F.lane); continue; } r -= I_FD;
        if (r < I_IN) { p0_transpose_item<2>(F.inp(I_WIN), D, INP, INP_PAD, (bf16*)(ws + W_IN), scr, r, F.lane); continue; } r -= I_IN;
        if (r < 2 * I_C1) { const int kv = r / I_C1; p0_transpose_item<0>(F.inp(kv ? I_W1V : I_W1K), 2048, 128, 256, (bf16*)(ws + W_C1) + (size_t)kv * 256 * 2048, scr, r % I_C1, F.lane); continue; } r -= 2 * I_C1;
        if (r < I_WO) { p0_transpose_item<0>(F.inp(I_WOUT), D, D, D, (bf16*)(ws + W_OUT), scr, r, F.lane); continue; } r -= I_WO;
        if (r < NE * I_MG) { const int e = r / I_MG; p0_transpose_item<1>(F.inp(I_MGU) + (size_t)e * D * 2 * DFE, D, 2 * DFE, 2 * DFE, (bf16*)(ws + W_MGU) + (size_t)e * 2 * DFE * D, scr, r % I_MG, F.lane); continue; } r -= NE * I_MG;
        { const int e = r / I_MD; p0_transpose_item<0>(F.inp(I_MDN) + (size_t)e * DFE * D, DFE, D, D, (bf16*)(ws + W_MDN) + (size_t)e * D * DFE, scr, r % I_MD, F.lane); }
    }
}

__device__ __forceinline__ void ln_phase(Frame& F, const float* src, const float* gam, const float* bet, float* dstf, bf16* dstb) {
    const int gw = F.vcu * NWAVES + F.wave, NGW = F.G * NWAVES;
    f32x4 gv[4], bv[4];
#pragma unroll
    for (int j = 0; j < 4; ++j) { gv[j] = *((const GAS f32x4*)gam + F.lane + 64 * j); bv[j] = *((const GAS f32x4*)bet + F.lane + 64 * j); }
    for (int m = gw; m < T; m += NGW) {
        const GAS f32x4* xr = (const GAS f32x4*)(src + (size_t)m * D) + F.lane;
        f32x4 v[4]; float s = 0.f;
#pragma unroll
        for (int j = 0; j < 4; ++j) { v[j] = xr[64 * j]; s += (v[j].x + v[j].y) + (v[j].z + v[j].w); }
        const float mean = wave_sum(s) * (1.f / D); float s2 = 0.f;
#pragma unroll
        for (int j = 0; j < 4; ++j) { v[j] = v[j] - mean; s2 += (v[j].x * v[j].x + v[j].y * v[j].y) + (v[j].z * v[j].z + v[j].w * v[j].w); }
        const float rstd = 1.f / sqrtf(wave_sum(s2) * (1.f / D) + LN_EPS);
        GAS f32x4* of = (GAS f32x4*)(dstf + (size_t)m * D) + F.lane;
#pragma unroll
        for (int j = 0; j < 4; ++j) { v[j] = v[j] * rstd * gv[j] + bv[j]; of[64 * j] = v[j]; }
        if (dstb) { GAS v2u* ob = (GAS v2u*)(dstb + (size_t)m * D) + F.lane;
#pragma unroll
            for (int j = 0; j < 4; ++j) { v2u pk; pk.x = pk2(v[j].x, v[j].y); pk.y = pk2(v[j].z, v[j].w); ob[64 * j] = pk; } }
    }
}

__device__ __forceinline__ void ln_router_phase(Frame& F, float* R0, const float* gam, const float* bet, bf16* dstb) {
    LAS float* rt = (LAS float*)(F.lds + RING_OFF);
    LAS unsigned* cnt = (LAS unsigned*)(F.lds + RING_OFF + 32768);
    const float* router = F.inp(I_ROUTER);
    for (int idx = F.tid; idx < 8192; idx += 512) { const int c = idx >> 3, e = idx & 7; rt[e * 1024 + c] = router[idx]; }
    if (F.tid < 8) cnt[F.tid] = 0u;
    __syncthreads();
    f32x4 gv[4], bv[4];
#pragma unroll
    for (int j = 0; j < 4; ++j) { gv[j] = *((const GAS f32x4*)gam + F.lane + 64 * j); bv[j] = *((const GAS f32x4*)bet + F.lane + 64 * j); }
    int* sel = (int*)(F.ws + WS_SEL);
    for (int k = 0; k < 16; ++k) {
        const int m = F.vcu * 128 + F.wave * 16 + k;
        const GAS f32x4* xr = (const GAS f32x4*)(R0 + (size_t)m * D) + F.lane;
        f32x4 v[4]; float s = 0.f;
#pragma unroll
        for (int j = 0; j < 4; ++j) { v[j] = xr[64 * j]; s += (v[j].x + v[j].y) + (v[j].z + v[j].w); }
        const float mean = wave_sum(s) * (1.f / D); float s2 = 0.f;
#pragma unroll
        for (int j = 0; j < 4; ++j) { v[j] = v[j] - mean; s2 += (v[j].x * v[j].x + v[j].y * v[j].y) + (v[j].z * v[j].z + v[j].w * v[j].w); }
        const float rstd = 1.f / sqrtf(wave_sum(s2) * (1.f / D) + LN_EPS);
        GAS f32x4* of = (GAS f32x4*)(R0 + (size_t)m * D) + F.lane;
        GAS v2u* ob = (GAS v2u*)(dstb + (size_t)m * D) + F.lane;
#pragma unroll
        for (int j = 0; j < 4; ++j) { v[j] = v[j] * rstd * gv[j] + bv[j]; of[64 * j] = v[j]; v2u pk; pk.x = pk2(v[j].x, v[j].y); pk.y = pk2(v[j].z, v[j].w); ob[64 * j] = pk; }
        float lg[8];
#pragma unroll
        for (int e = 0; e < 8; ++e) { float a = 0.f;
#pragma unroll
            for (int j = 0; j < 4; ++j) { const f32x4 r4 = *((const LAS f32x4*)(rt + e * 1024) + F.lane + 64 * j); a += (v[j].x * r4.x + v[j].y * r4.y) + (v[j].z * r4.z + v[j].w * r4.w); }
            lg[e] = wave_sum(a); }
        int i0 = 0; float v0 = lg[0];
#pragma unroll
        for (int e = 1; e < 8; ++e) if (lg[e] > v0) { v0 = lg[e]; i0 = e; }
        int i1 = -1; float v1 = -3.0e38f;
#pragma unroll
        for (int e = 0; e < 8; ++e) if (e != i0 && lg[e] > v1) { v1 = lg[e]; i1 = e; }
        const float ex = __expf(v1 - v0), w0 = 1.0f / (1.0f + ex), w1 = ex * w0;
        if (F.lane == 0) { *(GAS v4u*)(sel + (size_t)m * 4) = (v4u){(unsigned)i0, (unsigned)i1, __builtin_bit_cast(unsigned, w0), __builtin_bit_cast(unsigned, w1)};
            __hip_atomic_fetch_add(cnt + i0, 1u, __ATOMIC_RELAXED, __HIP_MEMORY_SCOPE_WORKGROUP); __hip_atomic_fetch_add(cnt + i1, 1u, __ATOMIC_RELAXED, __HIP_MEMORY_SCOPE_WORKGROUP); }
    }
    __syncthreads();
    if (F.tid < 8) ((unsigned*)(F.ws + WS_MISC + 4096))[F.vcu * 8 + F.tid] = cnt[F.tid];
}

__device__ __forceinline__ void moe_tables(Frame& F) {
    LAS int* cw = (LAS int*)(F.lds + RING_OFF + 65536);
    LAS int* mt = (LAS int*)(F.lds + MOET_OFF);
    const int* cg = (const int*)(F.ws + WS_MISC + 4096);
    __syncthreads();
    for (int idx = F.tid; idx < 2048; idx += 512) cw[idx] = __hip_atomic_load(cg + idx, RLX_AGENT);
    __syncthreads();
    { const int e = F.wave; int a[4]; int s = 0;
#pragma unroll
      for (int k = 0; k < 4; ++k) { a[k] = cw[(4 * F.lane + k) * 8 + e]; s += a[k]; }
      int inc = s;
#pragma unroll
      for (int o = 1; o < 64; o <<= 1) { const int y = __shfl_up(inc, o); if (F.lane >= o) inc += y; }
      if (F.lane == 63) mt[e] = inc;
      if (F.lane == (F.vcu >> 2)) { const int q = F.vcu & 3; mt[16 + e] = inc - s + (q > 0 ? a[0] : 0) + (q > 1 ? a[1] : 0) + (q > 2 ? a[2] : 0); } }
    __syncthreads();
    if (F.tid == 0) { int row = 0, tile = 0;
        for (int e = 0; e < 8; ++e) { mt[8 + e] = row; const int nt = (mt[e] + 255) >> 8; for (int i = 0; i < nt; ++i) mt[32 + tile + i] = e; tile += nt; row += nt << 8; }
        mt[24] = tile; }
    __syncthreads();
}

__device__ __forceinline__ void moe_dispatch_phase(Frame& F) {
    moe_tables(F);
    LAS int* mt = (LAS int*)(F.lds + MOET_OFF);
    LAS int* wcnt = (LAS int*)(F.lds + RING_OFF);
    LAS int* plist = (LAS int*)(F.lds + RING_OFF + 1024);
    const int* sel = (const int*)(F.ws + WS_SEL);
    int* sdst = (int*)(F.ws + WS_SDST); float* sw = (float*)(F.ws + WS_SW);
    const bf16* XB = (const bf16*)(F.ws + WS_XB); bf16* XS = (bf16*)(F.ws + WS_XS);
    int e = -1, rank = 0, t = 0, kk = 0; float wgt = 0.f;
    if (F.tid < 256) { const int tl = F.tid >> 1; kk = F.tid & 1; t = F.vcu * 128 + tl; e = sel[(size_t)t * 4 + kk]; wgt = __builtin_bit_cast(float, sel[(size_t)t * 4 + 2 + kk]);
#pragma unroll
        for (int ee = 0; ee < 8; ++ee) { const unsigned long long mk = __ballot(e == ee); if (e == ee) rank = __popcll(mk & ((1ull << F.lane) - 1ull)); if (F.lane == 0) wcnt[F.wave * 8 + ee] = __popcll(mk); } }
    __syncthreads();
    if (F.tid < 256) { int pre = 0; for (int w = 0; w < F.wave; ++w) pre += wcnt[w * 8 + e];
        const int pos = mt[8 + e] + mt[16 + e] + pre + rank;
        sdst[pos] = t * 2 + kk; sw[pos] = wgt; plist[F.tid] = pos; plist[256 + F.tid] = t; }
    __syncthreads();
    for (int q = F.wave * 32; q < F.wave * 32 + 32; ++q) { const int pos = plist[q], tt = plist[256 + q];
        const GAS v4u* s = (const GAS v4u*)(XB + (size_t)tt * D) + F.lane; GAS v4u* d = (GAS v4u*)(XS + (size_t)pos * D) + F.lane;
        const v4u a = s[0], b = s[64]; d[0] = a; d[64] = b; }
    if (F.vcu < 8) { const int ee = F.vcu, lo = mt[8 + ee] + mt[ee], hi = mt[8 + ee] + (((mt[ee] + 255) >> 8) << 8);
        for (int r = lo + F.wave; r < hi; r += NWAVES) { GAS v4u* d = (GAS v4u*)(XS + (size_t)r * D) + F.lane; d[0] = (v4u){0u, 0u, 0u, 0u}; d[64] = (v4u){0u, 0u, 0u, 0u}; if (F.lane == 0) { sdst[r] = -1; sw[r] = 0.f; } } }
}

__device__ __forceinline__ void final_phase(Frame& F, const float* R0, const float* gam, const float* bet, float* out) {
    const int gw = F.vcu * NWAVES + F.wave, NGW = F.G * NWAVES;
    const bf16* Y = (const bf16*)(F.ws + WS_Y);
    f32x4 gv[4], bv[4];
#pragma unroll
    for (int j = 0; j < 4; ++j) { gv[j] = *((const GAS f32x4*)gam + F.lane + 64 * j); bv[j] = *((const GAS f32x4*)bet + F.lane + 64 * j); }
    for (int m = gw; m < T; m += NGW) {
        const GAS f32x4* xr = (const GAS f32x4*)(R0 + (size_t)m * D) + F.lane;
        const GAS v2u* y0 = (const GAS v2u*)(Y + (size_t)m * 2 * D) + F.lane; const GAS v2u* y1 = y0 + 256;
        f32x4 v[4]; float s = 0.f;
#pragma unroll
        for (int j = 0; j < 4; ++j) { const v2u a = y0[64 * j], b = y1[64 * j]; v[j] = xr[64 * j] * ALPHA;
            v[j].x += bf2f(a.x & 0xffffu) + bf2f(b.x & 0xffffu); v[j].y += bf2f(a.x >> 16) + bf2f(b.x >> 16); v[j].z += bf2f(a.y & 0xffffu) + bf2f(b.y & 0xffffu); v[j].w += bf2f(a.y >> 16) + bf2f(b.y >> 16);
            s += (v[j].x + v[j].y) + (v[j].z + v[j].w); }
        const float mean = wave_sum(s) * (1.f / D); float s2 = 0.f;
#pragma unroll
        for (int j = 0; j < 4; ++j) { v[j] = v[j] - mean; s2 += (v[j].x * v[j].x + v[j].y * v[j].y) + (v[j].z * v[j].z + v[j].w * v[j].w); }
        const float rstd = 1.f / sqrtf(wave_sum(s2) * (1.f / D) + LN_EPS);
        GAS f32x4* of = (GAS f32x4*)(out + (size_t)m * D) + F.lane;
#pragma unroll
        for (int j = 0; j < 4; ++j) of[64 * j] = v[j] * rstd * gv[j] + bv[j];
    }
}

namespace ep {
using pg8::f32x4; using pg8::Unit; using pg8::u32x4; using pg8::u32x2; using pg8::cvt_pk_bf16;
constexpr int HALF = 128;

struct DenseOrder { int nM, nN, G, c; size_t astep, bstep;
    __device__ __forceinline__ bool next(int i, Unit& u) const { const long L = (long)i * G + c; if (L >= (long)nM * nN) return false;
        pg8::order_tile((int)L, nM, nN, u.pm, u.pn); u.aoff = (size_t)u.pm * astep; u.boff = (size_t)u.pn * bstep; return true; } };
struct PoolOrder { int G, c;
    __device__ __forceinline__ bool next(int i, Unit& u) const { const long L = (long)i * G + c; if (L >= (T / 256) * 4) return false;
        pg8::order_tile((int)L, T / 256, 4, u.pm, u.pn); u.aoff = (size_t)u.pm * 256 * D * 2 + (size_t)u.pn * 512; u.boff = (size_t)u.pn * 256 * 256 * 2; return true; } };
struct CmpOrder { int G, c;
    __device__ __forceinline__ bool next(int i, Unit& u) const { const long L = (long)i * G + c; if (L >= 256) return false;
        const int kv = (int)L >> 7, bg = ((int)L >> 2) & 31, kq = (int)L & 3; u.pm = bg; u.pn = kv * 4 + kq;
        u.aoff = ((size_t)kv * KV6_STRIDE + (size_t)bg * SEQ * 64 + (size_t)kq * 512) * 2; u.boff = ((size_t)kv * 256 * 2048 + (size_t)kq * 512) * 2; return true; } };
template <int NN> struct MoeOrder { int nM, G, c, tile0; const LAS int* tile_e; size_t a_tile, b_exp, b_tile; bool a_local;
    __device__ __forceinline__ bool next(int i, Unit& u) const { const int L = i * G + c; if (L >= nM * NN) return false;
        const int pml = L / NN; u.pn = L % NN; u.pm = tile0 + pml; const int e = __builtin_amdgcn_readfirstlane(tile_e[u.pm]);
        u.aoff = (size_t)(a_local ? pml : u.pm) * a_tile; u.boff = (size_t)e * b_exp + (size_t)u.pn * b_tile; return true; } };

struct EpiPool { static constexpr bool PERM = false; const float* x; const float* scale; float* out;
    __device__ __forceinline__ void operator()(const f32x4 (&acc)[2][2][4][2], const Unit& u, int wr, int wc, int fr, int fq) const {
        const int col0 = u.pn * 256 + wc * 32 + 4 * fq;
#pragma unroll
        for (int bj = 0; bj < 2; ++bj)
#pragma unroll
            for (int n = 0; n < 2; ++n) { const f32x4 sc = *(const f32x4*)(scale + col0 + bj * HALF + n * 16);
#pragma unroll
                for (int ai = 0; ai < 2; ++ai) {
#pragma unroll
                    for (int m = 0; m < 4; ++m) { const size_t off = (size_t)(u.pm * 256 + ai * HALF + wr * 64 + m * 16 + fr) * D + col0 + bj * HALF + n * 16;
                        const f32x4 xv = *(const f32x4*)(x + off); *(f32x4*)(out + off) = xv * ALPHA + acc[ai][bj][m][n] * sc; }
                    asm volatile("" ::: "memory"); } }
    } };
struct EpiResid { static constexpr bool PERM = false; float* R;
    __device__ __forceinline__ void operator()(const f32x4 (&acc)[2][2][4][2], const Unit& u, int wr, int wc, int fr, int fq) const {
        const int col0 = u.pn * 256 + wc * 32 + 4 * fq;
#pragma unroll
        for (int ai = 0; ai < 2; ++ai)
#pragma unroll
            for (int m = 0; m < 4; ++m) { const size_t off = (size_t)(u.pm * 256 + ai * HALF + wr * 64 + m * 16 + fr) * D + col0;
#pragma unroll
                for (int bj = 0; bj < 2; ++bj)
#pragma unroll
                    for (int n = 0; n < 2; ++n) { float* p = R + off + bj * HALF + n * 16; const f32x4 xv = *(const f32x4*)p; *(f32x4*)p = xv * ALPHA + acc[ai][bj][m][n]; }
                if (m & 1) asm volatile("" ::: "memory"); }
    } };
struct EpiSwiGLU { static constexpr bool PERM = true; bf16* O; int ldc; int pm0;
    __device__ __forceinline__ void operator()(const f32x4 (&acc)[2][2][4][2], const Unit& u, int wr, int wc, int fr, int fq) const {
        const int col0 = u.pn * 128 + wc * 32 + 8 * fq;
#pragma unroll
        for (int ai = 0; ai < 2; ++ai)
#pragma unroll
            for (int m = 0; m < 4; ++m) { bf16* rowp = O + (size_t)((u.pm - pm0) * 256 + ai * HALF + wr * 64 + m * 16 + fr) * ldc + col0;
                const f32x4 g0 = acc[ai][0][m][0], g1 = acc[ai][0][m][1], u0 = acc[ai][1][m][0], u1 = acc[ai][1][m][1];
                u32x4 w; w.x = cvt_pk_bf16(silu_f(g0[0]) * u0[0], silu_f(g0[1]) * u0[1]); w.y = cvt_pk_bf16(silu_f(g0[2]) * u0[2], silu_f(g0[3]) * u0[3]);
                w.z = cvt_pk_bf16(silu_f(g1[0]) * u1[0], silu_f(g1[1]) * u1[1]); w.w = cvt_pk_bf16(silu_f(g1[2]) * u1[2], silu_f(g1[3]) * u1[3]);
                *(u32x4*)rowp = w; }
    } };
struct EpiMoeDown { static constexpr bool PERM = true; bf16* Y; const int* sdst; const float* sw;
    __device__ __forceinline__ void operator()(const f32x4 (&acc)[2][2][4][2], const Unit& u, int wr, int wc, int fr, int fq) const {
        const int col0 = u.pn * 256 + wc * 32 + 8 * fq;
#pragma unroll
        for (int ai = 0; ai < 2; ++ai)
#pragma unroll
            for (int m = 0; m < 4; ++m) { const int sr = u.pm * 256 + ai * HALF + wr * 64 + m * 16 + fr; const int d = sdst[sr]; const float w = sw[sr];
                if (d >= 0) { bf16* rowp = Y + (size_t)d * D + col0;
#pragma unroll
                    for (int bj = 0; bj < 2; ++bj) { const f32x4 v0 = acc[ai][bj][m][0] * w, v1 = acc[ai][bj][m][1] * w;
                        u32x4 o; o.x = cvt_pk_bf16(v0[0], v0[1]); o.y = cvt_pk_bf16(v0[2], v0[3]); o.z = cvt_pk_bf16(v1[0], v1[1]); o.w = cvt_pk_bf16(v1[2], v1[3]);
                        *(u32x4*)(rowp + bj * HALF) = o; } } }
    } };
struct EpiCPart { static constexpr bool PERM = false; float* part;
    __device__ __forceinline__ void operator()(const f32x4 (&acc)[2][2][4][2], const Unit& u, int wr, int wc, int fr, int fq) const {
        const int col0 = wc * 32 + 4 * fq;
#pragma unroll
        for (int ai = 0; ai < 2; ++ai)
#pragma unroll
            for (int m = 0; m < 4; ++m) { float* rowp = part + ((size_t)u.pn * 8192 + u.pm * 256 + ai * HALF + wr * 64 + m * 16 + fr) * 128 + col0;
#pragma unroll
                for (int n = 0; n < 2; ++n) *(f32x4*)(rowp + n * 16) = acc[ai][0][m][n]; }
    } };
struct EpiInProj { static constexpr bool PERM = false; bf16* Q; bf16* KV6; float* gates; const float* rc; const float* rs;
    __device__ __forceinline__ void operator()(const f32x4 (&acc)[2][2][4][2], const Unit& u, int wr, int wc, int fr, int fq) const {
        const int pn = u.pn, i0 = 16 * (wc & 1) + 4 * fq;
        const bool rope = (pn < 4) || pn == 6 || pn == 8;
#pragma unroll
        for (int ai = 0; ai < 2; ++ai)
#pragma unroll
            for (int m = 0; m < 4; ++m) { const int row = u.pm * 256 + ai * HALF + wr * 64 + m * 16 + fr, pos = row & (SEQ - 1), bb = row >> 12;
                f32x4 cs = (f32x4){1.f, 1.f, 1.f, 1.f}, sn = (f32x4){0.f, 0.f, 0.f, 0.f};
                if (rope) { cs = *(const f32x4*)(rc + pos * 32 + i0); sn = *(const f32x4*)(rs + pos * 32 + i0); }
#pragma unroll
                for (int bj = 0; bj < 2; ++bj) { const int head = 2 * bj + (wc >> 1); const f32x4 x1 = acc[ai][bj][m][0], x2 = acc[ai][bj][m][1];
                    if (pn == 10) { if (head == 0) { float* gp = gates + (size_t)row * 48 + i0;
                            f32x4 s1; for (int j = 0; j < 4; ++j) s1[j] = 1.0f / (1.0f + __expf(-x1[j])); *(f32x4*)gp = s1;
                            if (i0 < 16) { f32x4 s2; for (int j = 0; j < 4; ++j) s2[j] = 1.0f / (1.0f + __expf(-x2[j])); *(f32x4*)(gp + 32) = s2; } } }
                    else { f32x4 o1 = x1 * cs - x2 * sn, o2 = x1 * sn + x2 * cs; bf16* dst;
                        if (pn < 4) { o1 = o1 * QSCALE; o2 = o2 * QSCALE; dst = Q + (size_t)row * D + (4 * pn + head) * 64 + i0; }
                        else dst = KV6 + (size_t)(pn - 4) * KV6_STRIDE + ((size_t)(bb * 4 + head) * SEQ + pos) * 64 + i0;
                        u32x2 a, b; a.x = cvt_pk_bf16(o1[0], o1[1]); a.y = cvt_pk_bf16(o1[2], o1[3]); b.x = cvt_pk_bf16(o2[0], o2[1]); b.y = cvt_pk_bf16(o2[2], o2[3]);
                        *(u32x2*)dst = a; *(u32x2*)(dst + 32) = b; } } }
    } };
}

__device__ __forceinline__ void compress_finish_phase(Frame& F) {
    LAS float* w2s = (LAS float*)(F.lds + RING_OFF);
    for (int idx = F.tid; idx < 2 * 8192; idx += 512) w2s[idx] = F.inp(idx < 8192 ? I_W2K : I_W2V)[idx & 8191];
    __syncthreads();
    const float* part = (const float*)(F.ws + WS_CPART); const float* cb = (const float*)(F.ws + WS_MISC);
    const float* rc = (const float*)(F.ws + WS_ROPE); const float* rs = rc + SEQ * 32;
    bf16* kvc = (bf16*)(F.ws + WS_KVC);
    const int gw = F.vcu * NWAVES + F.wave, NGW = F.G * NWAVES;
    for (int row = gw; row < 2 * 32 * 256; row += NGW) {
        const int kv = row >> 13, r = row & 8191, n = r & 255;
        bf16* dst = kvc + (size_t)row * 64 + F.lane;
        if (n == 255) { *dst = 0; continue; }
        float h0 = cb[kv * 128 + F.lane], h1 = cb[kv * 128 + 64 + F.lane];
#pragma unroll
        for (int q = 0; q < 4; ++q) { const float* p = part + ((size_t)(kv * 4 + q) * 8192 + r) * 128; h0 += p[F.lane]; h1 += p[64 + F.lane]; }
        h0 = silu_f(h0); h1 = silu_f(h1);
        const LAS float* w2 = w2s + kv * 8192 + F.lane; float o = 0.f;
#pragma unroll
        for (int c = 0; c < 64; ++c) o += __builtin_bit_cast(float, __builtin_amdgcn_readlane(__builtin_bit_cast(int, h0), c)) * w2[c * 64];
#pragma unroll
        for (int c = 0; c < 64; ++c) o += __builtin_bit_cast(float, __builtin_amdgcn_readlane(__builtin_bit_cast(int, h1), c)) * w2[(64 + c) * 64];
        if (kv == 0) { const int pos = 16 * n + 31, i = F.lane & 31; const float other = __shfl_xor(o, 32), cs = rc[pos * 32 + i], sn = rs[pos * 32 + i];
            o = (F.lane < 32) ? o * cs - other * sn : other * sn + o * cs; }
        *dst = (bf16)f2bf(o);
    }
    __syncthreads();
}

namespace att {
using f32x16 = __attribute__((ext_vector_type(16))) float;
using s16x4 = __attribute__((ext_vector_type(4))) short;
constexpr int SLOTB = 8192;
constexpr int LDS_K = 0, LDS_V = 2 * SLOTB, LDS_WS = 4 * SLOTB, LDS_OST = LDS_WS + NWAVES * 256, OSTR = 72  , LDS_IMP = LDS_OST + NWAVES * 32 * OSTR * 4, LDS_SM = LDS_IMP + NWAVES * 2048, LDS_END = LDS_SM + NWAVES * 64;
static_assert(LDS_END <= RING_BYTES, "attention LDS");
__device__ __forceinline__ int crow(int r, int hi) { return (r & 3) + 8 * (r >> 2) + 4 * hi; }
__device__ __forceinline__ float max3f(float a, float b, float c) { float r; asm("v_max3_f32 %0, %1, %2, %3" : "=v"(r) : "v"(a), "v"(b), "v"(c)); return r; }
__device__ __forceinline__ unsigned cvtpk(float lo, float hi) { unsigned r; asm("v_cvt_pk_bf16_f32 %0, %1, %2" : "=v"(r) : "v"(lo), "v"(hi)); return r; }
typedef short v4i16_t __attribute__((ext_vector_type(4)));
#define ATT_WAIT_BAR(N) asm volatile("s_waitcnt vmcnt(" #N ") lgkmcnt(0)\n\ts_barrier" ::: "memory")
#define ATT_LGKM_BAR() asm volatile("s_waitcnt lgkmcnt(0)\n\ts_barrier" ::: "memory")

__device__ __forceinline__ void qkt(f32x16& p0, f32x16& p1, const LAS unsigned char* Kslot, const bf16x8* qr, int r32, int hi) {
    const LAS unsigned char* kb = Kslot + hi * 1024 + r32 * 16;
    p0 = f32x16{}; p1 = f32x16{};
#pragma unroll
    for (int d0 = 0; d0 < 4; ++d0) {
        const bf16x8 b0 = *(const LAS bf16x8*)(kb + d0 * 2048), b1 = *(const LAS bf16x8*)(kb + d0 * 2048 + 512);
        p0 = __builtin_amdgcn_mfma_f32_32x32x16_bf16(b0, qr[d0], p0, 0, 0, 0); p1 = __builtin_amdgcn_mfma_f32_32x32x16_bf16(b1, qr[d0], p1, 0, 0, 0); }
}
__device__ __forceinline__ float rowmax(const f32x16& p0, const f32x16& p1) {
    float a = max3f(p0[0], p0[1], p1[0]), b = max3f(p0[2], p0[3], p1[1]); a = max3f(a, p1[2], p1[3]);
#pragma unroll
    for (int r = 4; r < 16; r += 4) { a = max3f(a, p0[r], p0[r + 1]); b = max3f(b, p0[r + 2], p0[r + 3]); a = max3f(a, p1[r], p1[r + 1]); b = max3f(b, p1[r + 2], p1[r + 3]); }
    const float m = fmaxf(a, b);
    auto rr = __builtin_amdgcn_permlane32_swap(__float_as_uint(m), __float_as_uint(m), false, false);
    return fmaxf(__uint_as_float(rr[0]), __uint_as_float(rr[1]));
}
__device__ __forceinline__ float halfswap_add(float v) { auto rr = __builtin_amdgcn_permlane32_swap(__float_as_uint(v), __float_as_uint(v), false, false); return __uint_as_float(rr[0]) + __uint_as_float(rr[1]); }
__device__ __forceinline__ void pv(f32x16* o, int vb, bf16x8 pa0, bf16x8 pa1, bf16x8 pa2, bf16x8 pa3) {
#pragma unroll
    for (int d0 = 0; d0 < 2; ++d0) { s16x4 lo[4], hi[4];
#pragma unroll
        for (int ks = 0; ks < 4; ++ks) {
            asm volatile("ds_read_b64_tr_b16 %0,%1 offset:%c2" : "=&v"(lo[ks]) : "v"(vb), "i"(d0 * 4096 + ks * 1024) : "memory");
            asm volatile("ds_read_b64_tr_b16 %0,%1 offset:%c2" : "=&v"(hi[ks]) : "v"(vb), "i"(d0 * 4096 + ks * 1024 + 512) : "memory"); }
        asm volatile("s_waitcnt lgkmcnt(0)" ::: "memory"); __builtin_amdgcn_sched_barrier(0);
#define ATT_PK(k) (bf16x8){lo[k][0], lo[k][1], lo[k][2], lo[k][3], hi[k][0], hi[k][1], hi[k][2], hi[k][3]}
        o[d0] = __builtin_amdgcn_mfma_f32_32x32x16_bf16(pa0, ATT_PK(0), o[d0], 0, 0, 0);
        o[d0] = __builtin_amdgcn_mfma_f32_32x32x16_bf16(pa1, ATT_PK(1), o[d0], 0, 0, 0);
        o[d0] = __builtin_amdgcn_mfma_f32_32x32x16_bf16(pa2, ATT_PK(2), o[d0], 0, 0, 0);
        o[d0] = __builtin_amdgcn_mfma_f32_32x32x16_bf16(pa3, ATT_PK(3), o[d0], 0, 0, 0);
#undef ATT_PK
    }
}
__device__ __forceinline__ void mask_gt(f32x16& p0, f32x16& p1, int thr, int hi) {
#pragma unroll
    for (int r = 0; r < 16; ++r) { const int kv = crow(r, hi); if (kv > thr) p0[r] = -INFINITY; if (kv + 32 > thr) p1[r] = -INFINITY; } }
__device__ __forceinline__ void mask_le(f32x16& p0, f32x16& p1, int thr, int hi) {
#pragma unroll
    for (int r = 0; r < 16; ++r) { const int kv = crow(r, hi); if (kv <= thr) p0[r] = -INFINITY; if (kv + 32 <= thr) p1[r] = -INFINITY; } }
__device__ __forceinline__ void mask_all(f32x16& p0, f32x16& p1) {
#pragma unroll
    for (int r = 0; r < 16; ++r) { p0[r] = -INFINITY; p1[r] = -INFINITY; } }

struct Ctx { LAS unsigned char* shm; int wid, lane, r32, hi; LAS float* wsf; int vb0; };

__device__ __forceinline__ void dma_k(const Ctx& c, const bf16* Kt, int slot) {
    __builtin_amdgcn_global_load_lds((const unsigned*)(Kt + c.lane * 64 + c.wid * 8), (LAS unsigned*)(c.shm + LDS_K + slot * SLOTB + c.wid * 1024), 16, 0, 0); }
__device__ __forceinline__ void dma_v(const Ctx& c, const bf16* Vt, int slot) {
    __builtin_amdgcn_global_load_lds((const unsigned*)(Vt + (16 * (c.wid & 3) + (c.lane >> 2)) * 64 + (c.wid >> 2) * 32 + (c.lane & 3) * 8), (LAS unsigned*)(c.shm + LDS_V + slot * SLOTB + c.wid * 1024), 16, 0, 0); }

__device__ __forceinline__ void p_times_v(const Ctx& c, f32x16* o, const f32x16& p0, const f32x16& p1, int slot) {
    v4u pw0 = (v4u){cvtpk(p0[0], p0[1]), cvtpk(p0[2], p0[3]), cvtpk(p0[4], p0[5]), cvtpk(p0[6], p0[7])};
    v4u pw1 = (v4u){cvtpk(p0[8], p0[9]), cvtpk(p0[10], p0[11]), cvtpk(p0[12], p0[13]), cvtpk(p0[14], p0[15])};
    v4u pw2 = (v4u){cvtpk(p1[0], p1[1]), cvtpk(p1[2], p1[3]), cvtpk(p1[4], p1[5]), cvtpk(p1[6], p1[7])};
    v4u pw3 = (v4u){cvtpk(p1[8], p1[9]), cvtpk(p1[10], p1[11]), cvtpk(p1[12], p1[13]), cvtpk(p1[14], p1[15])};
    pv(o, c.vb0 + slot * SLOTB, __builtin_bit_cast(bf16x8, pw0), __builtin_bit_cast(bf16x8, pw1), __builtin_bit_cast(bf16x8, pw2), __builtin_bit_cast(bf16x8, pw3));
}
__device__ __forceinline__ void online_step(const Ctx& c, f32x16& p0, f32x16& p1, float& m, float& l, f32x16* o, int slot) {
    const float rm = rowmax(p0, p1);
    const float mn = fmaxf(fmaxf(m, rm), -1.0e30f);
    const float f = __builtin_amdgcn_exp2f(m - mn);
    float s = 0.f;
#pragma unroll
    for (int r = 0; r < 16; ++r) { p0[r] = __builtin_amdgcn_exp2f(p0[r] - mn); p1[r] = __builtin_amdgcn_exp2f(p1[r] - mn); s += p0[r] + p1[r]; }
    l = l * f + s; m = mn;
    if (__any(f != 1.0f)) { if (c.hi == 0) c.wsf[c.r32] = f; LDS_WAIT();
#pragma unroll
        for (int r = 0; r < 16; ++r) { const float fr = c.wsf[crow(r, c.hi)]; o[0][r] *= fr; o[1][r] *= fr; }
        LDS_WAIT(); }
    p_times_v(c, o, p0, p1, slot);
}
__device__ __forceinline__ void fold_out(const Ctx& c, LAS float* outacc, const f32x16* o, float fac) {
    if (c.hi == 0) c.wsf[32 + c.r32] = fac; LDS_WAIT();
#pragma unroll
    for (int r = 0; r < 16; ++r) { const float fr = c.wsf[32 + crow(r, c.hi)]; LAS float* p = outacc + crow(r, c.hi) * OSTR + c.r32; p[0] += o[0][r] * fr; p[32] += o[1][r] * fr; }
    LDS_WAIT();
}

__device__ __forceinline__ void attn_unit(Frame& F, int b, int g, int qb) {
    Ctx c; c.shm = F.lds + RING_OFF; c.wid = F.wave; c.lane = F.lane; c.r32 = F.lane & 31; c.hi = F.lane >> 5;
    c.wsf = (LAS float*)(c.shm + LDS_WS) + c.wid * 64;
    c.vb0 = (int)(uintptr_t)(c.shm + LDS_V) + ((c.lane >> 4) & 1) * 32 + (c.lane & 3) * 8 + (4 * c.hi + ((c.lane & 15) >> 2)) * 64;
    const int tt = c.r32 & 7, hh = c.r32 >> 3, tok = 8 * c.wid + tt, t0 = 64 * qb, t = t0 + tok;
    const size_t grow = (size_t)b * SEQ + t;
    const bf16* Qp = (const bf16*)(F.ws + WS_Q) + grow * D + (4 * g + hh) * 64 + c.hi * 8;
    const bf16* KV6 = (const bf16*)(F.ws + WS_KV6) + (size_t)(b * 4 + g) * SEQ * 64;
    const bf16* KC = (const bf16*)(F.ws + WS_KVC) + (size_t)(b * 4 + g) * 256 * 64;
    VM_WAIT();
    bf16x8 qr[4];
#pragma unroll
    for (int d0 = 0; d0 < 4; ++d0) qr[d0] = *(const bf16x8*)(Qp + d0 * 16);
    const float* gp = (const float*)(F.ws + WS_GATES) + grow * 48 + (4 * g + hh) * 3;
    const float gate_c = gp[0], gate_s = gp[1], gate_w = gp[2];
    LAS float* out = (LAS float*)(c.shm + LDS_OST) + c.wid * 32 * OSTR;
#pragma unroll
    for (int k = 0; k < 32; ++k) out[k * OSTR + c.lane] = 0.f;
    LAS float* imp = (LAS float*)(c.shm + LDS_IMP) + c.wid * 512;
    LAS unsigned long long* smk = (LAS unsigned long long*)(c.shm + LDS_SM) + c.wid * 8;
    const bool need_sel = qb > 15;
    if (need_sel) {
#pragma unroll
        for (int k = 0; k < 8; ++k) imp[k * 64 + c.lane] = 0.f; }
    const int nmax = (t - 31) >> 4;
    const int nmax_min = (t0 - 31) >> 4;
    const int nct = ((4 * qb + 2) >> 6) + 1;
    const int e0 = nct, e1 = 2 * nct, e2 = e1 + qb + 1, ntot = e2 + (qb < 8 ? qb : 8) + 1;
#define ATT_ISSUE(i_, slot_) do { const int ii = (i_); const bf16 *Kt, *Vt; \
        if (ii < e1) { const int j = ii < e0 ? ii : ii - e0; Kt = KC + (size_t)j * 4096; Vt = Kt + 32 * 256 * 64; } \
        else if (ii < e2) { Kt = KV6 + 2 * KV6_STRIDE + (size_t)(ii - e1) * 4096; Vt = Kt + KV6_STRIDE; } \
        else { Kt = KV6 + 4 * KV6_STRIDE + (size_t)(qb - (ii - e2)) * 4096; Vt = Kt + KV6_STRIDE; } \
        dma_k(c, Kt, (slot_)); dma_v(c, Vt, (slot_)); } while (0)
    float m = -INFINITY, l = 0.f, inv = 0.f; f32x16 o[2]; o[0] = f32x16{}; o[1] = f32x16{};
    unsigned long long mymask = ~0ull;
    ATT_ISSUE(0, 0);
    for (int i = 0; i < ntot; ++i) {
        const int slot = i & 1;
        if (i + 1 < ntot) { ATT_ISSUE(i + 1, slot ^ 1); ATT_WAIT_BAR(2); } else { ATT_WAIT_BAR(0); }
        f32x16 p0, p1;
        qkt(p0, p1, c.shm + LDS_K + slot * SLOTB, qr, c.r32, c.hi);
        if (i < e1) {
            const int j = i < e0 ? i : i - e0;
            if (64 * j + 63 > nmax_min) mask_gt(p0, p1, nmax - 64 * j, c.hi);
            if (i < e0) {
                const float rm = rowmax(p0, p1), mn = fmaxf(fmaxf(m, rm), -1.0e30f); float s = 0.f;
#pragma unroll
                for (int r = 0; r < 16; ++r) s += __builtin_amdgcn_exp2f(p0[r] - mn) + __builtin_amdgcn_exp2f(p1[r] - mn);
                l = l * __builtin_amdgcn_exp2f(m - mn) + s; m = mn;
                if (i + 1 == e0) { const float lt = halfswap_add(l); inv = lt > 0.f ? 1.0f / lt : 0.f; }
            } else {
#pragma unroll
                for (int r = 0; r < 16; ++r) { p0[r] = __builtin_amdgcn_exp2f(p0[r] - m) * inv; p1[r] = __builtin_amdgcn_exp2f(p1[r] - m) * inv; }
                if (need_sel) {
                    float qs[8], ls[8];
#pragma unroll
                    for (int k = 0; k < 4; ++k) { qs[k] = (p0[4 * k] + p0[4 * k + 1]) + (p0[4 * k + 2] + p0[4 * k + 3]); ls[k] = p0[4 * k + 3];
                        qs[4 + k] = (p1[4 * k] + p1[4 * k + 1]) + (p1[4 * k + 2] + p1[4 * k + 3]); ls[4 + k] = p1[4 * k + 3]; }
#pragma unroll
                    for (int k = 0; k < 8; ++k) { qs[k] += __shfl_xor(qs[k], 8); qs[k] += __shfl_xor(qs[k], 16); ls[k] += __shfl_xor(ls[k], 8); ls[k] += __shfl_xor(ls[k], 16); }
                    if (hh == 0) {
#pragma unroll
                        for (int k = 0; k < 8; ++k) { const int jb = 16 * j + 2 * (k & 3) + c.hi + 8 * (k >> 2); imp[tt * 64 + jb] += qs[k]; }
                    }
                    LDS_WAIT();
                    if (hh == 0) {
#pragma unroll
                        for (int k = 0; k < 8; ++k) { const int jb = 16 * j + 2 * (k & 3) + c.hi + 8 * (k >> 2) + 1; if (jb < 64) imp[tt * 64 + jb] += ls[k]; }
                    }
                    LDS_WAIT();
                }
                p_times_v(c, o, p0, p1, slot);
                if (i + 1 == e1) {
                    fold_out(c, out, o, gate_c);
                    if (need_sel) {
                        for (int k = 0; k < 8; ++k) {
                            const int jl = c.lane; const bool valid = jl <= qb; const bool forced = (jl == 0) || (jl == qb) || (jl == qb - 1);
                            const float sc = valid ? imp[k * 64 + jl] + (forced ? 1000.0f : 0.0f) : -1.0f;
                            int rank = 0;
#pragma unroll
                            for (int q = 0; q < 64; ++q) { const float sq = __builtin_bit_cast(float, __builtin_amdgcn_readlane(__builtin_bit_cast(int, sc), q)); rank += (sq > sc || (sq == sc && q < jl)) ? 1 : 0; }
                            const unsigned long long mk = __ballot(valid && rank < 16);
                            if (c.lane == 0) smk[k] = mk;
                        }
                        LDS_WAIT();
                        mymask = smk[tt];
                    } else mymask = (2ull << qb) - 1ull;
                    m = -INFINITY; l = 0.f; o[0] = f32x16{}; o[1] = f32x16{};
                }
            }
        } else {
            if (i < e2) { const int j = i - e1;
                if (__any(!((mymask >> j) & 1ull))) { if (!((mymask >> j) & 1ull)) mask_all(p0, p1); }
                if (j == qb) mask_gt(p0, p1, tok, c.hi);
            } else { const int j = i - e2;
                if (j == 0) mask_gt(p0, p1, tok, c.hi);
                if (j == 8) mask_le(p0, p1, tok, c.hi);
            }
            online_step(c, p0, p1, m, l, o, slot);
            if (i + 1 == e2 || i + 1 == ntot) { const float lt = halfswap_add(l); const float gt = (i + 1 == e2) ? gate_s : gate_w;
                fold_out(c, out, o, lt > 0.f ? gt / lt : 0.f);
                m = -INFINITY; l = 0.f; o[0] = f32x16{}; o[1] = f32x16{}; }
        }
        ATT_LGKM_BAR();
    }
#undef ATT_ISSUE
    {
        LDS_WAIT();
        bf16* AO = (bf16*)(F.ws + WS_AO);
#pragma unroll
        for (int i = 0; i < 4; ++i) { const int row = i * 8 + (c.lane >> 3), ch = c.lane & 7; const LAS f32x4* sp = (const LAS f32x4*)(out + row * OSTR + ch * 8); const f32x4 a = sp[0], bq = sp[1];
            const v4u v = (v4u){cvtpk(a[0], a[1]), cvtpk(a[2], a[3]), cvtpk(bq[0], bq[1]), cvtpk(bq[2], bq[3])};
            *(v4u*)(AO + ((size_t)b * SEQ + t0 + 8 * c.wid + (row & 7)) * D + (4 * g + (row >> 3)) * 64 + ch * 8) = v; }
        LDS_WAIT();
    }
}
__device__ __forceinline__ void attn_phase(Frame& F) {
    const int bg = F.vcu >> 3, s = F.vcu & 7;
    for (int i = 0; i < 8; ++i) { const int base = (i >> 1) * 16; const int qb = (i & 1) ? base + 15 - s : base + s;
        attn_unit(F, bg >> 2, bg & 3, qb); }
}
#undef ATT_WAIT_BAR
#undef ATT_LGKM_BAR
}

#ifndef MK_PER_PHASE
#define MK_PER_PHASE 1
#endif
constexpr int N_PHASES = 24;
struct Args { const float* in[18]; float* out; unsigned char* ws; int ph_lo, ph_hi, li, pad; };

__global__ void __launch_bounds__(NWAVES * 64, 2) fwd_kernel(Args args) {
    extern __shared__ __attribute__((aligned(16))) unsigned char lds[];
    Frame F;
    F.lds = (LAS unsigned char*)lds;
    F.MISC = (volatile LAS unsigned*)(F.lds + MISC_OFF);
    refresh(F);
    F.G = gridDim.x; { const int bx = blockIdx.x; F.vcu = (F.G % 8 == 0) ? (bx % 8) * (F.G / 8) + bx / 8 : bx; }
    F.ws = args.ws; F.ctl = (gu32*)(args.ws + WS_CTL); F.out = args.out;
    for (int u = F.tid; u < (LDS_BYTES - LDSCTL_OFF) / 4; u += NWAVES * 64) ((LAS unsigned*)(F.lds + LDSCTL_OFF))[u] = 0u;
    __syncthreads();
    if (F.tid < 18) ((LAS unsigned long long*)(F.lds + PTR_OFF))[F.tid] = (unsigned long long)args.in[F.tid];
    __syncthreads();
    XcdBarrier bar = xcd_barrier_post((unsigned*)(F.ctl + CW_BAR) + args.li * XCD_BAR_WORDS, F.MISC + 8);
#define GRID_BAR() xcd_barrier(bar)
    const int lo = args.ph_lo, hi = args.ph_hi;
#ifndef PH_MASK
#define PH_MASK 0xFFFFFFu
#endif
#define IN(k) (((PH_MASK >> ((k) > 13 ? 13 + (((k) - 13) & 1) : (k))) & 1u) && lo <= (k) && (k) < hi)
#define BOTH(k) (IN(k) && IN((k) + 1))
    unsigned char* ws = args.ws;
    float* R0 = (float*)(ws + WS_R0); bf16* XB = (bf16*)(ws + WS_XB);
    const int cblk = (int)blockIdx.x;

    if (IN(0)) { refresh(F); p0_prologue(F); if (BOTH(0)) GRID_BAR(); }
    if (IN(1)) { refresh(F);
        pg8::Gemm g{(const bf16*)(ws + WS_APOOL), (const bf16*)(ws + W_POOL), D, 256, 256}; ep::PoolOrder S{F.G, cblk};
        ep::EpiPool E{F.inp(I_X), F.inp(I_POOLS), R0};
        pg8::gemm_phase<ep::EpiPool, ep::PoolOrder, true, false>(F.lds + RING_OFF, g, S, E);
        if (BOTH(1)) GRID_BAR(); }
    if (IN(2)) { refresh(F); ln_phase(F, R0, F.inp(I_LNG) + 0 * D, F.inp(I_LNB) + 0 * D, R0, XB); if (BOTH(2)) GRID_BAR(); }
    if (IN(3)) { refresh(F);
        pg8::Gemm g{XB, (const bf16*)(ws + W_FGU), D, D, D}; ep::DenseOrder S{T / 256, 2 * DFF / 256, F.G, cblk, (size_t)256 * D * 2, (size_t)256 * D * 2};
        ep::EpiSwiGLU E{(bf16*)(ws + WS_H1), DFF, 0};
        pg8::gemm_phase(F.lds + RING_OFF, g, S, E);
        if (BOTH(3)) GRID_BAR(); }
    if (IN(4)) { refresh(F);
        pg8::Gemm g{(const bf16*)(ws + WS_H1), (const bf16*)(ws + W_FDN), DFF, DFF, DFF}; ep::DenseOrder S{T / 256, D / 256, F.G, cblk, (size_t)256 * DFF * 2, (size_t)256 * DFF * 2};
        ep::EpiResid E{R0};
        pg8::gemm_phase(F.lds + RING_OFF, g, S, E);
        if (BOTH(4)) GRID_BAR(); }
    if (IN(5)) { refresh(F); ln_phase(F, R0, F.inp(I_LNG) + 1 * D, F.inp(I_LNB) + 1 * D, R0, XB); if (BOTH(5)) GRID_BAR(); }
    if (IN(6)) { refresh(F);
        pg8::Gemm g{XB, (const bf16*)(ws + W_IN), D, D, D}; ep::DenseOrder S{T / 256, INP_PAD / 256, F.G, cblk, (size_t)256 * D * 2, (size_t)256 * D * 2};
        ep::EpiInProj E{(bf16*)(ws + WS_Q), (bf16*)(ws + WS_KV6), (float*)(ws + WS_GATES), (const float*)(ws + WS_ROPE), (const float*)(ws + WS_ROPE) + SEQ * 32};
        pg8::gemm_phase(F.lds + RING_OFF, g, S, E);
        if (BOTH(6)) GRID_BAR(); }
    if (IN(7)) { refresh(F);
        pg8::Gemm g{(const bf16*)(ws + WS_KV6), (const bf16*)(ws + W_C1), 1024, 2048, 512}; ep::CmpOrder S{F.G, cblk};
        ep::EpiCPart E{(float*)(ws + WS_CPART)};
        pg8::gemm_phase(F.lds + RING_OFF, g, S, E);
        if (BOTH(7)) GRID_BAR(); }
    if (IN(8)) { refresh(F); compress_finish_phase(F); if (BOTH(8)) GRID_BAR(); }
    if (IN(9)) { refresh(F); att::attn_phase(F); if (BOTH(9)) GRID_BAR(); }
    if (IN(10)) { refresh(F);
        pg8::Gemm g{(const bf16*)(ws + WS_AO), (const bf16*)(ws + W_OUT), D, D, D}; ep::DenseOrder S{T / 256, D / 256, F.G, cblk, (size_t)256 * D * 2, (size_t)256 * D * 2};
        ep::EpiResid E{R0};
        pg8::gemm_phase(F.lds + RING_OFF, g, S, E);
        if (BOTH(10)) GRID_BAR(); }
    if (IN(11)) { refresh(F); ln_router_phase(F, R0, F.inp(I_LNG) + 2 * D, F.inp(I_LNB) + 2 * D, XB); if (BOTH(11)) GRID_BAR(); }
    if (IN(12)) { refresh(F); moe_dispatch_phase(F); if (BOTH(12)) GRID_BAR(); }
    for (int ch = 0; ch < MOE_NCH; ++ch) {
        const int p1 = 13 + 2 * ch, p2 = p1 + 1;
        const LAS int* mt = (const LAS int*)(F.lds + MOET_OFF);
        if (IN(p1)) { refresh(F);
            if (lo == p1) moe_tables(F);
            const int NT = mt[24], tile0 = MOE_CH * ch, nM = (NT - tile0) < MOE_CH ? (NT - tile0) : MOE_CH;
            if (nM > 0) {
                pg8::Gemm g{(const bf16*)(ws + WS_XS), (const bf16*)(ws + W_MGU), D, D, D};
                ep::MoeOrder<2 * DFE / 256> S{nM, F.G, cblk, tile0, mt + 32, (size_t)256 * D * 2, (size_t)2 * DFE * D * 2, (size_t)256 * D * 2, false};
                ep::EpiSwiGLU E{(bf16*)(ws + WS_H2), DFE, tile0};
                pg8::gemm_phase(F.lds + RING_OFF, g, S, E);
                if (BOTH(p1)) GRID_BAR(); } }
        if (IN(p2)) { refresh(F);
            if (lo == p2) moe_tables(F);
            const int NT = mt[24], tile0 = MOE_CH * ch, nM = (NT - tile0) < MOE_CH ? (NT - tile0) : MOE_CH;
            if (nM > 0) {
                pg8::Gemm g{(const bf16*)(ws + WS_H2), (const bf16*)(ws + W_MDN), DFE, DFE, DFE};
                ep::MoeOrder<D / 256> S{nM, F.G, cblk, tile0, mt + 32, (size_t)256 * DFE * 2, (size_t)D * DFE * 2, (size_t)256 * DFE * 2, true};
                ep::EpiMoeDown E{(bf16*)(ws + WS_Y), (const int*)(ws + WS_SDST), (const float*)(ws + WS_SW)};
                pg8::gemm_phase(F.lds + RING_OFF, g, S, E);
                if (BOTH(p2)) GRID_BAR(); } }
    }
    if (IN(23)) { refresh(F); final_phase(F, R0, F.inp(I_LNG) + 3 * D, F.inp(I_LNB) + 3 * D, F.out); }
#undef IN
#undef BOTH
#undef GRID_BAR
}

extern "C" void kernel_launch(void* const* d_in, const int* in_sizes, int n_in, void* d_out, int out_size, void* d_ws, size_t ws_size, hipStream_t stream) {
    static int grid = 0;
    if (grid == 0) {
        if (n_in != 18 || in_sizes[0] != T * D || out_size != T * D || ws_size < WS_END) { fprintf(stderr, "kernel_launch: shape/workspace mismatch (n_in %d, ws %zu)\n", n_in, ws_size); grid = -1; return; }
        int dev = 0, cus = 0, per_cu = 0;
        if (hipGetDevice(&dev) != hipSuccess || hipDeviceGetAttribute(&cus, hipDeviceAttributeMultiprocessorCount, dev) != hipSuccess) { grid = -1; return; }
        if (hipFuncSetAttribute((const void*)fwd_kernel, hipFuncAttributeMaxDynamicSharedMemorySize, LDS_BYTES) != hipSuccess) { fprintf(stderr, "kernel_launch: hipFuncSetAttribute failed\n"); grid = -1; return; }
        if (hipOccupancyMaxActiveBlocksPerMultiprocessor(&per_cu, (const void*)fwd_kernel, NWAVES * 64, LDS_BYTES) != hipSuccess || per_cu < 1) { fprintf(stderr, "kernel_launch: occupancy query says %d blocks per CU\n", per_cu); }
        (void)hipGetLastError();
        if (cus != 256) { fprintf(stderr, "kernel_launch: built for 256 CUs, device has %d\n", cus); grid = -1; return; }
        grid = 256;
    }
    if (grid < 0) return;
    if (hipMemsetAsync((char*)d_ws + WS_CTL, 0, CTL_ZERO_BYTES, stream) != hipSuccess) return;
    Args a{};
    for (int i = 0; i < 18; ++i) a.in[i] = (const float*)d_in[i];
    a.out = (float*)d_out; a.ws = (unsigned char*)d_ws;
#if MK_PER_PHASE
    for (int p = 0; p < N_PHASES; ++p) { a.ph_lo = p; a.ph_hi = p + 1; a.li = p; hipLaunchKernelGGL(fwd_kernel, dim3(grid), dim3(NWAVES * 64), LDS_BYTES, stream, a); }
#else
    a.ph_lo = 0; a.ph_hi = N_PHASES; a.li = 0;
    hipLaunchKernelGGL(fwd_kernel, dim3(grid), dim3(NWAVES * 64), LDS_BYTES, stream, a);
#endif
}
```

```cpp
#include <hip/hip_runtime.h>
#include <cstdio>
#include <cstdint>

namespace pg8 {
#define PG8_LAS __attribute__((address_space(3)))
typedef unsigned short bf16_t;
typedef short bf16x8 __attribute__((ext_vector_type(8)));
typedef float f32x4 __attribute__((ext_vector_type(4)));
typedef float f32x2 __attribute__((ext_vector_type(2)));
typedef unsigned u32x4 __attribute__((ext_vector_type(4)));
typedef unsigned u32x2 __attribute__((ext_vector_type(2)));
constexpr int BM = 256, BK = 64, HALF = 128, HTB = HALF * BK * 2  , STAGE_BYTES = 8 * HTB, NXCD = 8, WGM = 8;

__host__ __device__ __forceinline__ int lds_byte(int r, int c) { const int st = (r >> 4) * 2 + (c >> 5), rr = r & 15, cc = c & 31, ob = rr * 64 + cc * 2; return st * 1024 + (ob ^ (((ob >> 9) & 1) << 5)); }
__host__ __device__ __forceinline__ void stage_rc(int b, int& R, int& C) { const int st = b / 1024, sb = b % 1024, swz = sb ^ (((sb >> 9) & 1) << 5); R = (st >> 1) * 16 + swz / 64; C = (st & 1) * 32 + (swz % 64) / 2; }
__host__ __device__ __forceinline__ int perm32(int rho) { const int n = rho >> 4, i = rho & 15; return 8 * (i >> 2) + 4 * n + (i & 3); }

struct Unit { int pm, pn; size_t aoff, boff; };
struct Gemm { const bf16_t* A; const bf16_t* Bt; int lda, ldb, K; };

__device__ __forceinline__ void order_tile(int L, int nM, int nN, int& pm, int& pn) {
    const int nwg = nM * nN; int wgid = L;
    { const int q = nwg / NXCD, r = nwg % NXCD, xcd = wgid % NXCD, off = wgid / NXCD; wgid = (xcd < r ? xcd * (q + 1) : r * (q + 1) + (xcd - r) * q) + off; }
    const int nig = WGM * nN, gid = wgid / nig, fm = gid * WGM, gsz = (nM - fm) < WGM ? (nM - fm) : WGM;
    pm = fm + ((wgid % nig) % gsz); pn = (wgid % nig) / gsz;
}

__device__ __forceinline__ unsigned cvt_pk_bf16(float lo, float hi) { unsigned r; asm volatile("v_cvt_pk_bf16_f32 %0, %1, %2" : "=v"(r) : "v"(lo), "v"(hi)); return r; }

template <class Epi, class Sched, bool ALIGN_EPI = true, bool SP2 = true>
__device__ __forceinline__ void gemm_phase(PG8_LAS unsigned char* lds, const Gemm g, const Sched& S, const Epi& E) {
    int tid = threadIdx.x; asm volatile("" : "+v"(tid));
    const int wid = __builtin_amdgcn_readfirstlane(tid >> 6), lane = tid & 63, wr = wid >> 2, wc = wid & 3, fr = lane & 15, fq = lane >> 4;
    const int K = g.K, nt = K / BK;
    unsigned voffA[2], voffB[2];
#pragma unroll
    for (int i = 0; i < 2; ++i) { int R, C; stage_rc(tid * 16 + i * 8192, R, C); const int Rb = Epi::PERM ? ((R & ~31) + perm32(R & 31)) : R;
        voffA[i] = (unsigned)(R * g.lda + C) * 2u; voffB[i] = (unsigned)(Rb * g.ldb + C) * 2u; }
    const size_t kstep = (size_t)(BK * 2);
    const size_t hstepA = (size_t)HALF * g.lda * 2, hstepB = (size_t)HALF * g.ldb * 2;
    const unsigned ldsw = (unsigned)wid * 1024u;
    const int aoff = lds_byte(wr * 64 + fr, fq * 8), boff = lds_byte(wc * 32 + fr, fq * 8);
#define PG8_SA(b, h) (((b) * 2 + (h)) * HTB)
#define PG8_SB(b, h) ((4 + (b) * 2 + (h)) * HTB)
#define PG8_STAGE(bufoff, gbase, voff) do { _Pragma("unroll") for (int _i = 0; _i < 2; ++_i) \
        __builtin_amdgcn_global_load_lds((const unsigned*)((const char*)(gbase) + (voff)[_i]), (PG8_LAS unsigned*)(lds + (bufoff) + ldsw + _i * 8192), 16, 0, 0); } while (0)
#define PG8_LDA(dst, b, h) do { _Pragma("unroll") for (int m = 0; m < 4; ++m) _Pragma("unroll") for (int k = 0; k < 2; ++k) dst[m][k] = *(const PG8_LAS bf16x8*)(lds + PG8_SA(b, h) + aoff + m * 2048 + k * 1024); } while (0)
#define PG8_LDB(dst, b, h) do { _Pragma("unroll") for (int n = 0; n < 2; ++n) _Pragma("unroll") for (int k = 0; k < 2; ++k) dst[n][k] = *(const PG8_LAS bf16x8*)(lds + PG8_SB(b, h) + boff + n * 2048 + k * 1024); } while (0)
#define PG8_MMA(ai, bj, At, Bt) do { __builtin_amdgcn_s_setprio(1); _Pragma("unroll") for (int m = 0; m < 4; ++m) _Pragma("unroll") for (int n = 0; n < 2; ++n) _Pragma("unroll") for (int k = 0; k < 2; ++k) \
        acc[ai][bj][m][n] = __builtin_amdgcn_mfma_f32_16x16x32_bf16(Bt[n][k], At[m][k], acc[ai][bj][m][n], 0, 0, 0); __builtin_amdgcn_s_setprio(0); } while (0)
#define PG8_WAIT_V(n) asm volatile("s_waitcnt vmcnt(" #n ")" ::: "memory")
#define PG8_WAIT_L(n) asm volatile("s_waitcnt lgkmcnt(" #n ")" ::: "memory")
#define PG8_BAR __builtin_amdgcn_s_barrier()
#define PG8_SCHED __builtin_amdgcn_sched_barrier(0)
    Unit cur, nxt; int ui = 0;
    if (!S.next(0, cur)) return;
    f32x4 acc[2][2][4][2];
#pragma unroll
    for (int a = 0; a < 2; ++a)
#pragma unroll
        for (int b = 0; b < 2; ++b)
#pragma unroll
            for (int m = 0; m < 4; ++m)
#pragma unroll
                for (int n = 0; n < 2; ++n) acc[a][b][m][n] = (f32x4){0.f, 0.f, 0.f, 0.f};
    bf16x8 At[4][2], B0[2][2], B1[2][2];
    const char* cA = (const char*)g.A + cur.aoff; const char* cB = (const char*)g.Bt + cur.boff;
    if constexpr (SP2) {
        PG8_STAGE(PG8_SB(0, 0), cB, voffB); PG8_STAGE(PG8_SB(0, 1), cB + hstepB, voffB); PG8_STAGE(PG8_SA(0, 0), cA, voffA); PG8_STAGE(PG8_SA(0, 1), cA + hstepA, voffA);
        if (wr == 1) PG8_BAR;
        PG8_WAIT_V(2); PG8_BAR;
        PG8_STAGE(PG8_SB(1, 0), cB + kstep, voffB); PG8_STAGE(PG8_SA(1, 0), cA + kstep, voffA); PG8_STAGE(PG8_SB(1, 1), cB + hstepB + kstep, voffB);
        PG8_WAIT_V(6); PG8_BAR;
    } else {
        PG8_STAGE(PG8_SB(0, 0), cB, voffB); PG8_STAGE(PG8_SA(0, 0), cA, voffA); PG8_STAGE(PG8_SB(0, 1), cB + hstepB, voffB); PG8_STAGE(PG8_SA(0, 1), cA + hstepA, voffA);
        if (wr == 1) PG8_BAR;
        PG8_WAIT_V(4); PG8_BAR;
        PG8_STAGE(PG8_SB(1, 0), cB + kstep, voffB); PG8_STAGE(PG8_SA(1, 0), cA + kstep, voffA); PG8_STAGE(PG8_SB(1, 1), cB + hstepB + kstep, voffB);
        PG8_WAIT_V(6); PG8_BAR;
    }
    for (;;) {
        const bool has_next = S.next(ui + 1, nxt);
        const char* nA = has_next ? (const char*)g.A + nxt.aoff : cA; const char* nB = has_next ? (const char*)g.Bt + nxt.boff : cB;
        for (int t = 0; t < nt; t += 2) {
            const bool last = (t == nt - 2);
            const char* a1 = cA + (size_t)(t + 1) * kstep;
            const char* a2 = last ? nA : cA + (size_t)(t + 2) * kstep; const char* b2 = last ? nB : cB + (size_t)(t + 2) * kstep;
            const char* a3 = a2 + kstep; const char* b3 = b2 + kstep;
            if constexpr (SP2) {
            PG8_LDB(B0, 0, 0); PG8_LDB(B1, 0, 1); PG8_SCHED; PG8_LDA(At, 0, 0); PG8_STAGE(PG8_SA(1, 1), a1 + hstepA, voffA);
            PG8_WAIT_V(8); PG8_WAIT_L(0); PG8_BAR; PG8_MMA(0, 0, At, B0); PG8_MMA(0, 1, At, B1); PG8_BAR; PG8_SCHED;
            PG8_LDA(At, 0, 1); PG8_STAGE(PG8_SB(0, 0), b2, voffB); PG8_STAGE(PG8_SB(0, 1), b2 + hstepB, voffB); PG8_STAGE(PG8_SA(0, 0), a2, voffA);
            PG8_WAIT_V(8); PG8_WAIT_L(0); PG8_BAR; PG8_MMA(1, 0, At, B0); PG8_MMA(1, 1, At, B1); PG8_BAR; PG8_SCHED;
            PG8_LDB(B0, 1, 0); PG8_LDB(B1, 1, 1); PG8_SCHED; PG8_LDA(At, 1, 0); PG8_STAGE(PG8_SA(0, 1), a2 + hstepA, voffA);
            PG8_WAIT_V(8); PG8_WAIT_L(0); PG8_BAR; PG8_MMA(0, 0, At, B0); PG8_MMA(0, 1, At, B1); PG8_BAR; PG8_SCHED;
            PG8_LDA(At, 1, 1); PG8_STAGE(PG8_SB(1, 0), b3, voffB); PG8_STAGE(PG8_SB(1, 1), b3 + hstepB, voffB); PG8_STAGE(PG8_SA(1, 0), a3, voffA);
            PG8_WAIT_V(8); PG8_WAIT_L(0); PG8_BAR; PG8_MMA(1, 0, At, B0); PG8_MMA(1, 1, At, B1); PG8_BAR; PG8_SCHED;
            } else {
            PG8_LDB(B0, 0, 0); PG8_SCHED; PG8_LDA(At, 0, 0); PG8_STAGE(PG8_SA(1, 1), a1 + hstepA, voffA);
            PG8_WAIT_L(8); PG8_BAR; PG8_WAIT_L(0); PG8_MMA(0, 0, At, B0); PG8_BAR; PG8_SCHED;
            PG8_LDB(B1, 0, 1); PG8_STAGE(PG8_SB(0, 0), b2, voffB);
            PG8_BAR; PG8_WAIT_L(0); PG8_MMA(0, 1, At, B1); PG8_BAR;
            PG8_LDA(At, 0, 1); PG8_STAGE(PG8_SA(0, 0), a2, voffA);
            PG8_BAR; PG8_WAIT_L(0); PG8_MMA(1, 0, At, B0); PG8_BAR; PG8_SCHED;
            PG8_STAGE(PG8_SB(0, 1), b2 + hstepB, voffB);
            PG8_WAIT_V(6); PG8_BAR; PG8_MMA(1, 1, At, B1); PG8_BAR;
            PG8_LDB(B0, 1, 0); PG8_SCHED; PG8_LDA(At, 1, 0); PG8_STAGE(PG8_SA(0, 1), a2 + hstepA, voffA);
            PG8_WAIT_L(8); PG8_BAR; PG8_WAIT_L(0); PG8_MMA(0, 0, At, B0); PG8_BAR; PG8_SCHED;
            PG8_LDB(B1, 1, 1); PG8_STAGE(PG8_SB(1, 0), b3, voffB);
            PG8_BAR; PG8_WAIT_L(0); PG8_MMA(0, 1, At, B1); PG8_BAR;
            PG8_LDA(At, 1, 1); PG8_STAGE(PG8_SA(1, 0), a3, voffA);
            PG8_BAR; PG8_WAIT_L(0); PG8_MMA(1, 0, At, B0); PG8_BAR; PG8_SCHED;
            PG8_STAGE(PG8_SB(1, 1), b3 + hstepB, voffB);
            PG8_WAIT_V(6); PG8_BAR; PG8_MMA(1, 1, At, B1); PG8_BAR;
            }
        }
        if constexpr (ALIGN_EPI) { if (wr == 0) PG8_BAR; }
        E(acc, cur, wr, wc, fr, fq);
        if (!has_next) break;
#pragma unroll
        for (int a = 0; a < 2; ++a)
#pragma unroll
            for (int b = 0; b < 2; ++b)
#pragma unroll
                for (int m = 0; m < 4; ++m)
#pragma unroll
                    for (int n = 0; n < 2; ++n) acc[a][b][m][n] = (f32x4){0.f, 0.f, 0.f, 0.f};
        cur = nxt; cA = nA; cB = nB; ++ui;
        if constexpr (ALIGN_EPI) { if (wr == 1) PG8_BAR; }
    }
    PG8_WAIT_V(0);
    if constexpr (!ALIGN_EPI) { if (wr == 0) PG8_BAR; }
    PG8_BAR;
#undef PG8_SA
#undef PG8_SB
#undef PG8_STAGE
#undef PG8_LDA
#undef PG8_LDB
#undef PG8_MMA
#undef PG8_WAIT_V
#undef PG8_WAIT_L
#undef PG8_BAR
#undef PG8_SCHED
}
}

constexpr int NWAVES = 8;
constexpr int BATCH = 8, SEQ = 4096, D = 1024, T = BATCH * SEQ;
constexpr int DFF = 2816, NE = 8, DFE = 3584, INP = 2608, INP_PAD = 2816;
constexpr int NH = 16, NG = 4, HD = 64;
constexpr float LN_EPS = 1e-5f;
constexpr float ALPHA = 1.4142135623730951f;
constexpr float QSCALE = 0.125f * 1.4426950408889634f;
constexpr int MOE_CH = 64;
constexpr int MOE_MAXT = 264;
constexpr int MOE_NCH = 5;

constexpr size_t MiB = 1u << 20;
constexpr size_t WS_CTL = 0, CTL_ZERO_BYTES = 1 * MiB;
constexpr size_t WS_ROPE = 1 * MiB;
constexpr size_t WS_MISC = 2 * MiB;
constexpr size_t WS_SEL = 3 * MiB;
constexpr size_t WS_SDST = 4 * MiB;
constexpr size_t WS_SW = 5 * MiB;
constexpr size_t WS_KVC = 6 * MiB;
constexpr size_t WS_CPART = 8 * MiB;
constexpr size_t WS_GATES = 40 * MiB;
constexpr size_t W_POOL = 48 * MiB, W_FGU = 49 * MiB, W_FDN = 60 * MiB, W_IN = 66 * MiB, W_C1 = 72 * MiB, W_OUT = 74 * MiB, W_MGU = 76 * MiB, W_MDN = 188 * MiB;
constexpr size_t WS_R0 = 256 * MiB;
constexpr size_t WS_XB = 384 * MiB;
constexpr size_t WS_BIG = 448 * MiB;
constexpr size_t WS_APOOL = WS_BIG, WS_H1 = 512 * MiB;
constexpr size_t WS_Q = WS_BIG, WS_KV6 = 512 * MiB, WS_AO = 616 * MiB;
constexpr size_t WS_XS = WS_BIG, WS_H2 = 580 * MiB, WS_Y = 692 * MiB;
constexpr size_t WS_END = 820 * MiB;
constexpr size_t KV6_STRIDE = (size_t)T * 256;
static_assert(W_MGU + (size_t)NE * 2 * DFE * D * 2 <= W_MDN && W_MDN + (size_t)NE * D * DFE * 2 <= WS_R0, "weights map");
static_assert(WS_H1 + (size_t)T * DFF * 2 <= WS_END && WS_XS + (size_t)MOE_MAXT * 256 * D * 2 <= WS_H2 && WS_H2 + (size_t)MOE_CH * 256 * DFE * 2 <= WS_Y && WS_Y + (size_t)T * 2 * D * 2 <= WS_END, "big map");
constexpr int CW_TMO = 0, CW_BAR = 4096;
constexpr int N_BAR_REGIONS = 28;

constexpr int RING_OFF = 0, RING_BYTES = 131072;
constexpr int LDSCTL_OFF = RING_BYTES, MISC_OFF = LDSCTL_OFF + 320;
constexpr int PTR_OFF = RING_BYTES + 512;
constexpr int MOET_OFF = RING_BYTES + 1024;
constexpr int LDS_BYTES = 147456;

#define GAS __attribute__((address_space(1)))
#define LAS __attribute__((address_space(3)))
typedef unsigned short bf16;
typedef unsigned v4u __attribute__((ext_vector_type(4)));
typedef unsigned v2u __attribute__((ext_vector_type(2)));
typedef float f32x4 __attribute__((ext_vector_type(4)));
typedef float f32x2 __attribute__((ext_vector_type(2)));
typedef short bf16x8 __attribute__((ext_vector_type(8)));
typedef GAS unsigned gu32;
#define RLX_AGENT __ATOMIC_RELAXED, __HIP_MEMORY_SCOPE_AGENT
#define LDS_WAIT() asm volatile("s_waitcnt lgkmcnt(0)" ::: "memory")
#define VM_WAIT() asm volatile("s_waitcnt vmcnt(0)" ::: "memory")
__device__ __forceinline__ unsigned f2bf(float f) { unsigned u = __builtin_bit_cast(unsigned, f); return (u + 0x7fffu + ((u >> 16) & 1u)) >> 16; }
__device__ __forceinline__ unsigned pk2(float lo, float hi) { return f2bf(lo) | (f2bf(hi) << 16); }
__device__ __forceinline__ float bf2f(unsigned h) { return __builtin_bit_cast(float, h << 16); }

#define XB_TMO      128
#define XB_XCNT(j)  (256  + 64 * (j))
#define XB_XSUB(j)  (1280 + 64 * (j))
#define XB_XGEN(j)  (2304 + 64 * (j))
#define XB_TOP      3328
#define XB_TOPGEN   3392
#define XCD_BAR_WORDS 3456
#define XB_SPIN_CAP (1u << 18)
__device__ __forceinline__ unsigned xb_ld(unsigned* p)              { return __hip_atomic_load(p, __ATOMIC_RELAXED, __HIP_MEMORY_SCOPE_AGENT); }
__device__ __forceinline__ unsigned xb_add(unsigned* p, unsigned v) { return __hip_atomic_fetch_add(p, v, __ATOMIC_RELAXED, __HIP_MEMORY_SCOPE_AGENT); }
__device__ __forceinline__ unsigned xb_xcc_id() { return (unsigned)__builtin_amdgcn_s_getreg((3 << 11) | 20) & 0xFu; }
#define XB_SPIN(cond, bar) do { unsigned _sp = 0; while (cond) { __builtin_amdgcn_s_sleep(1); \
    if ((++_sp & 255u) == 0u) { if (xb_ld(&(bar)[XB_TMO])) break; if (_sp > XB_SPIN_CAP) { atomicAdd(&(bar)[XB_TMO], 1u); break; } } } } while (0)
struct XcdBarrier { unsigned* bar; unsigned x; volatile LAS unsigned* st; };
__device__ __forceinline__ XcdBarrier xcd_barrier_post(unsigned* bar, volatile LAS unsigned* st) {
    XcdBarrier b; b.bar = bar; b.x = xb_xcc_id(); b.st = st;
    if (threadIdx.x == 0) (void)xb_add(&bar[XB_XCNT(b.x)], 1u);
    return b;
}
__device__ __forceinline__ void xcd_barrier_complete(unsigned* bar, unsigned x, unsigned& nloc, unsigned& nx) {
    const unsigned G = gridDim.x * gridDim.y * gridDim.z;
    unsigned sum, cnt, mine, sp = 0u;
    for (;;) {
        sum = 0u; cnt = 0u; mine = 0u;
#pragma unroll
        for (unsigned j = 0; j < 16; ++j) { const unsigned c = xb_ld(&bar[XB_XCNT(j)]); sum += c; cnt += (c > 0u) ? 1u : 0u; mine = (j == x) ? c : mine; }
        if (sum == G) break;
        __builtin_amdgcn_s_sleep(1);
        if ((++sp & 255u) == 0u) { if (xb_ld(&bar[XB_TMO])) break; if (sp > XB_SPIN_CAP) { atomicAdd(&bar[XB_TMO], 1u); break; } }
    }
    nloc = mine > 0u ? mine : 1u; nx = cnt > 0u ? cnt : 1u;
}
__device__ __forceinline__ void xcd_barrier(const XcdBarrier& b) {
    asm volatile("s_waitcnt vmcnt(0)" ::: "memory");
    __syncthreads();
    if (threadIdx.x == 0) {
        unsigned* bar = b.bar;
        __builtin_amdgcn_s_waitcnt(0);
        unsigned nloc = b.st[0], nx = b.st[1];
        if (nloc == 0u) { xcd_barrier_complete(bar, b.x, nloc, nx); b.st[0] = nloc; b.st[1] = nx; }
        const unsigned old = xb_add(&bar[XB_XSUB(b.x)], 1u);
        const unsigned gen = old / nloc;
        if (old + 1u == (gen + 1u) * nloc) {
            __builtin_amdgcn_fence(__ATOMIC_RELEASE, "agent");
            asm volatile("s_waitcnt vmcnt(0)" ::: "memory");
            const unsigned og = xb_add(&bar[XB_TOP], 1u);
            const unsigned tg = og / nx;
            if (og + 1u == (tg + 1u) * nx) xb_add(&bar[XB_TOPGEN], 1u);
            else XB_SPIN(xb_ld(&bar[XB_TOPGEN]) == tg, bar);
            __builtin_amdgcn_fence(__ATOMIC_ACQUIRE, "agent");
            xb_add(&bar[XB_XGEN(b.x)], 1u);
            asm volatile("s_waitcnt vmcnt(0)" ::: "memory");
        } else {
            XB_SPIN(xb_ld(&bar[XB_XGEN(b.x)]) == gen, bar);
            __builtin_amdgcn_fence(__ATOMIC_ACQUIRE, "agent");
            asm volatile("s_waitcnt vmcnt(0)" ::: "memory");
        }
    }
    __syncthreads();
}

struct Frame {
    LAS unsigned char* lds;
    volatile LAS unsigned* MISC;
    gu32* ctl;
    unsigned char* ws;
    int tid, lane, wave;
    int vcu, G;
    float* out;
    __device__ __forceinline__ const float* inp(int i) const {
        const unsigned long long v = ((const LAS unsigned long long*)(lds + PTR_OFF))[i];
        const unsigned lo = __builtin_amdgcn_readfirstlane((unsigned)v), hi = __builtin_amdgcn_readfirstlane((unsigned)(v >> 32));
        return (const float*)(((unsigned long long)hi << 32) | lo); }
};
enum { I_X = 0, I_LNG, I_LNB, I_POOLW, I_POOLS, I_WIN, I_PEK, I_W1K, I_W2K, I_PEV, I_W1V, I_W2V, I_WOUT, I_FGU, I_FDN, I_ROUTER, I_MGU, I_MDN };

__device__ __forceinline__ void refresh(Frame& F) { int t = threadIdx.x; asm volatile("" : "+v"(t)); F.tid = t; F.lane = t & 63; F.wave = __builtin_amdgcn_readfirstlane(t >> 6); }
__device__ __forceinline__ float wave_sum(float v) {
#pragma unroll
    for (int o = 1; o < 64; o <<= 1) v += __shfl_xor(v, o);
    return v;
}
__device__ __forceinline__ float silu_f(float x) { return x * __builtin_amdgcn_rcpf(1.0f + __builtin_amdgcn_exp2f(-1.4426950408889634f * x)); }

template <int MODE> __device__ __forceinline__ int wrow_map(int n, int Npad) {
    if (MODE == 0) return n;
    if (MODE == 1) { const int half = Npad >> 1; return n < half ? ((n >> 7) << 8) + (n & 127) : (((n - half) >> 7) << 8) + 128 + ((n - half) & 127); }
    const int tile = n >> 8, o = n & 255, head = o >> 6, hf = (o >> 5) & 1, i = o & 31;
    return (tile << 8) + 128 * (head >> 1) + 32 * (2 * (head & 1) + (i >> 4)) + 16 * hf + (i & 15);
}
template <int MODE> __device__ __forceinline__ void p0_transpose_item(const float* W, int K, int Nreal, int Npad, bf16* WT, LAS float* scr, int item, int lane) {
    const int nblk = Npad / 32, kb = item / nblk, nb = item % nblk, k0 = 64 * kb, n0 = 32 * nb;
    const int nn = n0 + (lane & 31); const bool ok = nn < Nreal;
#pragma unroll 8
    for (int i = 0; i < 32; ++i) { const int kk = 2 * i + (lane >> 5); scr[kk * 33 + (lane & 31)] = ok ? W[(size_t)(k0 + kk) * Nreal + nn] : 0.f; }
    LDS_WAIT(); asm volatile("" ::: "memory");
    const int c = lane & 7;
#pragma unroll
    for (int j = 0; j < 4; ++j) { const int n = (lane >> 3) + 8 * j; const LAS float* s = scr + (8 * c) * 33 + n;
        v4u o; o.x = pk2(s[0 * 33], s[1 * 33]); o.y = pk2(s[2 * 33], s[3 * 33]); o.z = pk2(s[4 * 33], s[5 * 33]); o.w = pk2(s[6 * 33], s[7 * 33]);
        *(GAS v4u*)(WT + (size_t)wrow_map<MODE>(n0 + n, Npad) * K + k0 + 8 * c) = o; }
    LDS_WAIT(); asm volatile("" ::: "memory");
}

__device__ __forceinline__ void p0_pool_operand(Frame& F) {
    const float* x = F.inp(I_X); bf16* AP = (bf16*)(F.ws + WS_APOOL);
    LAS f32x4* tile = (LAS f32x4*)(F.lds + RING_OFF);
    for (int unit = F.vcu; unit < (T / 64) * 4; unit += F.G) {
        const int rb = unit >> 2, g = unit & 3, w = 2 << g, t0 = rb * 64, s0 = t0 & (SEQ - 1);
        const int halo = (w - 1) < s0 ? (w - 1) : s0;
        __syncthreads();
        for (int idx = F.tid; idx < (64 + halo) * 64; idx += NWAVES * 64) { const int row = idx >> 6, c4 = idx & 63;
            tile[row * 64 + c4] = *(const GAS f32x4*)(x + (size_t)(t0 - halo + row) * D + g * 256 + c4 * 4); }
        __syncthreads();
#pragma unroll 2
        for (int k = 0; k < 8; ++k) { const int o = F.tid + k * 512, r = o >> 6, c4 = o & 63, s = s0 + r;
            const int cnt = (s + 1) < w ? (s + 1) : w;
            f32x4 sum = (f32x4){0.f, 0.f, 0.f, 0.f};
            for (int j = 0; j < cnt; ++j) sum += tile[(halo + r - j) * 64 + c4];
            const f32x4 cur = tile[(halo + r) * 64 + c4]; const float fc = (float)cnt;
            const f32x4 v = (f32x4){sum.x / fc, sum.y / fc, sum.z / fc, sum.w / fc} - cur;
            v2u pk; pk.x = pk2(v.x, v.y); pk.y = pk2(v.z, v.w);
            *(GAS v2u*)(AP + (size_t)(t0 + r) * D + g * 256 + c4 * 4) = pk; }
    }
    __syncthreads();
}

__device__ __forceinline__ void p0_prologue(Frame& F) {
    const int gw = F.vcu * NWAVES + F.wave, NGW = F.G * NWAVES;
    { float* rc = (float*)(F.ws + WS_ROPE); float* rs = rc + SEQ * 32;
      for (int idx = F.vcu * 512 + F.tid; idx < SEQ * 32; idx += F.G * 512) { const int pos = idx >> 5, i = idx & 31;
          const float fr = powf(10000.0f, -(float)i / 32.0f);
          const double ang = (double)((float)pos * fr);
          const double k = __builtin_rint(ang * 0.15915494309189535); const double r = ang - k * 6.283185307179586476925287, r2 = r * r;
          double sn = 1.0, cs = 1.0;
#pragma unroll
          for (int q = 12; q >= 1; --q) { sn = 1.0 - r2 / (double)((2 * q) * (2 * q + 1)) * sn; cs = 1.0 - r2 / (double)((2 * q - 1) * (2 * q)) * cs; }
          rc[idx] = (float)cs; rs[idx] = (float)(r * sn); } }
    if (F.vcu < 2) { const float* pe = F.inp(F.vcu == 0 ? I_PEK : I_PEV); const float* w1 = F.inp(F.vcu == 0 ? I_W1K : I_W1V);
        LAS float* red = (LAS float*)(F.lds + RING_OFF + 98304);
        const int c = F.tid & 127, ks = F.tid >> 7; float s = 0.f;
        for (int r = ks * 512; r < ks * 512 + 512; ++r) s += pe[r] * w1[(size_t)r * 128 + c];
        red[ks * 128 + c] = s; __syncthreads();
        if (F.tid < 128) ((float*)(F.ws + WS_MISC))[F.vcu * 128 + F.tid] = (red[F.tid] + red[128 + F.tid]) + (red[256 + F.tid] + red[384 + F.tid]);
        __syncthreads(); }
    p0_pool_operand(F);
    LAS float* scr = (LAS float*)(F.lds + RING_OFF + F.wave * 16384);
    unsigned char* ws = F.ws;
    constexpr int I_P = 4 * 8, I_FG = (D / 64) * (2 * DFF / 32), I_FD = (DFF / 64) * (D / 32), I_IN = (D / 64) * (INP_PAD / 32), I_C1 = (2048 / 64) * (256 / 32), I_WO = (D / 64) * (D / 32);
    constexpr int I_MG = (D / 64) * (2 * DFE / 32), I_MD = (DFE / 64) * (D / 32);
    constexpr int NITEMS = 4 * I_P + I_FG + I_FD + I_IN + 2 * I_C1 + I_WO + NE * I_MG + NE * I_MD;
    for (int it = gw; it < NITEMS; it += NGW) {
        int r = it;
        if (r < 4 * I_P) { const int g = r / I_P; p0_transpose_item<0>(F.inp(I_POOLW) + (size_t)g * 65536, 256, 256, 256, (bf16*)(ws + W_POOL) + (size_t)g * 65536, scr, r % I_P, F.lane); continue; } r -= 4 * I_P;
        if (r < I_FG) { p0_transpose_item<1>(F.inp(I_FGU), D, 2 * DFF, 2 * DFF, (bf16*)(ws + W_FGU), scr, r, F.lane); continue; } r -= I_FG;
        if (r < I_FD) { p0_transpose_item<0>(F.inp(I_FDN), DFF, D, D, (bf16*)(ws + W_FDN), scr, r, F.lane); continue; } r -= I_FD;
        if (r < I_IN) { p0_transpose_item<2>(F.inp(I_WIN), D, INP, INP_PAD, (bf16*)(ws + W_IN), scr, r, F.lane); continue; } r -= I_IN;
        if (r < 2 * I_C1) { const int kv = r / I_C1; p0_transpose_item<0>(F.inp(kv ? I_W1V : I_W1K), 2048, 128, 256, (bf16*)(ws + W_C1) + (size_t)kv * 256 * 2048, scr, r % I_C1, F.lane); continue; } r -= 2 * I_C1;
        if (r < I_WO) { p0_transpose_item<0>(F.inp(I_WOUT), D, D, D, (bf16*)(ws + W_OUT), scr, r, F.lane); continue; } r -= I_WO;
        if (r < NE * I_MG) { const int e = r / I_MG; p0_transpose_item<1>(F.inp(I_MGU) + (size_t)e * D * 2 * DFE, D, 2 * DFE, 2 * DFE, (bf16*)(ws + W_MGU) + (size_t)e * 2 * DFE * D, scr, r % I_MG, F.lane); continue; } r -= NE * I_MG;
        { const int e = r / I_MD; p0_transpose_item<0>(F.inp(I_MDN) + (size_t)e * DFE * D, DFE, D, D, (bf16*)(ws + W_MDN) + (size_t)e * D * DFE, scr, r % I_MD, F.lane); }
    }
}

__device__ __forceinline__ void ln_phase(Frame& F, const float* src, const float* gam, const float* bet, float* dstf, bf16* dstb) {
    const int gw = F.vcu * NWAVES + F.wave, NGW = F.G * NWAVES;
    f32x4 gv[4], bv[4];
#pragma unroll
    for (int j = 0; j < 4; ++j) { gv[j] = *((const GAS f32x4*)gam + F.lane + 64 * j); bv[j] = *((const GAS f32x4*)bet + F.lane + 64 * j); }
    for (int m = gw; m < T; m += NGW) {
        const GAS f32x4* xr = (const GAS f32x4*)(src + (size_t)m * D) + F.lane;
        f32x4 v[4]; float s = 0.f;
#pragma unroll
        for (int j = 0; j < 4; ++j) { v[j] = xr[64 * j]; s += (v[j].x + v[j].y) + (v[j].z + v[j].w); }
        const float mean = wave_sum(s) * (1.f / D); float s2 = 0.f;
#pragma unroll
        for (int j = 0; j < 4; ++j) { v[j] = v[j] - mean; s2 += (v[j].x * v[j].x + v[j].y * v[j].y) + (v[j].z * v[j].z + v[j].w * v[j].w); }
        const float rstd = 1.f / sqrtf(wave_sum(s2) * (1.f / D) + LN_EPS);
        GAS f32x4* of = (GAS f32x4*)(dstf + (size_t)m * D) + F.lane;
#pragma unroll
        for (int j = 0; j < 4; ++j) { v[j] = v[j] * rstd * gv[j] + bv[j]; of[64 * j] = v[j]; }
        if (dstb) { GAS v2u* ob = (GAS v2u*)(dstb + (size_t)m * D) + F.lane;
#pragma unroll
            for (int j = 0; j < 4; ++j) { v2u pk; pk.x = pk2(v[j].x, v[j].y); pk.y = pk2(v[j].z, v[j].w); ob[64 * j] = pk; } }
    }
}

__device__ __forceinline__ void ln_router_phase(Frame& F, float* R0, const float* gam, const float* bet, bf16* dstb) {
    LAS float* rt = (LAS float*)(F.lds + RING_OFF);
    LAS unsigned* cnt = (LAS unsigned*)(F.lds + RING_OFF + 32768);
    const float* router = F.inp(I_ROUTER);
    for (int idx = F.tid; idx < 8192; idx += 512) { const int c = idx >> 3, e = idx & 7; rt[e * 1024 + c] = router[idx]; }
    if (F.tid < 8) cnt[F.tid] = 0u;
    __syncthreads();
    f32x4 gv[4], bv[4];
#pragma unroll
    for (int j = 0; j < 4; ++j) { gv[j] = *((const GAS f32x4*)gam + F.lane + 64 * j); bv[j] = *((const GAS f32x4*)bet + F.lane + 64 * j); }
    int* sel = (int*)(F.ws + WS_SEL);
    for (int k = 0; k < 16; ++k) {
        const int m = F.vcu * 128 + F.wave * 16 + k;
        const GAS f32x4* xr = (const GAS f32x4*)(R0 + (size_t)m * D) + F.lane;
        f32x4 v[4]; float s = 0.f;
#pragma unroll
        for (int j = 0; j < 4; ++j) { v[j] = xr[64 * j]; s += (v[j].x + v[j].y) + (v[j].z + v[j].w); }
        const float mean = wave_sum(s) * (1.f / D); float s2 = 0.f;
#pragma unroll
        for (int j = 0; j < 4; ++j) { v[j] = v[j] - mean; s2 += (v[j].x * v[j].x + v[j].y * v[j].y) + (v[j].z * v[j].z + v[j].w * v[j].w); }
        const float rstd = 1.f / sqrtf(wave_sum(s2) * (1.f / D) + LN_EPS);
        GAS f32x4* of = (GAS f32x4*)(R0 + (size_t)m * D) + F.lane;
        GAS v2u* ob = (GAS v2u*)(dstb + (size_t)m * D) + F.lane;
#pragma unroll
        for (int j = 0; j < 4; ++j) { v[j] = v[j] * rstd * gv[j] + bv[j]; of[64 * j] = v[j]; v2u pk; pk.x = pk2(v[j].x, v[j].y); pk.y = pk2(v[j].z, v[j].w); ob[64 * j] = pk; }
        float lg[8];
#pragma unroll
        for (int e = 0; e < 8; ++e) { float a = 0.f;
#pragma unroll
            for (int j = 0; j < 4; ++j) { const f32x4 r4 = *((const LAS f32x4*)(rt + e * 1024) + F.lane + 64 * j); a += (v[j].x * r4.x + v[j].y * r4.y) + (v[j].z * r4.z + v[j].w * r4.w); }
            lg[e] = wave_sum(a); }
        int i0 = 0; float v0 = lg[0];
#pragma unroll
        for (int e = 1; e < 8; ++e) if (lg[e] > v0) { v0 = lg[e]; i0 = e; }
        int i1 = -1; float v1 = -3.0e38f;
#pragma unroll
        for (int e = 0; e < 8; ++e) if (e != i0 && lg[e] > v1) { v1 = lg[e]; i1 = e; }
        const float ex = __expf(v1 - v0), w0 = 1.0f / (1.0f + ex), w1 = ex * w0;
        if (F.lane == 0) { *(GAS v4u*)(sel + (size_t)m * 4) = (v4u){(unsigned)i0, (unsigned)i1, __builtin_bit_cast(unsigned, w0), __builtin_bit_cast(unsigned, w1)};
            __hip_atomic_fetch_add(cnt + i0, 1u, __ATOMIC_RELAXED, __HIP_MEMORY_SCOPE_WORKGROUP); __hip_atomic_fetch_add(cnt + i1, 1u, __ATOMIC_RELAXED, __HIP_MEMORY_SCOPE_WORKGROUP); }
    }
    __syncthreads();
    if (F.tid < 8) ((unsigned*)(F.ws + WS_MISC + 4096))[F.vcu * 8 + F.tid] = cnt[F.tid];
}

__device__ __forceinline__ void moe_tables(Frame& F) {
    LAS int* cw = (LAS int*)(F.lds + RING_OFF + 65536);
    LAS int* mt = (LAS int*)(F.lds + MOET_OFF);
    const int* cg = (const int*)(F.ws + WS_MISC + 4096);
    __syncthreads();
    for (int idx = F.tid; idx < 2048; idx += 512) cw[idx] = __hip_atomic_load(cg + idx, RLX_AGENT);
    __syncthreads();
    { const int e = F.wave; int a[4]; int s = 0;
#pragma unroll
      for (int k = 0; k < 4; ++k) { a[k] = cw[(4 * F.lane + k) * 8 + e]; s += a[k]; }
      int inc = s;
#pragma unroll
      for (int o = 1; o < 64; o <<= 1) { const int y = __shfl_up(inc, o); if (F.lane >= o) inc += y; }
      if (F.lane == 63) mt[e] = inc;
      if (F.lane == (F.vcu >> 2)) { const int q = F.vcu & 3; mt[16 + e] = inc - s + (q > 0 ? a[0] : 0) + (q > 1 ? a[1] : 0) + (q > 2 ? a[2] : 0); } }
    __syncthreads();
    if (F.tid == 0) { int row = 0, tile = 0;
        for (int e = 0; e < 8; ++e) { mt[8 + e] = row; const int nt = (mt[e] + 255) >> 8; for (int i = 0; i < nt; ++i) mt[32 + tile + i] = e; tile += nt; row += nt << 8; }
        mt[24] = tile; }
    __syncthreads();
}

__device__ __forceinline__ void moe_dispatch_phase(Frame& F) {
    moe_tables(F);
    LAS int* mt = (LAS int*)(F.lds + MOET_OFF);
    LAS int* wcnt = (LAS int*)(F.lds + RING_OFF);
    LAS int* plist = (LAS int*)(F.lds + RING_OFF + 1024);
    const int* sel = (const int*)(F.ws + WS_SEL);
    int* sdst = (int*)(F.ws + WS_SDST); float* sw = (float*)(F.ws + WS_SW);
    const bf16* XB = (const bf16*)(F.ws + WS_XB); bf16* XS = (bf16*)(F.ws + WS_XS);
    int e = -1, rank = 0, t = 0, kk = 0; float wgt = 0.f;
    if (F.tid < 256) { const int tl = F.tid >> 1; kk = F.tid & 1; t = F.vcu * 128 + tl; e = sel[(size_t)t * 4 + kk]; wgt = __builtin_bit_cast(float, sel[(size_t)t * 4 + 2 + kk]);
#pragma unroll
        for (int ee = 0; ee < 8; ++ee) { const unsigned long long mk = __ballot(e == ee); if (e == ee) rank = __popcll(mk & ((1ull << F.lane) - 1ull)); if (F.lane == 0) wcnt[F.wave * 8 + ee] = __popcll(mk); } }
    __syncthreads();
    if (F.tid < 256) { int pre = 0; for (int w = 0; w < F.wave; ++w) pre += wcnt[w * 8 + e];
        const int pos = mt[8 + e] + mt[16 + e] + pre + rank;
        sdst[pos] = t * 2 + kk; sw[pos] = wgt; plist[F.tid] = pos; plist[256 + F.tid] = t; }
    __syncthreads();
    for (int q = F.wave * 32; q < F.wave * 32 + 32; ++q) { const int pos = plist[q], tt = plist[256 + q];
        const GAS v4u* s = (const GAS v4u*)(XB + (size_t)tt * D) + F.lane; GAS v4u* d = (GAS v4u*)(XS + (size_t)pos * D) + F.lane;
        const v4u a = s[0], b = s[64]; d[0] = a; d[64] = b; }
    if (F.vcu < 8) { const int ee = F.vcu, lo = mt[8 + ee] + mt[ee], hi = mt[8 + ee] + (((mt[ee] + 255) >> 8) << 8);
        for (int r = lo + F.wave; r < hi; r += NWAVES) { GAS v4u* d = (GAS v4u*)(XS + (size_t)r * D) + F.lane; d[0] = (v4u){0u, 0u, 0u, 0u}; d[64] = (v4u){0u, 0u, 0u, 0u}; if (F.lane == 0) { sdst[r] = -1; sw[r] = 0.f; } } }
}

__device__ __forceinline__ void final_phase(Frame& F, const float* R0, const float* gam, const float* bet, float* out) {
    const int gw = F.vcu * NWAVES + F.wave, NGW = F.G * NWAVES;
    const bf16* Y = (const bf16*)(F.ws + WS_Y);
    f32x4 gv[4], bv[4];
#pragma unroll
    for (int j = 0; j < 4; ++j) { gv[j] = *((const GAS f32x4*)gam + F.lane + 64 * j); bv[j] = *((const GAS f32x4*)bet + F.lane + 64 * j); }
    for (int m = gw; m < T; m += NGW) {
        const GAS f32x4* xr = (const GAS f32x4*)(R0 + (size_t)m * D) + F.lane;
        const GAS v2u* y0 = (const GAS v2u*)(Y + (size_t)m * 2 * D) + F.lane; const GAS v2u* y1 = y0 + 256;
        f32x4 v[4]; float s = 0.f;
#pragma unroll
        for (int j = 0; j < 4; ++j) { const v2u a = y0[64 * j], b = y1[64 * j]; v[j] = xr[64 * j] * ALPHA;
            v[j].x += bf2f(a.x & 0xffffu) + bf2f(b.x & 0xffffu); v[j].y += bf2f(a.x >> 16) + bf2f(b.x >> 16); v[j].z += bf2f(a.y & 0xffffu) + bf2f(b.y & 0xffffu); v[j].w += bf2f(a.y >> 16) + bf2f(b.y >> 16);
            s += (v[j].x + v[j].y) + (v[j].z + v[j].w); }
        const float mean = wave_sum(s) * (1.f / D); float s2 = 0.f;
#pragma unroll
        for (int j = 0; j < 4; ++j) { v[j] = v[j] - mean; s2 += (v[j].x * v[j].x + v[j].y * v[j].y) + (v[j].z * v[j].z + v[j].w * v[j].w); }
        const float rstd = 1.f / sqrtf(wave_sum(s2) * (1.f / D) + LN_EPS);
        GAS f32x4* of = (GAS f32x4*)(out + (size_t)m * D) + F.lane;
#pragma unroll
        for (int j = 0; j < 4; ++j) of[64 * j] = v[j] * rstd * gv[j] + bv[j];
    }
}

namespace ep {
using pg8::f32x4; using pg8::Unit; using pg8::u32x4; using pg8::u32x2; using pg8::cvt_pk_bf16;
constexpr int HALF = 128;

struct DenseOrder { int nM, nN, G, c; size_t astep, bstep;
    __device__ __forceinline__ bool next(int i, Unit& u) const { const long L = (long)i * G + c; if (L >= (long)nM * nN) return false;
        pg8::order_tile((int)L, nM, nN, u.pm, u.pn); u.aoff = (size_t)u.pm * astep; u.boff = (size_t)u.pn * bstep; return true; } };
struct PoolOrder { int G, c;
    __device__ __forceinline__ bool next(int i, Unit& u) const { const long L = (long)i * G + c; if (L >= (T / 256) * 4) return false;
        pg8::order_tile((int)L, T / 256, 4, u.pm, u.pn); u.aoff = (size_t)u.pm * 256 * D * 2 + (size_t)u.pn * 512; u.boff = (size_t)u.pn * 256 * 256 * 2; return true; } };
struct CmpOrder { int G, c;
    __device__ __forceinline__ bool next(int i, Unit& u) const { const long L = (long)i * G + c; if (L >= 256) return false;
        const int kv = (int)L >> 7, bg = ((int)L >> 2) & 31, kq = (int)L & 3; u.pm = bg; u.pn = kv * 4 + kq;
        u.aoff = ((size_t)kv * KV6_STRIDE + (size_t)bg * SEQ * 64 + (size_t)kq * 512) * 2; u.boff = ((size_t)kv * 256 * 2048 + (size_t)kq * 512) * 2; return true; } };
template <int NN> struct MoeOrder { int nM, G, c, tile0; const LAS int* tile_e; size_t a_tile, b_exp, b_tile; bool a_local;
    __device__ __forceinline__ bool next(int i, Unit& u) const { const int L = i * G + c; if (L >= nM * NN) return false;
        const int pml = L / NN; u.pn = L % NN; u.pm = tile0 + pml; const int e = __builtin_amdgcn_readfirstlane(tile_e[u.pm]);
        u.aoff = (size_t)(a_local ? pml : u.pm) * a_tile; u.boff = (size_t)e * b_exp + (size_t)u.pn * b_tile; return true; } };

struct EpiPool { static constexpr bool PERM = false; const float* x; const float* scale; float* out;
    __device__ __forceinline__ void operator()(const f32x4 (&acc)[2][2][4][2], const Unit& u, int wr, int wc, int fr, int fq) const {
        const int col0 = u.pn * 256 + wc * 32 + 4 * fq;
#pragma unroll
        for (int bj = 0; bj < 2; ++bj)
#pragma unroll
            for (int n = 0; n < 2; ++n) { const f32x4 sc = *(const f32x4*)(scale + col0 + bj * HALF + n * 16);
#pragma unroll
                for (int ai = 0; ai < 2; ++ai) {
#pragma unroll
                    for (int m = 0; m < 4; ++m) { const size_t off = (size_t)(u.pm * 256 + ai * HALF + wr * 64 + m * 16 + fr) * D + col0 + bj * HALF + n * 16;
                        const f32x4 xv = *(const f32x4*)(x + off); *(f32x4*)(out + off) = xv * ALPHA + acc[ai][bj][m][n] * sc; }
                    asm volatile("" ::: "memory"); } }
    } };
struct EpiResid { static constexpr bool PERM = false; float* R;
    __device__ __forceinline__ void operator()(const f32x4 (&acc)[2][2][4][2], const Unit& u, int wr, int wc, int fr, int fq) const {
        const int col0 = u.pn * 256 + wc * 32 + 4 * fq;
#pragma unroll
        for (int ai = 0; ai < 2; ++ai)
#pragma unroll
            for (int m = 0; m < 4; ++m) { const size_t off = (size_t)(u.pm * 256 + ai * HALF + wr * 64 + m * 16 + fr) * D + col0;
#pragma unroll
                for (int bj = 0; bj < 2; ++bj)
#pragma unroll
                    for (int n = 0; n < 2; ++n) { float* p = R + off + bj * HALF + n * 16; const f32x4 xv = *(const f32x4*)p; *(f32x4*)p = xv * ALPHA + acc[ai][bj][m][n]; }
                if (m & 1) asm volatile("" ::: "memory"); }
    } };
struct EpiSwiGLU { static constexpr bool PERM = true; bf16* O; int ldc; int pm0;
    __device__ __forceinline__ void operator()(const f32x4 (&acc)[2][2][4][2], const Unit& u, int wr, int wc, int fr, int fq) const {
        const int col0 = u.pn * 128 + wc * 32 + 8 * fq;
#pragma unroll
        for (int ai = 0; ai < 2; ++ai)
#pragma unroll
            for (int m = 0; m < 4; ++m) { bf16* rowp = O + (size_t)((u.pm - pm0) * 256 + ai * HALF + wr * 64 + m * 16 + fr) * ldc + col0;
                const f32x4 g0 = acc[ai][0][m][0], g1 = acc[ai][0][m][1], u0 = acc[ai][1][m][0], u1 = acc[ai][1][m][1];
                u32x4 w; w.x = cvt_pk_bf16(silu_f(g0[0]) * u0[0], silu_f(g0[1]) * u0[1]); w.y = cvt_pk_bf16(silu_f(g0[2]) * u0[2], silu_f(g0[3]) * u0[3]);
                w.z = cvt_pk_bf16(silu_f(g1[0]) * u1[0], silu_f(g1[1]) * u1[1]); w.w = cvt_pk_bf16(silu_f(g1[2]) * u1[2], silu_f(g1[3]) * u1[3]);
                *(u32x4*)rowp = w; }
    } };
struct EpiMoeDown { static constexpr bool PERM = true; bf16* Y; const int* sdst; const float* sw;
    __device__ __forceinline__ void operator()(const f32x4 (&acc)[2][2][4][2], const Unit& u, int wr, int wc, int fr, int fq) const {
        const int col0 = u.pn * 256 + wc * 32 + 8 * fq;
#pragma unroll
        for (int ai = 0; ai < 2; ++ai)
#pragma unroll
            for (int m = 0; m < 4; ++m) { const int sr = u.pm * 256 + ai * HALF + wr * 64 + m * 16 + fr; const int d = sdst[sr]; const float w = sw[sr];
                if (d >= 0) { bf16* rowp = Y + (size_t)d * D + col0;
#pragma unroll
                    for (int bj = 0; bj < 2; ++bj) { const f32x4 v0 = acc[ai][bj][m][0] * w, v1 = acc[ai][bj][m][1] * w;
                        u32x4 o; o.x = cvt_pk_bf16(v0[0], v0[1]); o.y = cvt_pk_bf16(v0[2], v0[3]); o.z = cvt_pk_bf16(v1[0], v1[1]); o.w = cvt_pk_bf16(v1[2], v1[3]);
                        *(u32x4*)(rowp + bj * HALF) = o; } } }
    } };
struct EpiCPart { static constexpr bool PERM = false; float* part;
    __device__ __forceinline__ void operator()(const f32x4 (&acc)[2][2][4][2], const Unit& u, int wr, int wc, int fr, int fq) const {
        const int col0 = wc * 32 + 4 * fq;
#pragma unroll
        for (int ai = 0; ai < 2; ++ai)
#pragma unroll
            for (int m = 0; m < 4; ++m) { float* rowp = part + ((size_t)u.pn * 8192 + u.pm * 256 + ai * HALF + wr * 64 + m * 16 + fr) * 128 + col0;
#pragma unroll
                for (int n = 0; n < 2; ++n) *(f32x4*)(rowp + n * 16) = acc[ai][0][m][n]; }
    } };
struct EpiInProj { static constexpr bool PERM = false; bf16* Q; bf16* KV6; float* gates; const float* rc; const float* rs;
    __device__ __forceinline__ void operator()(const f32x4 (&acc)[2][2][4][2], const Unit& u, int wr, int wc, int fr, int fq) const {
        const int pn = u.pn, i0 = 16 * (wc & 1) + 4 * fq;
        const bool rope = (pn < 4) || pn == 6 || pn == 8;
#pragma unroll
        for (int ai = 0; ai < 2; ++ai)
#pragma unroll
            for (int m = 0; m < 4; ++m) { const int row = u.pm * 256 + ai * HALF + wr * 64 + m * 16 + fr, pos = row & (SEQ - 1), bb = row >> 12;
                f32x4 cs = (f32x4){1.f, 1.f, 1.f, 1.f}, sn = (f32x4){0.f, 0.f, 0.f, 0.f};
                if (rope) { cs = *(const f32x4*)(rc + pos * 32 + i0); sn = *(const f32x4*)(rs + pos * 32 + i0); }
#pragma unroll
                for (int bj = 0; bj < 2; ++bj) { const int head = 2 * bj + (wc >> 1); const f32x4 x1 = acc[ai][bj][m][0], x2 = acc[ai][bj][m][1];
                    if (pn == 10) { if (head == 0) { float* gp = gates + (size_t)row * 48 + i0;
                            f32x4 s1; for (int j = 0; j < 4; ++j) s1[j] = 1.0f / (1.0f + __expf(-x1[j])); *(f32x4*)gp = s1;
                            if (i0 < 16) { f32x4 s2; for (int j = 0; j < 4; ++j) s2[j] = 1.0f / (1.0f + __expf(-x2[j])); *(f32x4*)(gp + 32) = s2; } } }
                    else { f32x4 o1 = x1 * cs - x2 * sn, o2 = x1 * sn + x2 * cs; bf16* dst;
                        if (pn < 4) { o1 = o1 * QSCALE; o2 = o2 * QSCALE; dst = Q + (size_t)row * D + (4 * pn + head) * 64 + i0; }
                        else dst = KV6 + (size_t)(pn - 4) * KV6_STRIDE + ((size_t)(bb * 4 + head) * SEQ + pos) * 64 + i0;
                        u32x2 a, b; a.x = cvt_pk_bf16(o1[0], o1[1]); a.y = cvt_pk_bf16(o1[2], o1[3]); b.x = cvt_pk_bf16(o2[0], o2[1]); b.y = cvt_pk_bf16(o2[2], o2[3]);
                        *(u32x2*)dst = a; *(u32x2*)(dst + 32) = b; } } }
    } };
}

__device__ __forceinline__ void compress_finish_phase(Frame& F) {
    LAS float* w2s = (LAS float*)(F.lds + RING_OFF);
    for (int idx = F.tid; idx < 2 * 8192; idx += 512) w2s[idx] = F.inp(idx < 8192 ? I_W2K : I_W2V)[idx & 8191];
    __syncthreads();
    const float* part = (const float*)(F.ws + WS_CPART); const float* cb = (const float*)(F.ws + WS_MISC);
    const float* rc = (const float*)(F.ws + WS_ROPE); const float* rs = rc + SEQ * 32;
    bf16* kvc = (bf16*)(F.ws + WS_KVC);
    const int gw = F.vcu * NWAVES + F.wave, NGW = F.G * NWAVES;
    for (int row = gw; row < 2 * 32 * 256; row += NGW) {
        const int kv = row >> 13, r = row & 8191, n = r & 255;
        bf16* dst = kvc + (size_t)row * 64 + F.lane;
        if (n == 255) { *dst = 0; continue; }
        float h0 = cb[kv * 128 + F.lane], h1 = cb[kv * 128 + 64 + F.lane];
#pragma unroll
        for (int q = 0; q < 4; ++q) { const float* p = part + ((size_t)(kv * 4 + q) * 8192 + r) * 128; h0 += p[F.lane]; h1 += p[64 + F.lane]; }
        h0 = silu_f(h0); h1 = silu_f(h1);
        const LAS float* w2 = w2s + kv * 8192 + F.lane; float o = 0.f;
#pragma unroll
        for (int c = 0; c < 64; ++c) o += __builtin_bit_cast(float, __builtin_amdgcn_readlane(__builtin_bit_cast(int, h0), c)) * w2[c * 64];
#pragma unroll
        for (int c = 0; c < 64; ++c) o += __builtin_bit_cast(float, __builtin_amdgcn_readlane(__builtin_bit_cast(int, h1), c)) * w2[(64 + c) * 64];
        if (kv == 0) { const int pos = 16 * n + 31, i = F.lane & 31; const float other = __shfl_xor(o, 32), cs = rc[pos * 32 + i], sn = rs[pos * 32 + i];
            o = (F.lane < 32) ? o * cs - other * sn : other * sn + o * cs; }
        *dst = (bf16)f2bf(o);
    }
    __syncthreads();
}

namespace att {
using f32x16 = __attribute__((ext_vector_type(16))) float;
using s16x4 = __attribute__((ext_vector_type(4))) short;
constexpr int SLOTB = 8192;
constexpr int LDS_K = 0, LDS_V = 2 * SLOTB, LDS_WS = 4 * SLOTB, LDS_OST = LDS_WS + NWAVES * 256, OSTR = 72  , LDS_IMP = LDS_OST + NWAVES * 32 * OSTR * 4, LDS_SM = LDS_IMP + NWAVES * 2048, LDS_END = LDS_SM + NWAVES * 64;
static_assert(LDS_END <= RING_BYTES, "attention LDS");
__device__ __forceinline__ int crow(int r, int hi) { return (r & 3) + 8 * (r >> 2) + 4 * hi; }
__device__ __forceinline__ float max3f(float a, float b, float c) { float r; asm("v_max3_f32 %0, %1, %2, %3" : "=v"(r) : "v"(a), "v"(b), "v"(c)); return r; }
__device__ __forceinline__ unsigned cvtpk(float lo, float hi) { unsigned r; asm("v_cvt_pk_bf16_f32 %0, %1, %2" : "=v"(r) : "v"(lo), "v"(hi)); return r; }
typedef short v4i16_t __attribute__((ext_vector_type(4)));
#define ATT_WAIT_BAR(N) asm volatile("s_waitcnt vmcnt(" #N ") lgkmcnt(0)\n\ts_barrier" ::: "memory")
#define ATT_LGKM_BAR() asm volatile("s_waitcnt lgkmcnt(0)\n\ts_barrier" ::: "memory")

__device__ __forceinline__ void qkt(f32x16& p0, f32x16& p1, const LAS unsigned char* Kslot, const bf16x8* qr, int r32, int hi) {
    const LAS unsigned char* kb = Kslot + hi * 1024 + r32 * 16;
    p0 = f32x16{}; p1 = f32x16{};
#pragma unroll
    for (int d0 = 0; d0 < 4; ++d0) {
        const bf16x8 b0 = *(const LAS bf16x8*)(kb + d0 * 2048), b1 = *(const LAS bf16x8*)(kb + d0 * 2048 + 512);
        p0 = __builtin_amdgcn_mfma_f32_32x32x16_bf16(b0, qr[d0], p0, 0, 0, 0); p1 = __builtin_amdgcn_mfma_f32_32x32x16_bf16(b1, qr[d0], p1, 0, 0, 0); }
}
__device__ __forceinline__ float rowmax(const f32x16& p0, const f32x16& p1) {
    float a = max3f(p0[0], p0[1], p1[0]), b = max3f(p0[2], p0[3], p1[1]); a = max3f(a, p1[2], p1[3]);
#pragma unroll
    for (int r = 4; r < 16; r += 4) { a = max3f(a, p0[r], p0[r + 1]); b = max3f(b, p0[r + 2], p0[r + 3]); a = max3f(a, p1[r], p1[r + 1]); b = max3f(b, p1[r + 2], p1[r + 3]); }
    const float m = fmaxf(a, b);
    auto rr = __builtin_amdgcn_permlane32_swap(__float_as_uint(m), __float_as_uint(m), false, false);
    return fmaxf(__uint_as_float(rr[0]), __uint_as_float(rr[1]));
}
__device__ __forceinline__ float halfswap_add(float v) { auto rr = __builtin_amdgcn_permlane32_swap(__float_as_uint(v), __float_as_uint(v), false, false); return __uint_as_float(rr[0]) + __uint_as_float(rr[1]); }
__device__ __forceinline__ void pv(f32x16* o, int vb, bf16x8 pa0, bf16x8 pa1, bf16x8 pa2, bf16x8 pa3) {
#pragma unroll
    for (int d0 = 0; d0 < 2; ++d0) { s16x4 lo[4], hi[4];
#pragma unroll
        for (int ks = 0; ks < 4; ++ks) {
            asm volatile("ds_read_b64_tr_b16 %0,%1 offset:%c2" : "=&v"(lo[ks]) : "v"(vb), "i"(d0 * 4096 + ks * 1024) : "memory");
            asm volatile("ds_read_b64_tr_b16 %0,%1 offset:%c2" : "=&v"(hi[ks]) : "v"(vb), "i"(d0 * 4096 + ks * 1024 + 512) : "memory"); }
        asm volatile("s_waitcnt lgkmcnt(0)" ::: "memory"); __builtin_amdgcn_sched_barrier(0);
#define ATT_PK(k) (bf16x8){lo[k][0], lo[k][1], lo[k][2], lo[k][3], hi[k][0], hi[k][1], hi[k][2], hi[k][3]}
        o[d0] = __builtin_amdgcn_mfma_f32_32x32x16_bf16(pa0, ATT_PK(0), o[d0], 0, 0, 0);
        o[d0] = __builtin_amdgcn_mfma_f32_32x32x16_bf16(pa1, ATT_PK(1), o[d0], 0, 0, 0);
        o[d0] = __builtin_amdgcn_mfma_f32_32x32x16_bf16(pa2, ATT_PK(2), o[d0], 0, 0, 0);
        o[d0] = __builtin_amdgcn_mfma_f32_32x32x16_bf16(pa3, ATT_PK(3), o[d0], 0, 0, 0);
#undef ATT_PK
    }
}
__device__ __forceinline__ void mask_gt(f32x16& p0, f32x16& p1, int thr, int hi) {
#pragma unroll
    for (int r = 0; r < 16; ++r) { const int kv = crow(r, hi); if (kv > thr) p0[r] = -INFINITY; if (kv + 32 > thr) p1[r] = -INFINITY; } }
__device__ __forceinline__ void mask_le(f32x16& p0, f32x16& p1, int thr, int hi) {
#pragma unroll
    for (int r = 0; r < 16; ++r) { const int kv = crow(r, hi); if (kv <= thr) p0[r] = -INFINITY; if (kv + 32 <= thr) p1[r] = -INFINITY; } }
__device__ __forceinline__ void mask_all(f32x16& p0, f32x16& p1) {
#pragma unroll
    for (int r = 0; r < 16; ++r) { p0[r] = -INFINITY; p1[r] = -INFINITY; } }

struct Ctx { LAS unsigned char* shm; int wid, lane, r32, hi; LAS float* wsf; int vb0; };

__device__ __forceinline__ void dma_k(const Ctx& c, const bf16* Kt, int slot) {
    __builtin_amdgcn_global_load_lds((const unsigned*)(Kt + c.lane * 64 + c.wid * 8), (LAS unsigned*)(c.shm + LDS_K + slot * SLOTB + c.wid * 1024), 16, 0, 0); }
__device__ __forceinline__ void dma_v(const Ctx& c, const bf16* Vt, int slot) {
    __builtin_amdgcn_global_load_lds((const unsigned*)(Vt + (16 * (c.wid & 3) + (c.lane >> 2)) * 64 + (c.wid >> 2) * 32 + (c.lane & 3) * 8), (LAS unsigned*)(c.shm + LDS_V + slot * SLOTB + c.wid * 1024), 16, 0, 0); }

__device__ __forceinline__ void p_times_v(const Ctx& c, f32x16* o, const f32x16& p0, const f32x16& p1, int slot) {
    v4u pw0 = (v4u){cvtpk(p0[0], p0[1]), cvtpk(p0[2], p0[3]), cvtpk(p0[4], p0[5]), cvtpk(p0[6], p0[7])};
    v4u pw1 = (v4u){cvtpk(p0[8], p0[9]), cvtpk(p0[10], p0[11]), cvtpk(p0[12], p0[13]), cvtpk(p0[14], p0[15])};
    v4u pw2 = (v4u){cvtpk(p1[0], p1[1]), cvtpk(p1[2], p1[3]), cvtpk(p1[4], p1[5]), cvtpk(p1[6], p1[7])};
    v4u pw3 = (v4u){cvtpk(p1[8], p1[9]), cvtpk(p1[10], p1[11]), cvtpk(p1[12], p1[13]), cvtpk(p1[14], p1[15])};
    pv(o, c.vb0 + slot * SLOTB, __builtin_bit_cast(bf16x8, pw0), __builtin_bit_cast(bf16x8, pw1), __builtin_bit_cast(bf16x8, pw2), __builtin_bit_cast(bf16x8, pw3));
}
__device__ __forceinline__ void online_step(const Ctx& c, f32x16& p0, f32x16& p1, float& m, float& l, f32x16* o, int slot) {
    const float rm = rowmax(p0, p1);
    const float mn = fmaxf(fmaxf(m, rm), -1.0e30f);
    const float f = __builtin_amdgcn_exp2f(m - mn);
    float s = 0.f;
#pragma unroll
    for (int r = 0; r < 16; ++r) { p0[r] = __builtin_amdgcn_exp2f(p0[r] - mn); p1[r] = __builtin_amdgcn_exp2f(p1[r] - mn); s += p0[r] + p1[r]; }
    l = l * f + s; m = mn;
    if (__any(f != 1.0f)) { if (c.hi == 0) c.wsf[c.r32] = f; LDS_WAIT();
#pragma unroll
        for (int r = 0; r < 16; ++r) { const float fr = c.wsf[crow(r, c.hi)]; o[0][r] *= fr; o[1][r] *= fr; }
        LDS_WAIT(); }
    p_times_v(c, o, p0, p1, slot);
}
__device__ __forceinline__ void fold_out(const Ctx& c, LAS float* outacc, const f32x16* o, float fac) {
    if (c.hi == 0) c.wsf[32 + c.r32] = fac; LDS_WAIT();
#pragma unroll
    for (int r = 0; r < 16; ++r) { const float fr = c.wsf[32 + crow(r, c.hi)]; LAS float* p = outacc + crow(r, c.hi) * OSTR + c.r32; p[0] += o[0][r] * fr; p[32] += o[1][r] * fr; }
    LDS_WAIT();
}

__device__ __forceinline__ void attn_unit(Frame& F, int b, int g, int qb) {
    Ctx c; c.shm = F.lds + RING_OFF; c.wid = F.wave; c.lane = F.lane; c.r32 = F.lane & 31; c.hi = F.lane >> 5;
    c.wsf = (LAS float*)(c.shm + LDS_WS) + c.wid * 64;
    c.vb0 = (int)(uintptr_t)(c.shm + LDS_V) + ((c.lane >> 4) & 1) * 32 + (c.lane & 3) * 8 + (4 * c.hi + ((c.lane & 15) >> 2)) * 64;
    const int tt = c.r32 & 7, hh = c.r32 >> 3, tok = 8 * c.wid + tt, t0 = 64 * qb, t = t0 + tok;
    const size_t grow = (size_t)b * SEQ + t;
    const bf16* Qp = (const bf16*)(F.ws + WS_Q) + grow * D + (4 * g + hh) * 64 + c.hi * 8;
    const bf16* KV6 = (const bf16*)(F.ws + WS_KV6) + (size_t)(b * 4 + g) * SEQ * 64;
    const bf16* KC = (const bf16*)(F.ws + WS_KVC) + (size_t)(b * 4 + g) * 256 * 64;
    VM_WAIT();
    bf16x8 qr[4];
#pragma unroll
    for (int d0 = 0; d0 < 4; ++d0) qr[d0] = *(const bf16x8*)(Qp + d0 * 16);
    const float* gp = (const float*)(F.ws + WS_GATES) + grow * 48 + (4 * g + hh) * 3;
    const float gate_c = gp[0], gate_s = gp[1], gate_w = gp[2];
    LAS float* out = (LAS float*)(c.shm + LDS_OST) + c.wid * 32 * OSTR;
#pragma unroll
    for (int k = 0; k < 32; ++k) out[k * OSTR + c.lane] = 0.f;
    LAS float* imp = (LAS float*)(c.shm + LDS_IMP) + c.wid * 512;
    LAS unsigned long long* smk = (LAS unsigned long long*)(c.shm + LDS_SM) + c.wid * 8;
    const bool need_sel = qb > 15;
    if (need_sel) {
#pragma unroll
        for (int k = 0; k < 8; ++k) imp[k * 64 + c.lane] = 0.f; }
    const int nmax = (t - 31) >> 4;
    const int nmax_min = (t0 - 31) >> 4;
    const int nct = ((4 * qb + 2) >> 6) + 1;
    const int e0 = nct, e1 = 2 * nct, e2 = e1 + qb + 1, ntot = e2 + (qb < 8 ? qb : 8) + 1;
#define ATT_ISSUE(i_, slot_) do { const int ii = (i_); const bf16 *Kt, *Vt; \
        if (ii < e1) { const int j = ii < e0 ? ii : ii - e0; Kt = KC + (size_t)j * 4096; Vt = Kt + 32 * 256 * 64; } \
        else if (ii < e2) { Kt = KV6 + 2 * KV6_STRIDE + (size_t)(ii - e1) * 4096; Vt = Kt + KV6_STRIDE; } \
        else { Kt = KV6 + 4 * KV6_STRIDE + (size_t)(qb - (ii - e2)) * 4096; Vt = Kt + KV6_STRIDE; } \
        dma_k(c, Kt, (slot_)); dma_v(c, Vt, (slot_)); } while (0)
    float m = -INFINITY, l = 0.f, inv = 0.f; f32x16 o[2]; o[0] = f32x16{}; o[1] = f32x16{};
    unsigned long long mymask = ~0ull;
    ATT_ISSUE(0, 0);
    for (int i = 0; i < ntot; ++i) {
        const int slot = i & 1;
        if (i + 1 < ntot) { ATT_ISSUE(i + 1, slot ^ 1); ATT_WAIT_BAR(2); } else { ATT_WAIT_BAR(0); }
        f32x16 p0, p1;
        qkt(p0, p1, c.shm + LDS_K + slot * SLOTB, qr, c.r32, c.hi);
        if (i < e1) {
            const int j = i < e0 ? i : i - e0;
            if (64 * j + 63 > nmax_min) mask_gt(p0, p1, nmax - 64 * j, c.hi);
            if (i < e0) {
                const float rm = rowmax(p0, p1), mn = fmaxf(fmaxf(m, rm), -1.0e30f); float s = 0.f;
#pragma unroll
                for (int r = 0; r < 16; ++r) s += __builtin_amdgcn_exp2f(p0[r] - mn) + __builtin_amdgcn_exp2f(p1[r] - mn);
                l = l * __builtin_amdgcn_exp2f(m - mn) + s; m = mn;
                if (i + 1 == e0) { const float lt = halfswap_add(l); inv = lt > 0.f ? 1.0f / lt : 0.f; }
            } else {
#pragma unroll
                for (int r = 0; r < 16; ++r) { p0[r] = __builtin_amdgcn_exp2f(p0[r] - m) * inv; p1[r] = __builtin_amdgcn_exp2f(p1[r] - m) * inv; }
                if (need_sel) {
                    float qs[8], ls[8];
#pragma unroll
                    for (int k = 0; k < 4; ++k) { qs[k] = (p0[4 * k] + p0[4 * k + 1]) + (p0[4 * k + 2] + p0[4 * k + 3]); ls[k] = p0[4 * k + 3];
                        qs[4 + k] = (p1[4 * k] + p1[4 * k + 1]) + (p1[4 * k + 2] + p1[4 * k + 3]); ls[4 + k] = p1[4 * k + 3]; }
#pragma unroll
                    for (int k = 0; k < 8; ++k) { qs[k] += __shfl_xor(qs[k], 8); qs[k] += __shfl_xor(qs[k], 16); ls[k] += __shfl_xor(ls[k], 8); ls[k] += __shfl_xor(ls[k], 16); }
                    if (hh == 0) {
#pragma unroll
                        for (int k = 0; k < 8; ++k) { const int jb = 16 * j + 2 * (k & 3) + c.hi + 8 * (k >> 2); imp[tt * 64 + jb] += qs[k]; }
                    }
                    LDS_WAIT();
                    if (hh == 0) {
#pragma unroll
                        for (int k = 0; k < 8; ++k) { const int jb = 16 * j + 2 * (k & 3) + c.hi + 8 * (k >> 2) + 1; if (jb < 64) imp[tt * 64 + jb] += ls[k]; }
                    }
                    LDS_WAIT();
                }
                p_times_v(c, o, p0, p1, slot);
                if (i + 1 == e1) {
                    fold_out(c, out, o, gate_c);
                    if (need_sel) {
                        for (int k = 0; k < 8; ++k) {
                            const int jl = c.lane; const bool valid = jl <= qb; const bool forced = (jl == 0) || (jl == qb) || (jl == qb - 1);
                            const float sc = valid ? imp[k * 64 + jl] + (forced ? 1000.0f : 0.0f) : -1.0f;
                            int rank = 0;
#pragma unroll
                            for (int q = 0; q < 64; ++q) { const float sq = __builtin_bit_cast(float, __builtin_amdgcn_readlane(__builtin_bit_cast(int, sc), q)); rank += (sq > sc || (sq == sc && q < jl)) ? 1 : 0; }
                            const unsigned long long mk = __ballot(valid && rank < 16);
                            if (c.lane == 0) smk[k] = mk;
                        }
                        LDS_WAIT();
                        mymask = smk[tt];
                    } else mymask = (2ull << qb) - 1ull;
                    m = -INFINITY; l = 0.f; o[0] = f32x16{}; o[1] = f32x16{};
                }
            }
        } else {
            if (i < e2) { const int j = i - e1;
                if (__any(!((mymask >> j) & 1ull))) { if (!((mymask >> j) & 1ull)) mask_all(p0, p1); }
                if (j == qb) mask_gt(p0, p1, tok, c.hi);
            } else { const int j = i - e2;
                if (j == 0) mask_gt(p0, p1, tok, c.hi);
                if (j == 8) mask_le(p0, p1, tok, c.hi);
            }
            online_step(c, p0, p1, m, l, o, slot);
            if (i + 1 == e2 || i + 1 == ntot) { const float lt = halfswap_add(l); const float gt = (i + 1 == e2) ? gate_s : gate_w;
                fold_out(c, out, o, lt > 0.f ? gt / lt : 0.f);
                m = -INFINITY; l = 0.f; o[0] = f32x16{}; o[1] = f32x16{}; }
        }
        ATT_LGKM_BAR();
    }
#undef ATT_ISSUE
    {
        LDS_WAIT();
        bf16* AO = (bf16*)(F.ws + WS_AO);
#pragma unroll
        for (int i = 0; i < 4; ++i) { const int row = i * 8 + (c.lane >> 3), ch = c.lane & 7; const LAS f32x4* sp = (const LAS f32x4*)(out + row * OSTR + ch * 8); const f32x4 a = sp[0], bq = sp[1];
            const v4u v = (v4u){cvtpk(a[0], a[1]), cvtpk(a[2], a[3]), cvtpk(bq[0], bq[1]), cvtpk(bq[2], bq[3])};
            *(v4u*)(AO + ((size_t)b * SEQ + t0 + 8 * c.wid + (row & 7)) * D + (4 * g + (row >> 3)) * 64 + ch * 8) = v; }
        LDS_WAIT();
    }
}
__device__ __forceinline__ void attn_phase(Frame& F) {
    const int bg = F.vcu >> 3, s = F.vcu & 7;
    for (int i = 0; i < 8; ++i) { const int base = (i >> 1) * 16; const int qb = (i & 1) ? base + 15 - s : base + s;
        attn_unit(F, bg >> 2, bg & 3, qb); }
}
#undef ATT_WAIT_BAR
#undef ATT_LGKM_BAR
}

#ifndef MK_PER_PHASE
#define MK_PER_PHASE 0
#endif
constexpr int N_PHASES = 24;
struct Args { const float* in[18]; float* out; unsigned char* ws; int ph_lo, ph_hi, li, pad; };

__global__ void __launch_bounds__(NWAVES * 64, 2) fwd_kernel(Args args) {
    extern __shared__ __attribute__((aligned(16))) unsigned char lds[];
    Frame F;
    F.lds = (LAS unsigned char*)lds;
    F.MISC = (volatile LAS unsigned*)(F.lds + MISC_OFF);
    refresh(F);
    F.G = gridDim.x; { const int bx = blockIdx.x; F.vcu = (F.G % 8 == 0) ? (bx % 8) * (F.G / 8) + bx / 8 : bx; }
    F.ws = args.ws; F.ctl = (gu32*)(args.ws + WS_CTL); F.out = args.out;
    for (int u = F.tid; u < (LDS_BYTES - LDSCTL_OFF) / 4; u += NWAVES * 64) ((LAS unsigned*)(F.lds + LDSCTL_OFF))[u] = 0u;
    __syncthreads();
    if (F.tid < 18) ((LAS unsigned long long*)(F.lds + PTR_OFF))[F.tid] = (unsigned long long)args.in[F.tid];
    __syncthreads();
    XcdBarrier bar = xcd_barrier_post((unsigned*)(F.ctl + CW_BAR) + args.li * XCD_BAR_WORDS, F.MISC + 8);
#define GRID_BAR() xcd_barrier(bar)
    const int lo = args.ph_lo, hi = args.ph_hi;
#ifndef PH_MASK
#define PH_MASK 0xFFFFFFu
#endif
#define IN(k) (((PH_MASK >> ((k) > 13 ? 13 + (((k) - 13) & 1) : (k))) & 1u) && lo <= (k) && (k) < hi)
#define BOTH(k) (IN(k) && IN((k) + 1))
    unsigned char* ws = args.ws;
    float* R0 = (float*)(ws + WS_R0); bf16* XB = (bf16*)(ws + WS_XB);
    const int cblk = (int)blockIdx.x;

    if (IN(0)) { refresh(F); p0_prologue(F); if (BOTH(0)) GRID_BAR(); }
    if (IN(1)) { refresh(F);
        pg8::Gemm g{(const bf16*)(ws + WS_APOOL), (const bf16*)(ws + W_POOL), D, 256, 256}; ep::PoolOrder S{F.G, cblk};
        ep::EpiPool E{F.inp(I_X), F.inp(I_POOLS), R0};
        pg8::gemm_phase<ep::EpiPool, ep::PoolOrder, true, false>(F.lds + RING_OFF, g, S, E);
        if (BOTH(1)) GRID_BAR(); }
    if (IN(2)) { refresh(F); ln_phase(F, R0, F.inp(I_LNG) + 0 * D, F.inp(I_LNB) + 0 * D, R0, XB); if (BOTH(2)) GRID_BAR(); }
    if (IN(3)) { refresh(F);
        pg8::Gemm g{XB, (const bf16*)(ws + W_FGU), D, D, D}; ep::DenseOrder S{T / 256, 2 * DFF / 256, F.G, cblk, (size_t)256 * D * 2, (size_t)256 * D * 2};
        ep::EpiSwiGLU E{(bf16*)(ws + WS_H1), DFF, 0};
        pg8::gemm_phase(F.lds + RING_OFF, g, S, E);
        if (BOTH(3)) GRID_BAR(); }
    if (IN(4)) { refresh(F);
        pg8::Gemm g{(const bf16*)(ws + WS_H1), (const bf16*)(ws + W_FDN), DFF, DFF, DFF}; ep::DenseOrder S{T / 256, D / 256, F.G, cblk, (size_t)256 * DFF * 2, (size_t)256 * DFF * 2};
        ep::EpiResid E{R0};
        pg8::gemm_phase(F.lds + RING_OFF, g, S, E);
        if (BOTH(4)) GRID_BAR(); }
    if (IN(5)) { refresh(F); ln_phase(F, R0, F.inp(I_LNG) + 1 * D, F.inp(I_LNB) + 1 * D, R0, XB); if (BOTH(5)) GRID_BAR(); }
    if (IN(6)) { refresh(F);
        pg8::Gemm g{XB, (const bf16*)(ws + W_IN), D, D, D}; ep::DenseOrder S{T / 256, INP_PAD / 256, F.G, cblk, (size_t)256 * D * 2, (size_t)256 * D * 2};
        ep::EpiInProj E{(bf16*)(ws + WS_Q), (bf16*)(ws + WS_KV6), (float*)(ws + WS_GATES), (const float*)(ws + WS_ROPE), (const float*)(ws + WS_ROPE) + SEQ * 32};
        pg8::gemm_phase(F.lds + RING_OFF, g, S, E);
        if (BOTH(6)) GRID_BAR(); }
    if (IN(7)) { refresh(F);
        pg8::Gemm g{(const bf16*)(ws + WS_KV6), (const bf16*)(ws + W_C1), 1024, 2048, 512}; ep::CmpOrder S{F.G, cblk};
        ep::EpiCPart E{(float*)(ws + WS_CPART)};
        pg8::gemm_phase(F.lds + RING_OFF, g, S, E);
        if (BOTH(7)) GRID_BAR(); }
    if (IN(8)) { refresh(F); compress_finish_phase(F); if (BOTH(8)) GRID_BAR(); }
    if (IN(9)) { refresh(F); att::attn_phase(F); if (BOTH(9)) GRID_BAR(); }
    if (IN(10)) { refresh(F);
        pg8::Gemm g{(const bf16*)(ws + WS_AO), (const bf16*)(ws + W_OUT), D, D, D}; ep::DenseOrder S{T / 256, D / 256, F.G, cblk, (size_t)256 * D * 2, (size_t)256 * D * 2};
        ep::EpiResid E{R0};
        pg8::gemm_phase(F.lds + RING_OFF, g, S, E);
        if (BOTH(10)) GRID_BAR(); }
    if (IN(11)) { refresh(F); ln_router_phase(F, R0, F.inp(I_LNG) + 2 * D, F.inp(I_LNB) + 2 * D, XB); if (BOTH(11)) GRID_BAR(); }
    if (IN(12)) { refresh(F); moe_dispatch_phase(F); if (BOTH(12)) GRID_BAR(); }
    for (int ch = 0; ch < MOE_NCH; ++ch) {
        const int p1 = 13 + 2 * ch, p2 = p1 + 1;
        const LAS int* mt = (const LAS int*)(F.lds + MOET_OFF);
        if (IN(p1)) { refresh(F);
            if (lo == p1) moe_tables(F);
            const int NT = mt[24], tile0 = MOE_CH * ch, nM = (NT - tile0) < MOE_CH ? (NT - tile0) : MOE_CH;
            if (nM > 0) {
                pg8::Gemm g{(const bf16*)(ws + WS_XS), (const bf16*)(ws + W_MGU), D, D, D};
                ep::MoeOrder<2 * DFE / 256> S{nM, F.G, cblk, tile0, mt + 32, (size_t)256 * D * 2, (size_t)2 * DFE * D * 2, (size_t)256 * D * 2, false};
                ep::EpiSwiGLU E{(bf16*)(ws + WS_H2), DFE, tile0};
                pg8::gemm_phase(F.lds + RING_OFF, g, S, E);
                if (BOTH(p1)) GRID_BAR(); } }
        if (IN(p2)) { refresh(F);
            if (lo == p2) moe_tables(F);
            const int NT = mt[24], tile0 = MOE_CH * ch, nM = (NT - tile0) < MOE_CH ? (NT - tile0) : MOE_CH;
            if (nM > 0) {
                pg8::Gemm g{(const bf16*)(ws + WS_H2), (const bf16*)(ws + W_MDN), DFE, DFE, DFE};
                ep::MoeOrder<D / 256> S{nM, F.G, cblk, tile0, mt + 32, (size_t)256 * DFE * 2, (size_t)D * DFE * 2, (size_t)256 * DFE * 2, true};
                ep::EpiMoeDown E{(bf16*)(ws + WS_Y), (const int*)(ws + WS_SDST), (const float*)(ws + WS_SW)};
                pg8::gemm_phase(F.lds + RING_OFF, g, S, E);
                if (BOTH(p2)) GRID_BAR(); } }
    }
    if (IN(23)) { refresh(F); final_phase(F, R0, F.inp(I_LNG) + 3 * D, F.inp(I_LNB) + 3 * D, F.out); }
#undef IN
#undef BOTH
#undef GRID_BAR
}

extern "C" void kernel_launch(void* const* d_in, const int* in_sizes, int n_in, void* d_out, int out_size, void* d_ws, size_t ws_size, hipStream_t stream) {
    static int grid = 0;
    if (grid == 0) {
        if (n_in != 18 || in_sizes[0] != T * D || out_size != T * D || ws_size < WS_END) { fprintf(stderr, "kernel_launch: shape/workspace mismatch (n_in %d, ws %zu)\n", n_in, ws_size); grid = -1; return; }
        int dev = 0, cus = 0, per_cu = 0;
        if (hipGetDevice(&dev) != hipSuccess || hipDeviceGetAttribute(&cus, hipDeviceAttributeMultiprocessorCount, dev) != hipSuccess) { grid = -1; return; }
        if (hipFuncSetAttribute((const void*)fwd_kernel, hipFuncAttributeMaxDynamicSharedMemorySize, LDS_BYTES) != hipSuccess) { fprintf(stderr, "kernel_launch: hipFuncSetAttribute failed\n"); grid = -1; return; }
        if (hipOccupancyMaxActiveBlocksPerMultiprocessor(&per_cu, (const void*)fwd_kernel, NWAVES * 64, LDS_BYTES) != hipSuccess || per_cu < 1) { fprintf(stderr, "kernel_launch: occupancy query says %d blocks per CU\n", per_cu); }
        (void)hipGetLastError();
        if (cus != 256) { fprintf(stderr, "kernel_launch: built for 256 CUs, device has %d\n", cus); grid = -1; return; }
        grid = 256;
    }
    if (grid < 0) return;
    if (hipMemsetAsync((char*)d_ws + WS_CTL, 0, CTL_ZERO_BYTES, stream) != hipSuccess) return;
    Args a{};
    for (int i = 0; i < 18; ++i) a.in[i] = (const float*)d_in[i];
    a.out = (float*)d_out; a.ws = (unsigned char*)d_ws;
#if MK_PER_PHASE
    for (int p = 0; p < N_PHASES; ++p) { a.ph_lo = p; a.ph_hi = p + 1; a.li = p; hipLaunchKernelGGL(fwd_kernel, dim3(grid), dim3(NWAVES * 64), LDS_BYTES, stream, a); }
#else
    a.ph_lo = 0; a.ph_hi = N_PHASES; a.li = 0;
    hipLaunchKernelGGL(fwd_kernel, dim3(grid), dim3(NWAVES * 64), LDS_BYTES, stream, a);
#endif
}
```

```cpp
#include <hip/hip_runtime.h>
#include <cstdio>
#include <cstdint>

namespace pg8 {
#define PG8_LAS __attribute__((address_space(3)))
typedef unsigned short bf16_t;
typedef short bf16x8 __attribute__((ext_vector_type(8)));
typedef float f32x4 __attribute__((ext_vector_type(4)));
typedef float f32x2 __attribute__((ext_vector_type(2)));
typedef unsigned u32x4 __attribute__((ext_vector_type(4)));
typedef unsigned u32x2 __attribute__((ext_vector_type(2)));
constexpr int BM = 256, BK = 64, HALF = 128, HTB = HALF * BK * 2  , STAGE_BYTES = 8 * HTB, NXCD = 8, WGM = 8;

__host__ __device__ __forceinline__ int lds_byte(int r, int c) { const int st = (r >> 4) * 2 + (c >> 5), rr = r & 15, cc = c & 31, ob = rr * 64 + cc * 2; return st * 1024 + (ob ^ (((ob >> 9) & 1) << 5)); }
__host__ __device__ __forceinline__ void stage_rc(int b, int& R, int& C) { const int st = b / 1024, sb = b % 1024, swz = sb ^ (((sb >> 9) & 1) << 5); R = (st >> 1) * 16 + swz / 64; C = (st & 1) * 32 + (swz % 64) / 2; }
__host__ __device__ __forceinline__ int perm32(int rho) { const int n = rho >> 4, i = rho & 15; return 8 * (i >> 2) + 4 * n + (i & 3); }

struct Unit { int pm, pn; size_t aoff, boff; };
struct Gemm { const bf16_t* A; const bf16_t* Bt; int lda, ldb, K; };

__device__ __forceinline__ void order_tile(int L, int nM, int nN, int& pm, int& pn) {
    const int nwg = nM * nN; int wgid = L;
    { const int q = nwg / NXCD, r = nwg % NXCD, xcd = wgid % NXCD, off = wgid / NXCD; wgid = (xcd < r ? xcd * (q + 1) : r * (q + 1) + (xcd - r) * q) + off; }
    const int nig = WGM * nN, gid = wgid / nig, fm = gid * WGM, gsz = (nM - fm) < WGM ? (nM - fm) : WGM;
    pm = fm + ((wgid % nig) % gsz); pn = (wgid % nig) / gsz;
}

__device__ __forceinline__ unsigned cvt_pk_bf16(float lo, float hi) { unsigned r; asm volatile("v_cvt_pk_bf16_f32 %0, %1, %2" : "=v"(r) : "v"(lo), "v"(hi)); return r; }

template <class Epi, class Sched, bool ALIGN_EPI = true, bool SP2 = true>
__device__ __forceinline__ void gemm_phase(PG8_LAS unsigned char* lds, const Gemm g, const Sched& S, const Epi& E) {
    int tid = threadIdx.x; asm volatile("" : "+v"(tid));
    const int wid = __builtin_amdgcn_readfirstlane(tid >> 6), lane = tid & 63, wr = wid >> 2, wc = wid & 3, fr = lane & 15, fq = lane >> 4;
    const int K = g.K, nt = K / BK;
    unsigned voffA[2], voffB[2];
#pragma unroll
    for (int i = 0; i < 2; ++i) { int R, C; stage_rc(tid * 16 + i * 8192, R, C); const int Rb = Epi::PERM ? ((R & ~31) + perm32(R & 31)) : R;
        voffA[i] = (unsigned)(R * g.lda + C) * 2u; voffB[i] = (unsigned)(Rb * g.ldb + C) * 2u; }
    const size_t kstep = (size_t)(BK * 2);
    const size_t hstepA = (size_t)HALF * g.lda * 2, hstepB = (size_t)HALF * g.ldb * 2;
    const unsigned ldsw = (unsigned)wid * 1024u;
    const int aoff = lds_byte(wr * 64 + fr, fq * 8), boff = lds_byte(wc * 32 + fr, fq * 8);
#define PG8_SA(b, h) (((b) * 2 + (h)) * HTB)
#define PG8_SB(b, h) ((4 + (b) * 2 + (h)) * HTB)
#define PG8_STAGE(bufoff, gbase, voff) do { _Pragma("unroll") for (int _i = 0; _i < 2; ++_i) \
        __builtin_amdgcn_global_load_lds((const unsigned*)((const char*)(gbase) + (voff)[_i]), (PG8_LAS unsigned*)(lds + (bufoff) + ldsw + _i * 8192), 16, 0, 0); } while (0)
#define PG8_LDA(dst, b, h) do { _Pragma("unroll") for (int m = 0; m < 4; ++m) _Pragma("unroll") for (int k = 0; k < 2; ++k) dst[m][k] = *(const PG8_LAS bf16x8*)(lds + PG8_SA(b, h) + aoff + m * 2048 + k * 1024); } while (0)
#define PG8_LDB(dst, b, h) do { _Pragma("unroll") for (int n = 0; n < 2; ++n) _Pragma("unroll") for (int k = 0; k < 2; ++k) dst[n][k] = *(const PG8_LAS bf16x8*)(lds + PG8_SB(b, h) + boff + n * 2048 + k * 1024); } while (0)
#define PG8_MMA(ai, bj, At, Bt) do { __builtin_amdgcn_s_setprio(1); _Pragma("unroll") for (int m = 0; m < 4; ++m) _Pragma("unroll") for (int n = 0; n < 2; ++n) _Pragma("unroll") for (int k = 0; k < 2; ++k) \
        acc[ai][bj][m][n] = __builtin_amdgcn_mfma_f32_16x16x32_bf16(Bt[n][k], At[m][k], acc[ai][bj][m][n], 0, 0, 0); __builtin_amdgcn_s_setprio(0); } while (0)
#define PG8_WAIT_V(n) asm volatile("s_waitcnt vmcnt(" #n ")" ::: "memory")
#define PG8_WAIT_L(n) asm volatile("s_waitcnt lgkmcnt(" #n ")" ::: "memory")
#define PG8_BAR __builtin_amdgcn_s_barrier()
#define PG8_SCHED __builtin_amdgcn_sched_barrier(0)
    Unit cur, nxt; int ui = 0;
    if (!S.next(0, cur)) return;
    f32x4 acc[2][2][4][2];
#pragma unroll
    for (int a = 0; a < 2; ++a)
#pragma unroll
        for (int b = 0; b < 2; ++b)
#pragma unroll
            for (int m = 0; m < 4; ++m)
#pragma unroll
                for (int n = 0; n < 2; ++n) acc[a][b][m][n] = (f32x4){0.f, 0.f, 0.f, 0.f};
    bf16x8 At[4][2], B0[2][2], B1[2][2];
    const char* cA = (const char*)g.A + cur.aoff; const char* cB = (const char*)g.Bt + cur.boff;
    if constexpr (SP2) {
        PG8_STAGE(PG8_SB(0, 0), cB, voffB); PG8_STAGE(PG8_SB(0, 1), cB + hstepB, voffB); PG8_STAGE(PG8_SA(0, 0), cA, voffA); PG8_STAGE(PG8_SA(0, 1), cA + hstepA, voffA);
        if (wr == 1) PG8_BAR;
        PG8_WAIT_V(2); PG8_BAR;
        PG8_STAGE(PG8_SB(1, 0), cB + kstep, voffB); PG8_STAGE(PG8_SA(1, 0), cA + kstep, voffA); PG8_STAGE(PG8_SB(1, 1), cB + hstepB + kstep, voffB);
        PG8_WAIT_V(6); PG8_BAR;
    } else {
        PG8_STAGE(PG8_SB(0, 0), cB, voffB); PG8_STAGE(PG8_SA(0, 0), cA, voffA); PG8_STAGE(PG8_SB(0, 1), cB + hstepB, voffB); PG8_STAGE(PG8_SA(0, 1), cA + hstepA, voffA);
        if (wr == 1) PG8_BAR;
        PG8_WAIT_V(4); PG8_BAR;
        PG8_STAGE(PG8_SB(1, 0), cB + kstep, voffB); PG8_STAGE(PG8_SA(1, 0), cA + kstep, voffA); PG8_STAGE(PG8_SB(1, 1), cB + hstepB + kstep, voffB);
        PG8_WAIT_V(6); PG8_BAR;
    }
    for (;;) {
        const bool has_next = S.next(ui + 1, nxt);
        const char* nA = has_next ? (const char*)g.A + nxt.aoff : cA; const char* nB = has_next ? (const char*)g.Bt + nxt.boff : cB;
        for (int t = 0; t < nt; t += 2) {
            const bool last = (t == nt - 2);
            const char* a1 = cA + (size_t)(t + 1) * kstep;
            const char* a2 = last ? nA : cA + (size_t)(t + 2) * kstep; const char* b2 = last ? nB : cB + (size_t)(t + 2) * kstep;
            const char* a3 = a2 + kstep; const char* b3 = b2 + kstep;
            if constexpr (SP2) {
            PG8_LDB(B0, 0, 0); PG8_LDB(B1, 0, 1); PG8_SCHED; PG8_LDA(At, 0, 0); PG8_STAGE(PG8_SA(1, 1), a1 + hstepA, voffA);
            PG8_WAIT_V(8); PG8_WAIT_L(0); PG8_BAR; PG8_MMA(0, 0, At, B0); PG8_MMA(0, 1, At, B1); PG8_BAR; PG8_SCHED;
            PG8_LDA(At, 0, 1); PG8_STAGE(PG8_SB(0, 0), b2, voffB); PG8_STAGE(PG8_SB(0, 1), b2 + hstepB, voffB); PG8_STAGE(PG8_SA(0, 0), a2, voffA);
            PG8_WAIT_V(8); PG8_WAIT_L(0); PG8_BAR; PG8_MMA(1, 0, At, B0); PG8_MMA(1, 1, At, B1); PG8_BAR; PG8_SCHED;
            PG8_LDB(B0, 1, 0); PG8_LDB(B1, 1, 1); PG8_SCHED; PG8_LDA(At, 1, 0); PG8_STAGE(PG8_SA(0, 1), a2 + hstepA, voffA);
            PG8_WAIT_V(8); PG8_WAIT_L(0); PG8_BAR; PG8_MMA(0, 0, At, B0); PG8_MMA(0, 1, At, B1); PG8_BAR; PG8_SCHED;
            PG8_LDA(At, 1, 1); PG8_STAGE(PG8_SB(1, 0), b3, voffB); PG8_STAGE(PG8_SB(1, 1), b3 + hstepB, voffB); PG8_STAGE(PG8_SA(1, 0), a3, voffA);
            PG8_WAIT_V(8); PG8_WAIT_L(0); PG8_BAR; PG8_MMA(1, 0, At, B0); PG8_MMA(1, 1, At, B1); PG8_BAR; PG8_SCHED;
            } else {
            PG8_LDB(B0, 0, 0); PG8_SCHED; PG8_LDA(At, 0, 0); PG8_STAGE(PG8_SA(1, 1), a1 + hstepA, voffA);
            PG8_WAIT_L(8); PG8_BAR; PG8_WAIT_L(0); PG8_MMA(0, 0, At, B0); PG8_BAR; PG8_SCHED;
            PG8_LDB(B1, 0, 1); PG8_STAGE(PG8_SB(0, 0), b2, voffB);
            PG8_BAR; PG8_WAIT_L(0); PG8_MMA(0, 1, At, B1); PG8_BAR;
            PG8_LDA(At, 0, 1); PG8_STAGE(PG8_SA(0, 0), a2, voffA);
            PG8_BAR; PG8_WAIT_L(0); PG8_MMA(1, 0, At, B0); PG8_BAR; PG8_SCHED;
            PG8_STAGE(PG8_SB(0, 1), b2 + hstepB, voffB);
            PG8_WAIT_V(6); PG8_BAR; PG8_MMA(1, 1, At, B1); PG8_BAR;
            PG8_LDB(B0, 1, 0); PG8_SCHED; PG8_LDA(At, 1, 0); PG8_STAGE(PG8_SA(0, 1), a2 + hstepA, voffA);
            PG8_WAIT_L(8); PG8_BAR; PG8_WAIT_L(0); PG8_MMA(0, 0, At, B0); PG8_BAR; PG8_SCHED;
            PG8_LDB(B1, 1, 1); PG8_STAGE(PG8_SB(1, 0), b3, voffB);
            PG8_BAR; PG8_WAIT_L(0); PG8_MMA(0, 1, At, B1); PG8_BAR;
            PG8_LDA(At, 1, 1); PG8_STAGE(PG8_SA(1, 0), a3, voffA);
            PG8_BAR; PG8_WAIT_L(0); PG8_MMA(1, 0, At, B0); PG8_BAR; PG8_SCHED;
            PG8_STAGE(PG8_SB(1, 1), b3 + hstepB, voffB);
            PG8_WAIT_V(6); PG8_BAR; PG8_MMA(1, 1, At, B1); PG8_BAR;
            }
        }
        if constexpr (ALIGN_EPI) { if (wr == 0) PG8_BAR; }
        E(acc, cur, wr, wc, fr, fq);
        if (!has_next) break;
#pragma unroll
        for (int a = 0; a < 2; ++a)
#pragma unroll
            for (int b = 0; b < 2; ++b)
#pragma unroll
                for (int m = 0; m < 4; ++m)
#pragma unroll
                    for (int n = 0; n < 2; ++n) acc[a][b][m][n] = (f32x4){0.f, 0.f, 0.f, 0.f};
        cur = nxt; cA = nA; cB = nB; ++ui;
        if constexpr (ALIGN_EPI) { if (wr == 1) PG8_BAR; }
    }
    PG8_WAIT_V(0);
    if constexpr (!ALIGN_EPI) { if (wr == 0) PG8_BAR; }
    PG8_BAR;
#undef PG8_SA
#undef PG8_SB
#undef PG8_STAGE
#undef PG8_LDA
#undef PG8_LDB
#undef PG8_MMA
#undef PG8_WAIT_V
#undef PG8_WAIT_L
#undef PG8_BAR
#undef PG8_SCHED
}
}

constexpr int NWAVES = 8;
constexpr int BATCH = 8, SEQ = 4096, D = 1024, T = BATCH * SEQ;
constexpr int DFF = 2816, NE = 8, DFE = 3584, INP = 2608, INP_PAD = 2816;
constexpr int NH = 16, NG = 4, HD = 64;
constexpr float LN_EPS = 1e-5f;
constexpr float ALPHA = 1.4142135623730951f;
constexpr float QSCALE = 0.125f * 1.4426950408889634f;
constexpr int MOE_CH = 64;
constexpr int MOE_MAXT = 264;
constexpr int MOE_NCH = 5;

constexpr size_t MiB = 1u << 20;
constexpr size_t WS_CTL = 0, CTL_ZERO_BYTES = 1 * MiB;
constexpr size_t WS_ROPE = 1 * MiB;
constexpr size_t WS_MISC = 2 * MiB;
constexpr size_t WS_SEL = 3 * MiB;
constexpr size_t WS_SDST = 4 * MiB;
constexpr size_t WS_SW = 5 * MiB;
constexpr size_t WS_KVC = 6 * MiB;
constexpr size_t WS_CPART = 8 * MiB;
constexpr size_t WS_GATES = 40 * MiB;
constexpr size_t W_POOL = 48 * MiB, W_FGU = 49 * MiB, W_FDN = 60 * MiB, W_IN = 66 * MiB, W_C1 = 72 * MiB, W_OUT = 74 * MiB, W_MGU = 76 * MiB, W_MDN = 188 * MiB;
constexpr size_t WS_R0 = 256 * MiB;
constexpr size_t WS_XB = 384 * MiB;
constexpr size_t WS_BIG = 448 * MiB;
constexpr size_t WS_APOOL = WS_BIG, WS_H1 = 512 * MiB;
constexpr size_t WS_Q = WS_BIG, WS_KV6 = 512 * MiB, WS_AO = 616 * MiB;
constexpr size_t WS_XS = WS_BIG, WS_H2 = 580 * MiB, WS_Y = 692 * MiB;
constexpr size_t WS_END = 820 * MiB;
constexpr size_t KV6_STRIDE = (size_t)T * 256;
static_assert(W_MGU + (size_t)NE * 2 * DFE * D * 2 <= W_MDN && W_MDN + (size_t)NE * D * DFE * 2 <= WS_R0, "weights map");
static_assert(WS_H1 + (size_t)T * DFF * 2 <= WS_END && WS_XS + (size_t)MOE_MAXT * 256 * D * 2 <= WS_H2 && WS_H2 + (size_t)MOE_CH * 256 * DFE * 2 <= WS_Y && WS_Y + (size_t)T * 2 * D * 2 <= WS_END, "big map");
constexpr int CW_TMO = 0, CW_BAR = 4096;
constexpr int N_BAR_REGIONS = 28;

constexpr int RING_OFF = 0, RING_BYTES = 131072;
constexpr int LDSCTL_OFF = RING_BYTES, MISC_OFF = LDSCTL_OFF + 320;
constexpr int PTR_OFF = RING_BYTES + 512;
constexpr int MOET_OFF = RING_BYTES + 1024;
constexpr int LDS_BYTES = 147456;

#define GAS __attribute__((address_space(1)))
#define LAS __attribute__((address_space(3)))
typedef unsigned short bf16;
typedef unsigned v4u __attribute__((ext_vector_type(4)));
typedef unsigned v2u __attribute__((ext_vector_type(2)));
typedef float f32x4 __attribute__((ext_vector_type(4)));
typedef float f32x2 __attribute__((ext_vector_type(2)));
typedef short bf16x8 __attribute__((ext_vector_type(8)));
typedef GAS unsigned gu32;
#define RLX_AGENT __ATOMIC_RELAXED, __HIP_MEMORY_SCOPE_AGENT
#define LDS_WAIT() asm volatile("s_waitcnt lgkmcnt(0)" ::: "memory")
#define VM_WAIT() asm volatile("s_waitcnt vmcnt(0)" ::: "memory")
__device__ __forceinline__ unsigned f2bf(float f) { unsigned u = __builtin_bit_cast(unsigned, f); return (u + 0x7fffu + ((u >> 16) & 1u)) >> 16; }
__device__ __forceinline__ unsigned pk2(float lo, float hi) { return f2bf(lo) | (f2bf(hi) << 16); }
__device__ __forceinline__ float bf2f(unsigned h) { return __builtin_bit_cast(float, h << 16); }

#define XB_TMO      128
#define XB_XCNT(j)  (256  + 64 * (j))
#define XB_XSUB(j)  (1280 + 64 * (j))
#define XB_XGEN(j)  (2304 + 64 * (j))
#define XB_TOP      3328
#define XB_TOPGEN   3392
#define XCD_BAR_WORDS 3456
#define XB_SPIN_CAP (1u << 18)
__device__ __forceinline__ unsigned xb_ld(unsigned* p)              { return __hip_atomic_load(p, __ATOMIC_RELAXED, __HIP_MEMORY_SCOPE_AGENT); }
__device__ __forceinline__ unsigned xb_add(unsigned* p, unsigned v) { return __hip_atomic_fetch_add(p, v, __ATOMIC_RELAXED, __HIP_MEMORY_SCOPE_AGENT); }
__device__ __forceinline__ unsigned xb_xcc_id() { return (unsigned)__builtin_amdgcn_s_getreg((3 << 11) | 20) & 0xFu; }
#define XB_SPIN(cond, bar) do { unsigned _sp = 0; while (cond) { __builtin_amdgcn_s_sleep(1); \
    if ((++_sp & 255u) == 0u) { if (xb_ld(&(bar)[XB_TMO])) break; if (_sp > XB_SPIN_CAP) { atomicAdd(&(bar)[XB_TMO], 1u); break; } } } } while (0)
struct XcdBarrier { unsigned* bar; unsigned x; volatile LAS unsigned* st; };
__device__ __forceinline__ XcdBarrier xcd_barrier_post(unsigned* bar, volatile LAS unsigned* st) {
    XcdBarrier b; b.bar = bar; b.x = xb_xcc_id(); b.st = st;
    if (threadIdx.x == 0) (void)xb_add(&bar[XB_XCNT(b.x)], 1u);
    return b;
}
__device__ __forceinline__ void xcd_barrier_complete(unsigned* bar, unsigned x, unsigned& nloc, unsigned& nx) {
    const unsigned G = gridDim.x * gridDim.y * gridDim.z;
    unsigned sum, cnt, mine, sp = 0u;
    for (;;) {
        sum = 0u; cnt = 0u; mine = 0u;
#pragma unroll
        for (unsigned j = 0; j < 16; ++j) { const unsigned c = xb_ld(&bar[XB_XCNT(j)]); sum += c; cnt += (c > 0u) ? 1u : 0u; mine = (j == x) ? c : mine; }
        if (sum == G) break;
        __builtin_amdgcn_s_sleep(1);
        if ((++sp & 255u) == 0u) { if (xb_ld(&bar[XB_TMO])) break; if (sp > XB_SPIN_CAP) { atomicAdd(&bar[XB_TMO], 1u); break; } }
    }
    nloc = mine > 0u ? mine : 1u; nx = cnt > 0u ? cnt : 1u;
}
__device__ __forceinline__ void xcd_barrier(const XcdBarrier& b) {
    asm volatile("s_waitcnt vmcnt(0)" ::: "memory");
    __syncthreads();
    if (threadIdx.x == 0) {
        unsigned* bar = b.bar;
        __builtin_amdgcn_s_waitcnt(0);
        unsigned nloc = b.st[0], nx = b.st[1];
        if (nloc == 0u) { xcd_barrier_complete(bar, b.x, nloc, nx); b.st[0] = nloc; b.st[1] = nx; }
        const unsigned old = xb_add(&bar[XB_XSUB(b.x)], 1u);
        const unsigned gen = old / nloc;
        if (old + 1u == (gen + 1u) * nloc) {
            __builtin_amdgcn_fence(__ATOMIC_RELEASE, "agent");
            asm volatile("s_waitcnt vmcnt(0)" ::: "memory");
            const unsigned og = xb_add(&bar[XB_TOP], 1u);
            const unsigned tg = og / nx;
            if (og + 1u == (tg + 1u) * nx) xb_add(&bar[XB_TOPGEN], 1u);
            else XB_SPIN(xb_ld(&bar[XB_TOPGEN]) == tg, bar);
            __builtin_amdgcn_fence(__ATOMIC_ACQUIRE, "agent");
            xb_add(&bar[XB_XGEN(b.x)], 1u);
            asm volatile("s_waitcnt vmcnt(0)" ::: "memory");
        } else {
            XB_SPIN(xb_ld(&bar[XB_XGEN(b.x)]) == gen, bar);
            __builtin_amdgcn_fence(__ATOMIC_ACQUIRE, "agent");
            asm volatile("s_waitcnt vmcnt(0)" ::: "memory");
        }
    }
    __syncthreads();
}

struct Frame {
    LAS unsigned char* lds;
    volatile LAS unsigned* MISC;
    gu32* ctl;
    unsigned char* ws;
    int tid, lane, wave;
    int vcu, G;
    float* out;
    __device__ __forceinline__ const float* inp(int i) const {
        const unsigned long long v = ((const LAS unsigned long long*)(lds + PTR_OFF))[i];
        const unsigned lo = __builtin_amdgcn_readfirstlane((unsigned)v), hi = __builtin_amdgcn_readfirstlane((unsigned)(v >> 32));
        return (const float*)(((unsigned long long)hi << 32) | lo); }
};
enum { I_X = 0, I_LNG, I_LNB, I_POOLW, I_POOLS, I_WIN, I_PEK, I_W1K, I_W2K, I_PEV, I_W1V, I_W2V, I_WOUT, I_FGU, I_FDN, I_ROUTER, I_MGU, I_MDN };

__device__ __forceinline__ void refresh(Frame& F) { int t = threadIdx.x; asm volatile("" : "+v"(t)); F.tid = t; F.lane = t & 63; F.wave = __builtin_amdgcn_readfirstlane(t >> 6); }
__device__ __forceinline__ float wave_sum(float v) {
#pragma unroll
    for (int o = 1; o < 64; o <<= 1) v += __shfl_xor(v, o);
    return v;
}
__device__ __forceinline__ float silu_f(float x) { return x * __builtin_amdgcn_rcpf(1.0f + __builtin_amdgcn_exp2f(-1.4426950408889634f * x)); }

__device__ __forceinline__ int wrow_map(int mode, int n, int Npad) {
    if (mode == 0) return n;
    if (mode == 1) { const int half = Npad >> 1; return n < half ? ((n >> 7) << 8) + (n & 127) : (((n - half) >> 7) << 8) + 128 + ((n - half) & 127); }
    const int tile = n >> 8, o = n & 255, head = o >> 6, hf = (o >> 5) & 1, i = o & 31;
    return (tile << 8) + 128 * (head >> 1) + 32 * (2 * (head & 1) + (i >> 4)) + 16 * hf + (i & 15);
}
struct WItem { const float* W; bf16* WT; int K, Nreal, Npad, mode, k0, n0; };
constexpr int W_NITEMS_POOL = 4 * 4 * 4, W_NI_FG = (D / 64) * (2 * DFF / 64), W_NI_FD = (DFF / 64) * (D / 64), W_NI_IN = (D / 64) * (INP_PAD / 64), W_NI_C1 = (2048 / 64) * (256 / 64), W_NI_WO = (D / 64) * (D / 64);
constexpr int W_NI_MG = (D / 64) * (2 * DFE / 64), W_NI_MD = (DFE / 64) * (D / 64);
constexpr int W_NITEMS = W_NITEMS_POOL + W_NI_FG + W_NI_FD + W_NI_IN + 2 * W_NI_C1 + W_NI_WO + NE * W_NI_MG + NE * W_NI_MD;
__device__ __forceinline__ WItem witem_decode(const Frame& F, int it) {
    WItem w; int r = it; int sub;
    unsigned char* ws = F.ws;
    if (r < W_NITEMS_POOL) { const int g = r / 16; sub = r % 16; w = WItem{F.inp(I_POOLW) + (size_t)g * 65536, (bf16*)(ws + W_POOL) + (size_t)g * 65536, 256, 256, 256, 0, 0, 0}; }
    else if ((r -= W_NITEMS_POOL) < W_NI_FG) { sub = r; w = WItem{F.inp(I_FGU), (bf16*)(ws + W_FGU), D, 2 * DFF, 2 * DFF, 1, 0, 0}; }
    else if ((r -= W_NI_FG) < W_NI_FD) { sub = r; w = WItem{F.inp(I_FDN), (bf16*)(ws + W_FDN), DFF, D, D, 0, 0, 0}; }
    else if ((r -= W_NI_FD) < W_NI_IN) { sub = r; w = WItem{F.inp(I_WIN), (bf16*)(ws + W_IN), D, INP, INP_PAD, 2, 0, 0}; }
    else if ((r -= W_NI_IN) < 2 * W_NI_C1) { const int kv = r / W_NI_C1; sub = r % W_NI_C1; w = WItem{F.inp(kv ? I_W1V : I_W1K), (bf16*)(ws + W_C1) + (size_t)kv * 256 * 2048, 2048, 128, 256, 0, 0, 0}; }
    else if ((r -= 2 * W_NI_C1) < W_NI_WO) { sub = r; w = WItem{F.inp(I_WOUT), (bf16*)(ws + W_OUT), D, D, D, 0, 0, 0}; }
    else if ((r -= W_NI_WO) < NE * W_NI_MG) { const int e = r / W_NI_MG; sub = r % W_NI_MG; w = WItem{F.inp(I_MGU) + (size_t)e * D * 2 * DFE, (bf16*)(ws + W_MGU) + (size_t)e * 2 * DFE * D, D, 2 * DFE, 2 * DFE, 1, 0, 0}; }
    else { r -= NE * W_NI_MG; const int e = r / W_NI_MD; sub = r % W_NI_MD; w = WItem{F.inp(I_MDN) + (size_t)e * DFE * D, (bf16*)(ws + W_MDN) + (size_t)e * D * DFE, DFE, D, D, 0, 0, 0}; }
    const int nblk = w.Npad / 64; w.k0 = 64 * (sub / nblk); w.n0 = 64 * (sub % nblk);
    return w;
}
__device__ __forceinline__ void witem_load(const WItem& w, int lane, f32x4 (&ld)[16]) {
    const int nn = w.n0 + 4 * (lane & 15); const bool ok = nn < w.Nreal;
    const float* base = w.W + (size_t)(w.k0 + 2 * (lane >> 4)) * w.Nreal + nn;
#pragma unroll
    for (int j = 0; j < 16; ++j) { const int kk = 8 * (j >> 1) + (j & 1); ld[j] = ok ? *(const GAS f32x4*)(base + (size_t)kk * w.Nreal) : (f32x4){0.f, 0.f, 0.f, 0.f}; }
}
__device__ __forceinline__ void witem_store(const WItem& w, int lane, const f32x4 (&ld)[16], LAS unsigned* scr) {
#pragma unroll
    for (int m = 0; m < 8; ++m) { const f32x4 a = ld[2 * m], b = ld[2 * m + 1]; LAS unsigned* d = scr + (4 * m + (lane >> 4)) * 66 + 4 * (lane & 15);
        *(LAS v2u*)d = (v2u){pg8::cvt_pk_bf16(a[0], b[0]), pg8::cvt_pk_bf16(a[1], b[1])}; *(LAS v2u*)(d + 2) = (v2u){pg8::cvt_pk_bf16(a[2], b[2]), pg8::cvt_pk_bf16(a[3], b[3])}; }
    LDS_WAIT(); asm volatile("" ::: "memory");
    const int c = lane & 7;
#pragma unroll
    for (int j = 0; j < 8; ++j) { const int n = (lane >> 3) + 8 * j; const LAS unsigned* s = scr + (4 * c) * 66 + n;
        const v4u o = (v4u){s[0], s[66], s[132], s[198]};
        *(GAS v4u*)(w.WT + (size_t)wrow_map(w.mode, w.n0 + n, w.Npad) * w.K + w.k0 + 8 * c) = o; }
    LDS_WAIT(); asm volatile("" ::: "memory");
}

__device__ __forceinline__ void p0_pool_operand(Frame& F) {
    const float* x = F.inp(I_X); bf16* AP = (bf16*)(F.ws + WS_APOOL);
    LAS f32x4* tile = (LAS f32x4*)(F.lds + RING_OFF);
    for (int unit = F.vcu; unit < (T / 64) * 4; unit += F.G) {
        const int rb = unit >> 2, g = unit & 3, w = 2 << g, t0 = rb * 64, s0 = t0 & (SEQ - 1);
        const int halo = (w - 1) < s0 ? (w - 1) : s0;
        __syncthreads();
        for (int idx = F.tid; idx < (64 + halo) * 64; idx += NWAVES * 64) { const int row = idx >> 6, c4 = idx & 63;
            tile[row * 64 + c4] = *(const GAS f32x4*)(x + (size_t)(t0 - halo + row) * D + g * 256 + c4 * 4); }
        __syncthreads();
#pragma unroll 2
        for (int k = 0; k < 8; ++k) { const int o = F.tid + k * 512, r = o >> 6, c4 = o & 63, s = s0 + r;
            const int cnt = (s + 1) < w ? (s + 1) : w;
            f32x4 sum = (f32x4){0.f, 0.f, 0.f, 0.f};
            for (int j = 0; j < cnt; ++j) sum += tile[(halo + r - j) * 64 + c4];
            const f32x4 cur = tile[(halo + r) * 64 + c4]; const float fc = (float)cnt;
            const f32x4 v = (f32x4){sum.x / fc, sum.y / fc, sum.z / fc, sum.w / fc} - cur;
            v2u pk; pk.x = pk2(v.x, v.y); pk.y = pk2(v.z, v.w);
            *(GAS v2u*)(AP + (size_t)(t0 + r) * D + g * 256 + c4 * 4) = pk; }
    }
    __syncthreads();
}

__device__ __forceinline__ void p0_prologue(Frame& F) {
    const int gw = F.vcu * NWAVES + F.wave, NGW = F.G * NWAVES;
    { float* rc = (float*)(F.ws + WS_ROPE); float* rs = rc + SEQ * 32;
      for (int idx = F.vcu * 512 + F.tid; idx < SEQ * 32; idx += F.G * 512) { const int pos = idx >> 5, i = idx & 31;
          const float fr = powf(10000.0f, -(float)i / 32.0f);
          const double ang = (double)((float)pos * fr);
          const double k = __builtin_rint(ang * 0.15915494309189535); const double r = ang - k * 6.283185307179586476925287, r2 = r * r;
          double sn = 1.0, cs = 1.0;
#pragma unroll
          for (int q = 12; q >= 1; --q) { sn = 1.0 - r2 * (1.0 / (double)((2 * q) * (2 * q + 1))) * sn; cs = 1.0 - r2 * (1.0 / (double)((2 * q - 1) * (2 * q))) * cs; }
          rc[idx] = (float)cs; rs[idx] = (float)(r * sn); } }
    if (F.vcu < 256) { const int kv = F.vcu >> 7, cc = F.vcu & 127; const float* pe = F.inp(kv == 0 ? I_PEK : I_PEV); const float* w1 = F.inp(kv == 0 ? I_W1K : I_W1V);
        LAS float* red = (LAS float*)(F.lds + RING_OFF + 98304);
        float s = 0.f;
#pragma unroll
        for (int q = 0; q < 4; ++q) { const int r = F.tid + 512 * q; s += pe[r] * w1[(size_t)r * 128 + cc]; }
        s = wave_sum(s); if (F.lane == 0) red[F.wave] = s; __syncthreads();
        if (F.tid == 0) ((float*)(F.ws + WS_MISC))[kv * 128 + cc] = ((red[0] + red[1]) + (red[2] + red[3])) + ((red[4] + red[5]) + (red[6] + red[7]));
        __syncthreads(); }
    p0_pool_operand(F);
    LAS unsigned* scr = (LAS unsigned*)(F.lds + RING_OFF + F.wave * 16384);
    int it = gw;
    if (it < W_NITEMS) {
        WItem cur = witem_decode(F, it); f32x4 la[16], lb[16]; witem_load(cur, F.lane, la);
        for (;;) {
            const int nx = it + NGW; const bool more = nx < W_NITEMS; WItem nxt = cur;
            if (more) { nxt = witem_decode(F, nx); witem_load(nxt, F.lane, lb); }
            witem_store(cur, F.lane, la, scr);
            if (!more) break;
#pragma unroll
            for (int j = 0; j < 16; ++j) la[j] = lb[j];
            cur = nxt; it = nx;
        }
    }
}

__device__ __forceinline__ void ln_phase(Frame& F, const float* src, const float* gam, const float* bet, float* dstf, bf16* dstb) {
    const int gw = F.vcu * NWAVES + F.wave, NGW = F.G * NWAVES;
    f32x4 gv[4], bv[4];
#pragma unroll
    for (int j = 0; j < 4; ++j) { gv[j] = *((const GAS f32x4*)gam + F.lane + 64 * j); bv[j] = *((const GAS f32x4*)bet + F.lane + 64 * j); }
    for (int m = gw; m < T; m += NGW) {
        const GAS f32x4* xr = (const GAS f32x4*)(src + (size_t)m * D) + F.lane;
        f32x4 v[4]; float s = 0.f;
#pragma unroll
        for (int j = 0; j < 4; ++j) { v[j] = xr[64 * j]; s += (v[j].x + v[j].y) + (v[j].z + v[j].w); }
        const float mean = wave_sum(s) * (1.f / D); float s2 = 0.f;
#pragma unroll
        for (int j = 0; j < 4; ++j) { v[j] = v[j] - mean; s2 += (v[j].x * v[j].x + v[j].y * v[j].y) + (v[j].z * v[j].z + v[j].w * v[j].w); }
        const float rstd = 1.f / sqrtf(wave_sum(s2) * (1.f / D) + LN_EPS);
        GAS f32x4* of = (GAS f32x4*)(dstf + (size_t)m * D) + F.lane;
#pragma unroll
        for (int j = 0; j < 4; ++j) { v[j] = v[j] * rstd * gv[j] + bv[j]; of[64 * j] = v[j]; }
        if (dstb) { GAS v2u* ob = (GAS v2u*)(dstb + (size_t)m * D) + F.lane;
#pragma unroll
            for (int j = 0; j < 4; ++j) { v2u pk; pk.x = pk2(v[j].x, v[j].y); pk.y = pk2(v[j].z, v[j].w); ob[64 * j] = pk; } }
    }
}

__device__ __forceinline__ void ln_router_phase(Frame& F, float* R0, const float* gam, const float* bet, bf16* dstb) {
    LAS float* rt = (LAS float*)(F.lds + RING_OFF);
    LAS unsigned* cnt = (LAS unsigned*)(F.lds + RING_OFF + 32768);
    const float* router = F.inp(I_ROUTER);
    for (int idx = F.tid; idx < 8192; idx += 512) { const int c = idx >> 3, e = idx & 7; rt[e * 1024 + c] = router[idx]; }
    if (F.tid < 8) cnt[F.tid] = 0u;
    __syncthreads();
    f32x4 gv[4], bv[4];
#pragma unroll
    for (int j = 0; j < 4; ++j) { gv[j] = *((const GAS f32x4*)gam + F.lane + 64 * j); bv[j] = *((const GAS f32x4*)bet + F.lane + 64 * j); }
    int* sel = (int*)(F.ws + WS_SEL);
    for (int k = 0; k < 16; ++k) {
        const int m = F.vcu * 128 + F.wave * 16 + k;
        const GAS f32x4* xr = (const GAS f32x4*)(R0 + (size_t)m * D) + F.lane;
        f32x4 v[4]; float s = 0.f;
#pragma unroll
        for (int j = 0; j < 4; ++j) { v[j] = xr[64 * j]; s += (v[j].x + v[j].y) + (v[j].z + v[j].w); }
        const float mean = wave_sum(s) * (1.f / D); float s2 = 0.f;
#pragma unroll
        for (int j = 0; j < 4; ++j) { v[j] = v[j] - mean; s2 += (v[j].x * v[j].x + v[j].y * v[j].y) + (v[j].z * v[j].z + v[j].w * v[j].w); }
        const float rstd = 1.f / sqrtf(wave_sum(s2) * (1.f / D) + LN_EPS);
        GAS f32x4* of = (GAS f32x4*)(R0 + (size_t)m * D) + F.lane;
        GAS v2u* ob = (GAS v2u*)(dstb + (size_t)m * D) + F.lane;
#pragma unroll
        for (int j = 0; j < 4; ++j) { v[j] = v[j] * rstd * gv[j] + bv[j]; of[64 * j] = v[j]; v2u pk; pk.x = pk2(v[j].x, v[j].y); pk.y = pk2(v[j].z, v[j].w); ob[64 * j] = pk; }
        float lg[8];
#pragma unroll
        for (int e = 0; e < 8; ++e) { float a = 0.f;
#pragma unroll
            for (int j = 0; j < 4; ++j) { const f32x4 r4 = *((const LAS f32x4*)(rt + e * 1024) + F.lane + 64 * j); a += (v[j].x * r4.x + v[j].y * r4.y) + (v[j].z * r4.z + v[j].w * r4.w); }
            lg[e] = wave_sum(a); }
        int i0 = 0; float v0 = lg[0];
#pragma unroll
        for (int e = 1; e < 8; ++e) if (lg[e] > v0) { v0 = lg[e]; i0 = e; }
        int i1 = -1; float v1 = -3.0e38f;
#pragma unroll
        for (int e = 0; e < 8; ++e) if (e != i0 && lg[e] > v1) { v1 = lg[e]; i1 = e; }
        const float ex = __expf(v1 - v0), w0 = 1.0f / (1.0f + ex), w1 = ex * w0;
        if (F.lane == 0) { *(GAS v4u*)(sel + (size_t)m * 4) = (v4u){(unsigned)i0, (unsigned)i1, __builtin_bit_cast(unsigned, w0), __builtin_bit_cast(unsigned, w1)};
            __hip_atomic_fetch_add(cnt + i0, 1u, __ATOMIC_RELAXED, __HIP_MEMORY_SCOPE_WORKGROUP); __hip_atomic_fetch_add(cnt + i1, 1u, __ATOMIC_RELAXED, __HIP_MEMORY_SCOPE_WORKGROUP); }
    }
    __syncthreads();
    if (F.tid < 8) ((unsigned*)(F.ws + WS_MISC + 4096))[F.vcu * 8 + F.tid] = cnt[F.tid];
}

__device__ __forceinline__ void moe_tables(Frame& F) {
    LAS int* cw = (LAS int*)(F.lds + RING_OFF + 65536);
    LAS int* mt = (LAS int*)(F.lds + MOET_OFF);
    const int* cg = (const int*)(F.ws + WS_MISC + 4096);
    __syncthreads();
    for (int idx = F.tid; idx < 2048; idx += 512) cw[idx] = __hip_atomic_load(cg + idx, RLX_AGENT);
    __syncthreads();
    { const int e = F.wave; int a[4]; int s = 0;
#pragma unroll
      for (int k = 0; k < 4; ++k) { a[k] = cw[(4 * F.lane + k) * 8 + e]; s += a[k]; }
      int inc = s;
#pragma unroll
      for (int o = 1; o < 64; o <<= 1) { const int y = __shfl_up(inc, o); if (F.lane >= o) inc += y; }
      if (F.lane == 63) mt[e] = inc;
      if (F.lane == (F.vcu >> 2)) { const int q = F.vcu & 3; mt[16 + e] = inc - s + (q > 0 ? a[0] : 0) + (q > 1 ? a[1] : 0) + (q > 2 ? a[2] : 0); } }
    __syncthreads();
    if (F.tid == 0) { int row = 0, tile = 0;
        for (int e = 0; e < 8; ++e) { mt[8 + e] = row; const int nt = (mt[e] + 255) >> 8; for (int i = 0; i < nt; ++i) mt[32 + tile + i] = e; tile += nt; row += nt << 8; }
        mt[24] = tile; }
    __syncthreads();
}

__device__ __forceinline__ void moe_dispatch_phase(Frame& F) {
    moe_tables(F);
    LAS int* mt = (LAS int*)(F.lds + MOET_OFF);
    LAS int* wcnt = (LAS int*)(F.lds + RING_OFF);
    LAS int* plist = (LAS int*)(F.lds + RING_OFF + 1024);
    const int* sel = (const int*)(F.ws + WS_SEL);
    int* sdst = (int*)(F.ws + WS_SDST); float* sw = (float*)(F.ws + WS_SW);
    const bf16* XB = (const bf16*)(F.ws + WS_XB); bf16* XS = (bf16*)(F.ws + WS_XS);
    int e = -1, rank = 0, t = 0, kk = 0; float wgt = 0.f;
    if (F.tid < 256) { const int tl = F.tid >> 1; kk = F.tid & 1; t = F.vcu * 128 + tl; e = sel[(size_t)t * 4 + kk]; wgt = __builtin_bit_cast(float, sel[(size_t)t * 4 + 2 + kk]);
#pragma unroll
        for (int ee = 0; ee < 8; ++ee) { const unsigned long long mk = __ballot(e == ee); if (e == ee) rank = __popcll(mk & ((1ull << F.lane) - 1ull)); if (F.lane == 0) wcnt[F.wave * 8 + ee] = __popcll(mk); } }
    __syncthreads();
    if (F.tid < 256) { int pre = 0; for (int w = 0; w < F.wave; ++w) pre += wcnt[w * 8 + e];
        const int pos = mt[8 + e] + mt[16 + e] + pre + rank;
        sdst[pos] = t * 2 + kk; sw[pos] = wgt; plist[F.tid] = pos; plist[256 + F.tid] = t; }
    __syncthreads();
    for (int q = F.wave * 32; q < F.wave * 32 + 32; ++q) { const int pos = plist[q], tt = plist[256 + q];
        const GAS v4u* s = (const GAS v4u*)(XB + (size_t)tt * D) + F.lane; GAS v4u* d = (GAS v4u*)(XS + (size_t)pos * D) + F.lane;
        const v4u a = s[0], b = s[64]; d[0] = a; d[64] = b; }
    if (F.vcu < 8) { const int ee = F.vcu, lo = mt[8 + ee] + mt[ee], hi = mt[8 + ee] + (((mt[ee] + 255) >> 8) << 8);
        for (int r = lo + F.wave; r < hi; r += NWAVES) { GAS v4u* d = (GAS v4u*)(XS + (size_t)r * D) + F.lane; d[0] = (v4u){0u, 0u, 0u, 0u}; d[64] = (v4u){0u, 0u, 0u, 0u}; if (F.lane == 0) { sdst[r] = -1; sw[r] = 0.f; } } }
}

__device__ __forceinline__ void final_phase(Frame& F, const float* R0, const float* gam, const float* bet, float* out) {
    const int gw = F.vcu * NWAVES + F.wave, NGW = F.G * NWAVES;
    const bf16* Y = (const bf16*)(F.ws + WS_Y);
    f32x4 gv[4], bv[4];
#pragma unroll
    for (int j = 0; j < 4; ++j) { gv[j] = *((const GAS f32x4*)gam + F.lane + 64 * j); bv[j] = *((const GAS f32x4*)bet + F.lane + 64 * j); }
    for (int m = gw; m < T; m += NGW) {
        const GAS f32x4* xr = (const GAS f32x4*)(R0 + (size_t)m * D) + F.lane;
        const GAS v2u* y0 = (const GAS v2u*)(Y + (size_t)m * 2 * D) + F.lane; const GAS v2u* y1 = y0 + 256;
        f32x4 v[4]; float s = 0.f;
#pragma unroll
        for (int j = 0; j < 4; ++j) { const v2u a = y0[64 * j], b = y1[64 * j]; v[j] = xr[64 * j] * ALPHA;
            v[j].x += bf2f(a.x & 0xffffu) + bf2f(b.x & 0xffffu); v[j].y += bf2f(a.x >> 16) + bf2f(b.x >> 16); v[j].z += bf2f(a.y & 0xffffu) + bf2f(b.y & 0xffffu); v[j].w += bf2f(a.y >> 16) + bf2f(b.y >> 16);
            s += (v[j].x + v[j].y) + (v[j].z + v[j].w); }
        const float mean = wave_sum(s) * (1.f / D); float s2 = 0.f;
#pragma unroll
        for (int j = 0; j < 4; ++j) { v[j] = v[j] - mean; s2 += (v[j].x * v[j].x + v[j].y * v[j].y) + (v[j].z * v[j].z + v[j].w * v[j].w); }
        const float rstd = 1.f / sqrtf(wave_sum(s2) * (1.f / D) + LN_EPS);
        GAS f32x4* of = (GAS f32x4*)(out + (size_t)m * D) + F.lane;
#pragma unroll
        for (int j = 0; j < 4; ++j) of[64 * j] = v[j] * rstd * gv[j] + bv[j];
    }
}

namespace ep {
using pg8::f32x4; using pg8::Unit; using pg8::u32x4; using pg8::u32x2; using pg8::cvt_pk_bf16;
constexpr int HALF = 128;

struct DenseOrder { int nM, nN, G, c; size_t astep, bstep;
    __device__ __forceinline__ bool next(int i, Unit& u) const { const long L = (long)i * G + c; if (L >= (long)nM * nN) return false;
        pg8::order_tile((int)L, nM, nN, u.pm, u.pn); u.aoff = (size_t)u.pm * astep; u.boff = (size_t)u.pn * bstep; return true; } };
struct PoolOrder { int G, c;
    __device__ __forceinline__ bool next(int i, Unit& u) const { const long L = (long)i * G + c; if (L >= (T / 256) * 4) return false;
        pg8::order_tile((int)L, T / 256, 4, u.pm, u.pn); u.aoff = (size_t)u.pm * 256 * D * 2 + (size_t)u.pn * 512; u.boff = (size_t)u.pn * 256 * 256 * 2; return true; } };
struct CmpOrder { int G, c;
    __device__ __forceinline__ bool next(int i, Unit& u) const { const long L = (long)i * G + c; if (L >= 256) return false;
        const int kv = (int)L >> 7, bg = ((int)L >> 2) & 31, kq = (int)L & 3; u.pm = bg; u.pn = kv * 4 + kq;
        u.aoff = ((size_t)kv * KV6_STRIDE + (size_t)bg * SEQ * 64 + (size_t)kq * 512) * 2; u.boff = ((size_t)kv * 256 * 2048 + (size_t)kq * 512) * 2; return true; } };
template <int NN> struct MoeOrder { int nM, G, c, tile0; const LAS int* tile_e; size_t a_tile, b_exp, b_tile; bool a_local;
    __device__ __forceinline__ bool next(int i, Unit& u) const { const int L = i * G + c; if (L >= nM * NN) return false;
        const int pml = L / NN; u.pn = L % NN; u.pm = tile0 + pml; const int e = __builtin_amdgcn_readfirstlane(tile_e[u.pm]);
        u.aoff = (size_t)(a_local ? pml : u.pm) * a_tile; u.boff = (size_t)e * b_exp + (size_t)u.pn * b_tile; return true; } };

struct EpiPool { static constexpr bool PERM = false; const float* x; const float* scale; float* out;
    __device__ __forceinline__ void operator()(const f32x4 (&acc)[2][2][4][2], const Unit& u, int wr, int wc, int fr, int fq) const {
        const int col0 = u.pn * 256 + wc * 32 + 4 * fq;
#pragma unroll
        for (int bj = 0; bj < 2; ++bj)
#pragma unroll
            for (int n = 0; n < 2; ++n) { const f32x4 sc = *(const f32x4*)(scale + col0 + bj * HALF + n * 16);
#pragma unroll
                for (int ai = 0; ai < 2; ++ai) {
#pragma unroll
                    for (int m = 0; m < 4; ++m) { const size_t off = (size_t)(u.pm * 256 + ai * HALF + wr * 64 + m * 16 + fr) * D + col0 + bj * HALF + n * 16;
                        const f32x4 xv = *(const f32x4*)(x + off); *(f32x4*)(out + off) = xv * ALPHA + acc[ai][bj][m][n] * sc; }
                    asm volatile("" ::: "memory"); } }
    } };
struct EpiResid { static constexpr bool PERM = false; float* R;
    __device__ __forceinline__ void operator()(const f32x4 (&acc)[2][2][4][2], const Unit& u, int wr, int wc, int fr, int fq) const {
        const int col0 = u.pn * 256 + wc * 32 + 4 * fq;
#pragma unroll
        for (int ai = 0; ai < 2; ++ai)
#pragma unroll
            for (int m = 0; m < 4; ++m) { const size_t off = (size_t)(u.pm * 256 + ai * HALF + wr * 64 + m * 16 + fr) * D + col0;
#pragma unroll
                for (int bj = 0; bj < 2; ++bj)
#pragma unroll
                    for (int n = 0; n < 2; ++n) { float* p = R + off + bj * HALF + n * 16; const f32x4 xv = *(const f32x4*)p; *(f32x4*)p = xv * ALPHA + acc[ai][bj][m][n]; }
                if (m & 1) asm volatile("" ::: "memory"); }
    } };
struct EpiSwiGLU { static constexpr bool PERM = true; bf16* O; int ldc; int pm0;
    __device__ __forceinline__ void operator()(const f32x4 (&acc)[2][2][4][2], const Unit& u, int wr, int wc, int fr, int fq) const {
        const int col0 = u.pn * 128 + wc * 32 + 8 * fq;
#pragma unroll
        for (int ai = 0; ai < 2; ++ai)
#pragma unroll
            for (int m = 0; m < 4; ++m) { bf16* rowp = O + (size_t)((u.pm - pm0) * 256 + ai * HALF + wr * 64 + m * 16 + fr) * ldc + col0;
                const f32x4 g0 = acc[ai][0][m][0], g1 = acc[ai][0][m][1], u0 = acc[ai][1][m][0], u1 = acc[ai][1][m][1];
                u32x4 w; w.x = cvt_pk_bf16(silu_f(g0[0]) * u0[0], silu_f(g0[1]) * u0[1]); w.y = cvt_pk_bf16(silu_f(g0[2]) * u0[2], silu_f(g0[3]) * u0[3]);
                w.z = cvt_pk_bf16(silu_f(g1[0]) * u1[0], silu_f(g1[1]) * u1[1]); w.w = cvt_pk_bf16(silu_f(g1[2]) * u1[2], silu_f(g1[3]) * u1[3]);
                *(u32x4*)rowp = w; }
    } };
struct EpiMoeDown { static constexpr bool PERM = true; bf16* Y; const int* sdst; const float* sw;
    __device__ __forceinline__ void operator()(const f32x4 (&acc)[2][2][4][2], const Unit& u, int wr, int wc, int fr, int fq) const {
        const int col0 = u.pn * 256 + wc * 32 + 8 * fq;
#pragma unroll
        for (int ai = 0; ai < 2; ++ai)
#pragma unroll
            for (int m = 0; m < 4; ++m) { const int sr = u.pm * 256 + ai * HALF + wr * 64 + m * 16 + fr; const int d = sdst[sr]; const float w = sw[sr];
                if (d >= 0) { bf16* rowp = Y + (size_t)d * D + col0;
#pragma unroll
                    for (int bj = 0; bj < 2; ++bj) { const f32x4 v0 = acc[ai][bj][m][0] * w, v1 = acc[ai][bj][m][1] * w;
                        u32x4 o; o.x = cvt_pk_bf16(v0[0], v0[1]); o.y = cvt_pk_bf16(v0[2], v0[3]); o.z = cvt_pk_bf16(v1[0], v1[1]); o.w = cvt_pk_bf16(v1[2], v1[3]);
                        *(u32x4*)(rowp + bj * HALF) = o; } } }
    } };
struct EpiCPart { static constexpr bool PERM = false; float* part;
    __device__ __forceinline__ void operator()(const f32x4 (&acc)[2][2][4][2], const Unit& u, int wr, int wc, int fr, int fq) const {
        const int col0 = wc * 32 + 4 * fq;
#pragma unroll
        for (int ai = 0; ai < 2; ++ai)
#pragma unroll
            for (int m = 0; m < 4; ++m) { float* rowp = part + ((size_t)u.pn * 8192 + u.pm * 256 + ai * HALF + wr * 64 + m * 16 + fr) * 128 + col0;
#pragma unroll
                for (int n = 0; n < 2; ++n) *(f32x4*)(rowp + n * 16) = acc[ai][0][m][n]; }
    } };
struct EpiInProj { static constexpr bool PERM = false; bf16* Q; bf16* KV6; float* gates; const float* rc; const float* rs;
    __device__ __forceinline__ void operator()(const f32x4 (&acc)[2][2][4][2], const Unit& u, int wr, int wc, int fr, int fq) const {
        const int pn = u.pn, i0 = 16 * (wc & 1) + 4 * fq;
        const bool rope = (pn < 4) || pn == 6 || pn == 8;
#pragma unroll
        for (int ai = 0; ai < 2; ++ai)
#pragma unroll
            for (int m = 0; m < 4; ++m) { const int row = u.pm * 256 + ai * HALF + wr * 64 + m * 16 + fr, pos = row & (SEQ - 1), bb = row >> 12;
                f32x4 cs = (f32x4){1.f, 1.f, 1.f, 1.f}, sn = (f32x4){0.f, 0.f, 0.f, 0.f};
                if (rope) { cs = *(const f32x4*)(rc + pos * 32 + i0); sn = *(const f32x4*)(rs + pos * 32 + i0); }
#pragma unroll
                for (int bj = 0; bj < 2; ++bj) { const int head = 2 * bj + (wc >> 1); const f32x4 x1 = acc[ai][bj][m][0], x2 = acc[ai][bj][m][1];
                    if (pn == 10) { if (head == 0) { float* gp = gates + (size_t)row * 48 + i0;
                            f32x4 s1; for (int j = 0; j < 4; ++j) s1[j] = 1.0f / (1.0f + __expf(-x1[j])); *(f32x4*)gp = s1;
                            if (i0 < 16) { f32x4 s2; for (int j = 0; j < 4; ++j) s2[j] = 1.0f / (1.0f + __expf(-x2[j])); *(f32x4*)(gp + 32) = s2; } } }
                    else { f32x4 o1 = x1 * cs - x2 * sn, o2 = x1 * sn + x2 * cs; bf16* dst;
                        if (pn < 4) { o1 = o1 * QSCALE; o2 = o2 * QSCALE; dst = Q + (size_t)row * D + (4 * pn + head) * 64 + i0; }
                        else dst = KV6 + (size_t)(pn - 4) * KV6_STRIDE + ((size_t)(bb * 4 + head) * SEQ + pos) * 64 + i0;
                        u32x2 a, b; a.x = cvt_pk_bf16(o1[0], o1[1]); a.y = cvt_pk_bf16(o1[2], o1[3]); b.x = cvt_pk_bf16(o2[0], o2[1]); b.y = cvt_pk_bf16(o2[2], o2[3]);
                        *(u32x2*)dst = a; *(u32x2*)(dst + 32) = b; } } }
    } };
}

__device__ __forceinline__ void compress_finish_phase(Frame& F) {
    LAS float* w2s = (LAS float*)(F.lds + RING_OFF);
    for (int idx = F.tid; idx < 2 * 8192; idx += 512) w2s[idx] = F.inp(idx < 8192 ? I_W2K : I_W2V)[idx & 8191];
    __syncthreads();
    const float* part = (const float*)(F.ws + WS_CPART); const float* cb = (const float*)(F.ws + WS_MISC);
    const float* rc = (const float*)(F.ws + WS_ROPE); const float* rs = rc + SEQ * 32;
    bf16* kvc = (bf16*)(F.ws + WS_KVC);
    const int gw = F.vcu * NWAVES + F.wave, NGW = F.G * NWAVES;
    for (int row = gw; row < 2 * 32 * 256; row += NGW) {
        const int kv = row >> 13, r = row & 8191, n = r & 255;
        bf16* dst = kvc + (size_t)row * 64 + F.lane;
        if (n == 255) { *dst = 0; continue; }
        float h0 = cb[kv * 128 + F.lane], h1 = cb[kv * 128 + 64 + F.lane];
#pragma unroll
        for (int q = 0; q < 4; ++q) { const float* p = part + ((size_t)(kv * 4 + q) * 8192 + r) * 128; h0 += p[F.lane]; h1 += p[64 + F.lane]; }
        h0 = silu_f(h0); h1 = silu_f(h1);
        const LAS float* w2 = w2s + kv * 8192 + F.lane; float o = 0.f;
#pragma unroll
        for (int c = 0; c < 64; ++c) o += __builtin_bit_cast(float, __builtin_amdgcn_readlane(__builtin_bit_cast(int, h0), c)) * w2[c * 64];
#pragma unroll
        for (int c = 0; c < 64; ++c) o += __builtin_bit_cast(float, __builtin_amdgcn_readlane(__builtin_bit_cast(int, h1), c)) * w2[(64 + c) * 64];
        if (kv == 0) { const int pos = 16 * n + 31, i = F.lane & 31; const float other = __shfl_xor(o, 32), cs = rc[pos * 32 + i], sn = rs[pos * 32 + i];
            o = (F.lane < 32) ? o * cs - other * sn : other * sn + o * cs; }
        *dst = (bf16)f2bf(o);
    }
    __syncthreads();
}

namespace att {
using f32x16 = __attribute__((ext_vector_type(16))) float;
using s16x4 = __attribute__((ext_vector_type(4))) short;
constexpr int SLOTB = 8192;
constexpr int LDS_K = 0, LDS_V = 2 * SLOTB, LDS_WS = 4 * SLOTB, LDS_OST = LDS_WS + NWAVES * 256, OSTR = 72  , LDS_IMP = LDS_OST + NWAVES * 32 * OSTR * 4, LDS_SM = LDS_IMP + NWAVES * 2048, LDS_END = LDS_SM + NWAVES * 64;
static_assert(LDS_END <= RING_BYTES, "attention LDS");
__device__ __forceinline__ int crow(int r, int hi) { return (r & 3) + 8 * (r >> 2) + 4 * hi; }
__device__ __forceinline__ float max3f(float a, float b, float c) { float r; asm("v_max3_f32 %0, %1, %2, %3" : "=v"(r) : "v"(a), "v"(b), "v"(c)); return r; }
__device__ __forceinline__ unsigned cvtpk(float lo, float hi) { unsigned r; asm("v_cvt_pk_bf16_f32 %0, %1, %2" : "=v"(r) : "v"(lo), "v"(hi)); return r; }
typedef short v4i16_t __attribute__((ext_vector_type(4)));
#define ATT_WAIT_BAR(N) asm volatile("s_waitcnt vmcnt(" #N ") lgkmcnt(0)\n\ts_barrier" ::: "memory")
#define ATT_LGKM_BAR() asm volatile("s_waitcnt lgkmcnt(0)\n\ts_barrier" ::: "memory")

__device__ __forceinline__ void qkt(f32x16& p0, f32x16& p1, const LAS unsigned char* Kslot, const bf16x8* qr, int r32, int hi) {
    const LAS unsigned char* kb = Kslot + hi * 1024 + r32 * 16;
    p0 = f32x16{}; p1 = f32x16{};
#pragma unroll
    for (int d0 = 0; d0 < 4; ++d0) {
        const bf16x8 b0 = *(const LAS bf16x8*)(kb + d0 * 2048), b1 = *(const LAS bf16x8*)(kb + d0 * 2048 + 512);
        p0 = __builtin_amdgcn_mfma_f32_32x32x16_bf16(b0, qr[d0], p0, 0, 0, 0); p1 = __builtin_amdgcn_mfma_f32_32x32x16_bf16(b1, qr[d0], p1, 0, 0, 0); }
}
__device__ __forceinline__ float rowmax(const f32x16& p0, const f32x16& p1) {
    float a = max3f(p0[0], p0[1], p1[0]), b = max3f(p0[2], p0[3], p1[1]); a = max3f(a, p1[2], p1[3]);
#pragma unroll
    for (int r = 4; r < 16; r += 4) { a = max3f(a, p0[r], p0[r + 1]); b = max3f(b, p0[r + 2], p0[r + 3]); a = max3f(a, p1[r], p1[r + 1]); b = max3f(b, p1[r + 2], p1[r + 3]); }
    const float m = fmaxf(a, b);
    auto rr = __builtin_amdgcn_permlane32_swap(__float_as_uint(m), __float_as_uint(m), false, false);
    return fmaxf(__uint_as_float(rr[0]), __uint_as_float(rr[1]));
}
__device__ __forceinline__ float halfswap_add(float v) { auto rr = __builtin_amdgcn_permlane32_swap(__float_as_uint(v), __float_as_uint(v), false, false); return __uint_as_float(rr[0]) + __uint_as_float(rr[1]); }
__device__ __forceinline__ void pv(f32x16* o, int vb, bf16x8 pa0, bf16x8 pa1, bf16x8 pa2, bf16x8 pa3) {
#pragma unroll
    for (int d0 = 0; d0 < 2; ++d0) { s16x4 lo[4], hi[4];
#pragma unroll
        for (int ks = 0; ks < 4; ++ks) {
            asm volatile("ds_read_b64_tr_b16 %0,%1 offset:%c2" : "=&v"(lo[ks]) : "v"(vb), "i"(d0 * 4096 + ks * 1024) : "memory");
            asm volatile("ds_read_b64_tr_b16 %0,%1 offset:%c2" : "=&v"(hi[ks]) : "v"(vb), "i"(d0 * 4096 + ks * 1024 + 512) : "memory"); }
        asm volatile("s_waitcnt lgkmcnt(0)" ::: "memory"); __builtin_amdgcn_sched_barrier(0);
#define ATT_PK(k) (bf16x8){lo[k][0], lo[k][1], lo[k][2], lo[k][3], hi[k][0], hi[k][1], hi[k][2], hi[k][3]}
        o[d0] = __builtin_amdgcn_mfma_f32_32x32x16_bf16(pa0, ATT_PK(0), o[d0], 0, 0, 0);
        o[d0] = __builtin_amdgcn_mfma_f32_32x32x16_bf16(pa1, ATT_PK(1), o[d0], 0, 0, 0);
        o[d0] = __builtin_amdgcn_mfma_f32_32x32x16_bf16(pa2, ATT_PK(2), o[d0], 0, 0, 0);
        o[d0] = __builtin_amdgcn_mfma_f32_32x32x16_bf16(pa3, ATT_PK(3), o[d0], 0, 0, 0);
#undef ATT_PK
    }
}
__device__ __forceinline__ void mask_gt(f32x16& p0, f32x16& p1, int thr, int hi) {
#pragma unroll
    for (int r = 0; r < 16; ++r) { const int kv = crow(r, hi); if (kv > thr) p0[r] = -INFINITY; if (kv + 32 > thr) p1[r] = -INFINITY; } }
__device__ __forceinline__ void mask_le(f32x16& p0, f32x16& p1, int thr, int hi) {
#pragma unroll
    for (int r = 0; r < 16; ++r) { const int kv = crow(r, hi); if (kv <= thr) p0[r] = -INFINITY; if (kv + 32 <= thr) p1[r] = -INFINITY; } }
__device__ __forceinline__ void mask_all(f32x16& p0, f32x16& p1) {
#pragma unroll
    for (int r = 0; r < 16; ++r) { p0[r] = -INFINITY; p1[r] = -INFINITY; } }

struct Ctx { LAS unsigned char* shm; int wid, lane, r32, hi; LAS float* wsf; int vb0; };

__device__ __forceinline__ void dma_k(const Ctx& c, const bf16* Kt, int slot) {
    __builtin_amdgcn_global_load_lds((const unsigned*)(Kt + c.lane * 64 + c.wid * 8), (LAS unsigned*)(c.shm + LDS_K + slot * SLOTB + c.wid * 1024), 16, 0, 0); }
__device__ __forceinline__ void dma_v(const Ctx& c, const bf16* Vt, int slot) {
    __builtin_amdgcn_global_load_lds((const unsigned*)(Vt + (16 * (c.wid & 3) + (c.lane >> 2)) * 64 + (c.wid >> 2) * 32 + (c.lane & 3) * 8), (LAS unsigned*)(c.shm + LDS_V + slot * SLOTB + c.wid * 1024), 16, 0, 0); }

__device__ __forceinline__ void p_times_v(const Ctx& c, f32x16* o, const f32x16& p0, const f32x16& p1, int slot) {
    v4u pw0 = (v4u){cvtpk(p0[0], p0[1]), cvtpk(p0[2], p0[3]), cvtpk(p0[4], p0[5]), cvtpk(p0[6], p0[7])};
    v4u pw1 = (v4u){cvtpk(p0[8], p0[9]), cvtpk(p0[10], p0[11]), cvtpk(p0[12], p0[13]), cvtpk(p0[14], p0[15])};
    v4u pw2 = (v4u){cvtpk(p1[0], p1[1]), cvtpk(p1[2], p1[3]), cvtpk(p1[4], p1[5]), cvtpk(p1[6], p1[7])};
    v4u pw3 = (v4u){cvtpk(p1[8], p1[9]), cvtpk(p1[10], p1[11]), cvtpk(p1[12], p1[13]), cvtpk(p1[14], p1[15])};
    pv(o, c.vb0 + slot * SLOTB, __builtin_bit_cast(bf16x8, pw0), __builtin_bit_cast(bf16x8, pw1), __builtin_bit_cast(bf16x8, pw2), __builtin_bit_cast(bf16x8, pw3));
}
__device__ __forceinline__ void online_step(const Ctx& c, f32x16& p0, f32x16& p1, float& m, float& l, f32x16* o, int slot) {
    const float rm = rowmax(p0, p1);
    const float mn = fmaxf(fmaxf(m, rm), -1.0e30f);
    const float f = __builtin_amdgcn_exp2f(m - mn);
    float s = 0.f;
#pragma unroll
    for (int r = 0; r < 16; ++r) { p0[r] = __builtin_amdgcn_exp2f(p0[r] - mn); p1[r] = __builtin_amdgcn_exp2f(p1[r] - mn); s += p0[r] + p1[r]; }
    l = l * f + s; m = mn;
    if (__any(f != 1.0f)) { if (c.hi == 0) c.wsf[c.r32] = f; LDS_WAIT();
#pragma unroll
        for (int r = 0; r < 16; ++r) { const float fr = c.wsf[crow(r, c.hi)]; o[0][r] *= fr; o[1][r] *= fr; }
        LDS_WAIT(); }
    p_times_v(c, o, p0, p1, slot);
}
__device__ __forceinline__ void fold_out(const Ctx& c, LAS float* outacc, const f32x16* o, float fac) {
    if (c.hi == 0) c.wsf[32 + c.r32] = fac; LDS_WAIT();
#pragma unroll
    for (int r = 0; r < 16; ++r) { const float fr = c.wsf[32 + crow(r, c.hi)]; LAS float* p = outacc + crow(r, c.hi) * OSTR + c.r32; p[0] += o[0][r] * fr; p[32] += o[1][r] * fr; }
    LDS_WAIT();
}

__device__ __forceinline__ void attn_unit(Frame& F, int b, int g, int qb) {
    Ctx c; c.shm = F.lds + RING_OFF; c.wid = F.wave; c.lane = F.lane; c.r32 = F.lane & 31; c.hi = F.lane >> 5;
    c.wsf = (LAS float*)(c.shm + LDS_WS) + c.wid * 64;
    c.vb0 = (int)(uintptr_t)(c.shm + LDS_V) + ((c.lane >> 4) & 1) * 32 + (c.lane & 3) * 8 + (4 * c.hi + ((c.lane & 15) >> 2)) * 64;
    const int tt = c.r32 & 7, hh = c.r32 >> 3, tok = 8 * c.wid + tt, t0 = 64 * qb, t = t0 + tok;
    const size_t grow = (size_t)b * SEQ + t;
    const bf16* Qp = (const bf16*)(F.ws + WS_Q) + grow * D + (4 * g + hh) * 64 + c.hi * 8;
    const bf16* KV6 = (const bf16*)(F.ws + WS_KV6) + (size_t)(b * 4 + g) * SEQ * 64;
    const bf16* KC = (const bf16*)(F.ws + WS_KVC) + (size_t)(b * 4 + g) * 256 * 64;
    VM_WAIT();
    bf16x8 qr[4];
#pragma unroll
    for (int d0 = 0; d0 < 4; ++d0) qr[d0] = *(const bf16x8*)(Qp + d0 * 16);
    const float* gp = (const float*)(F.ws + WS_GATES) + grow * 48 + (4 * g + hh) * 3;
    const float gate_c = gp[0], gate_s = gp[1], gate_w = gp[2];
    LAS float* out = (LAS float*)(c.shm + LDS_OST) + c.wid * 32 * OSTR;
#pragma unroll
    for (int k = 0; k < 32; ++k) out[k * OSTR + c.lane] = 0.f;
    LAS float* imp = (LAS float*)(c.shm + LDS_IMP) + c.wid * 512;
    LAS unsigned long long* smk = (LAS unsigned long long*)(c.shm + LDS_SM) + c.wid * 8;
    const bool need_sel = qb > 15;
    if (need_sel) {
#pragma unroll
        for (int k = 0; k < 8; ++k) imp[k * 64 + c.lane] = 0.f; }
    const int nmax = (t - 31) >> 4;
    const int nmax_min = (t0 - 31) >> 4;
    const int nct = ((4 * qb + 2) >> 6) + 1;
    const int e0 = nct, e1 = 2 * nct, e2 = e1 + qb + 1, ntot = e2 + (qb < 8 ? qb : 8) + 1;
#define ATT_ISSUE(i_, slot_) do { const int ii = (i_); const bf16 *Kt, *Vt; \
        if (ii < e1) { const int j = ii < e0 ? ii : ii - e0; Kt = KC + (size_t)j * 4096; Vt = Kt + 32 * 256 * 64; } \
        else if (ii < e2) { Kt = KV6 + 2 * KV6_STRIDE + (size_t)(ii - e1) * 4096; Vt = Kt + KV6_STRIDE; } \
        else { Kt = KV6 + 4 * KV6_STRIDE + (size_t)(qb - (ii - e2)) * 4096; Vt = Kt + KV6_STRIDE; } \
        dma_k(c, Kt, (slot_)); dma_v(c, Vt, (slot_)); } while (0)
    float m = -INFINITY, l = 0.f, inv = 0.f; f32x16 o[2]; o[0] = f32x16{}; o[1] = f32x16{};
    unsigned long long mymask = ~0ull;
    ATT_ISSUE(0, 0);
    for (int i = 0; i < ntot; ++i) {
        const int slot = i & 1;
        if (i + 1 < ntot) { ATT_ISSUE(i + 1, slot ^ 1); ATT_WAIT_BAR(2); } else { ATT_WAIT_BAR(0); }
        f32x16 p0, p1;
        qkt(p0, p1, c.shm + LDS_K + slot * SLOTB, qr, c.r32, c.hi);
        if (i < e1) {
            const int j = i < e0 ? i : i - e0;
            if (64 * j + 63 > nmax_min) mask_gt(p0, p1, nmax - 64 * j, c.hi);
            if (i < e0) {
                const float rm = rowmax(p0, p1), mn = fmaxf(fmaxf(m, rm), -1.0e30f); float s = 0.f;
#pragma unroll
                for (int r = 0; r < 16; ++r) s += __builtin_amdgcn_exp2f(p0[r] - mn) + __builtin_amdgcn_exp2f(p1[r] - mn);
                l = l * __builtin_amdgcn_exp2f(m - mn) + s; m = mn;
                if (i + 1 == e0) { const float lt = halfswap_add(l); inv = lt > 0.f ? 1.0f / lt : 0.f; }
            } else {
#pragma unroll
                for (int r = 0; r < 16; ++r) { p0[r] = __builtin_amdgcn_exp2f(p0[r] - m) * inv; p1[r] = __builtin_amdgcn_exp2f(p1[r] - m) * inv; }
                if (need_sel) {
                    float qs[8], ls[8];
#pragma unroll
                    for (int k = 0; k < 4; ++k) { qs[k] = (p0[4 * k] + p0[4 * k + 1]) + (p0[4 * k + 2] + p0[4 * k + 3]); ls[k] = p0[4 * k + 3];
                        qs[4 + k] = (p1[4 * k] + p1[4 * k + 1]) + (p1[4 * k + 2] + p1[4 * k + 3]); ls[4 + k] = p1[4 * k + 3]; }
#pragma unroll
                    for (int k = 0; k < 8; ++k) { qs[k] += __shfl_xor(qs[k], 8); qs[k] += __shfl_xor(qs[k], 16); ls[k] += __shfl_xor(ls[k], 8); ls[k] += __shfl_xor(ls[k], 16); }
                    if (hh == 0) {
#pragma unroll
                        for (int k = 0; k < 8; ++k) { const int jb = 16 * j + 2 * (k & 3) + c.hi + 8 * (k >> 2); imp[tt * 64 + jb] += qs[k]; }
                    }
                    LDS_WAIT();
                    if (hh == 0) {
#pragma unroll
                        for (int k = 0; k < 8; ++k) { const int jb = 16 * j + 2 * (k & 3) + c.hi + 8 * (k >> 2) + 1; if (jb < 64) imp[tt * 64 + jb] += ls[k]; }
                    }
                    LDS_WAIT();
                }
                p_times_v(c, o, p0, p1, slot);
                if (i + 1 == e1) {
                    fold_out(c, out, o, gate_c);
                    if (need_sel) {
                        for (int k = 0; k < 8; ++k) {
                            const int jl = c.lane; const bool valid = jl <= qb; const bool forced = (jl == 0) || (jl == qb) || (jl == qb - 1);
                            const float sc = valid ? imp[k * 64 + jl] + (forced ? 1000.0f : 0.0f) : -1.0f;
                            int rank = 0;
#pragma unroll
                            for (int q = 0; q < 64; ++q) { const float sq = __builtin_bit_cast(float, __builtin_amdgcn_readlane(__builtin_bit_cast(int, sc), q)); rank += (sq > sc || (sq == sc && q < jl)) ? 1 : 0; }
                            const unsigned long long mk = __ballot(valid && rank < 16);
                            if (c.lane == 0) smk[k] = mk;
                        }
                        LDS_WAIT();
                        mymask = smk[tt];
                    } else mymask = (2ull << qb) - 1ull;
                    m = -INFINITY; l = 0.f; o[0] = f32x16{}; o[1] = f32x16{};
                }
            }
        } else {
            if (i < e2) { const int j = i - e1;
                if (__any(!((mymask >> j) & 1ull))) { if (!((mymask >> j) & 1ull)) mask_all(p0, p1); }
                if (j == qb) mask_gt(p0, p1, tok, c.hi);
            } else { const int j = i - e2;
                if (j == 0) mask_gt(p0, p1, tok, c.hi);
                if (j == 8) mask_le(p0, p1, tok, c.hi);
            }
            online_step(c, p0, p1, m, l, o, slot);
            if (i + 1 == e2 || i + 1 == ntot) { const float lt = halfswap_add(l); const float gt = (i + 1 == e2) ? gate_s : gate_w;
                fold_out(c, out, o, lt > 0.f ? gt / lt : 0.f);
                m = -INFINITY; l = 0.f; o[0] = f32x16{}; o[1] = f32x16{}; }
        }
        ATT_LGKM_BAR();
    }
#undef ATT_ISSUE
    {
        LDS_WAIT();
        bf16* AO = (bf16*)(F.ws + WS_AO);
#pragma unroll
        for (int i = 0; i < 4; ++i) { const int row = i * 8 + (c.lane >> 3), ch = c.lane & 7; const LAS f32x4* sp = (const LAS f32x4*)(out + row * OSTR + ch * 8); const f32x4 a = sp[0], bq = sp[1];
            const v4u v = (v4u){cvtpk(a[0], a[1]), cvtpk(a[2], a[3]), cvtpk(bq[0], bq[1]), cvtpk(bq[2], bq[3])};
            *(v4u*)(AO + ((size_t)b * SEQ + t0 + 8 * c.wid + (row & 7)) * D + (4 * g + (row >> 3)) * 64 + ch * 8) = v; }
        LDS_WAIT();
    }
}
__device__ __forceinline__ void attn_phase(Frame& F) {
    const int bg = F.vcu >> 3, s = F.vcu & 7;
    for (int i = 0; i < 8; ++i) { const int base = (i >> 1) * 16; const int qb = (i & 1) ? base + 15 - s : base + s;
        attn_unit(F, bg >> 2, bg & 3, qb); }
}
#undef ATT_WAIT_BAR
#undef ATT_LGKM_BAR
}

#ifndef MK_PER_PHASE
#define MK_PER_PHASE 0
#endif
constexpr int N_PHASES = 24;
struct Args { const float* in[18]; float* out; unsigned char* ws; int ph_lo, ph_hi, li, pad; };

__global__ void __launch_bounds__(NWAVES * 64, 2) fwd_kernel(Args args) {
    extern __shared__ __attribute__((aligned(16))) unsigned char lds[];
    Frame F;
    F.lds = (LAS unsigned char*)lds;
    F.MISC = (volatile LAS unsigned*)(F.lds + MISC_OFF);
    refresh(F);
    F.G = gridDim.x; { const int bx = blockIdx.x; F.vcu = (F.G % 8 == 0) ? (bx % 8) * (F.G / 8) + bx / 8 : bx; }
    F.ws = args.ws; F.ctl = (gu32*)(args.ws + WS_CTL); F.out = args.out;
    for (int u = F.tid; u < (LDS_BYTES - LDSCTL_OFF) / 4; u += NWAVES * 64) ((LAS unsigned*)(F.lds + LDSCTL_OFF))[u] = 0u;
    __syncthreads();
    if (F.tid < 18) ((LAS unsigned long long*)(F.lds + PTR_OFF))[F.tid] = (unsigned long long)args.in[F.tid];
    __syncthreads();
    XcdBarrier bar = xcd_barrier_post((unsigned*)(F.ctl + CW_BAR) + args.li * XCD_BAR_WORDS, F.MISC + 8);
#define GRID_BAR() xcd_barrier(bar)
    const int lo = args.ph_lo, hi = args.ph_hi;
#ifndef PH_MASK
#define PH_MASK 0xFFFFFFu
#endif
#define IN(k) (((PH_MASK >> ((k) > 13 ? 13 + (((k) - 13) & 1) : (k))) & 1u) && lo <= (k) && (k) < hi)
#define BOTH(k) (IN(k) && IN((k) + 1))
#ifndef REP_MASK
#define REP_MASK 0u
#endif
#define REPS(k) (1 + (int)((REP_MASK >> ((k) > 13 ? 13 + (((k) - 13) & 1) : (k))) & 1u))
    unsigned char* ws = args.ws;
    float* R0 = (float*)(ws + WS_R0); bf16* XB = (bf16*)(ws + WS_XB);
    const int cblk = (int)blockIdx.x;

    if (IN(0)) for (int rep_ = 0; rep_ < REPS(0); ++rep_) { refresh(F); p0_prologue(F); if (BOTH(0)) GRID_BAR(); }
    if (IN(1)) for (int rep_ = 0; rep_ < REPS(1); ++rep_) { refresh(F);
        pg8::Gemm g{(const bf16*)(ws + WS_APOOL), (const bf16*)(ws + W_POOL), D, 256, 256}; ep::PoolOrder S{F.G, cblk};
        ep::EpiPool E{F.inp(I_X), F.inp(I_POOLS), R0};
        pg8::gemm_phase<ep::EpiPool, ep::PoolOrder, true, false>(F.lds + RING_OFF, g, S, E);
        if (BOTH(1)) GRID_BAR(); }
    if (IN(2)) for (int rep_ = 0; rep_ < REPS(2); ++rep_) { refresh(F); ln_phase(F, R0, F.inp(I_LNG) + 0 * D, F.inp(I_LNB) + 0 * D, R0, XB); if (BOTH(2)) GRID_BAR(); }
    if (IN(3)) for (int rep_ = 0; rep_ < REPS(3); ++rep_) { refresh(F);
        pg8::Gemm g{XB, (const bf16*)(ws + W_FGU), D, D, D}; ep::DenseOrder S{T / 256, 2 * DFF / 256, F.G, cblk, (size_t)256 * D * 2, (size_t)256 * D * 2};
        ep::EpiSwiGLU E{(bf16*)(ws + WS_H1), DFF, 0};
        pg8::gemm_phase(F.lds + RING_OFF, g, S, E);
        if (BOTH(3)) GRID_BAR(); }
    if (IN(4)) for (int rep_ = 0; rep_ < REPS(4); ++rep_) { refresh(F);
        pg8::Gemm g{(const bf16*)(ws + WS_H1), (const bf16*)(ws + W_FDN), DFF, DFF, DFF}; ep::DenseOrder S{T / 256, D / 256, F.G, cblk, (size_t)256 * DFF * 2, (size_t)256 * DFF * 2};
        ep::EpiResid E{R0};
        pg8::gemm_phase(F.lds + RING_OFF, g, S, E);
        if (BOTH(4)) GRID_BAR(); }
    if (IN(5)) for (int rep_ = 0; rep_ < REPS(5); ++rep_) { refresh(F); ln_phase(F, R0, F.inp(I_LNG) + 1 * D, F.inp(I_LNB) + 1 * D, R0, XB); if (BOTH(5)) GRID_BAR(); }
    if (IN(6)) for (int rep_ = 0; rep_ < REPS(6); ++rep_) { refresh(F);
        pg8::Gemm g{XB, (const bf16*)(ws + W_IN), D, D, D}; ep::DenseOrder S{T / 256, INP_PAD / 256, F.G, cblk, (size_t)256 * D * 2, (size_t)256 * D * 2};
        ep::EpiInProj E{(bf16*)(ws + WS_Q), (bf16*)(ws + WS_KV6), (float*)(ws + WS_GATES), (const float*)(ws + WS_ROPE), (const float*)(ws + WS_ROPE) + SEQ * 32};
        pg8::gemm_phase(F.lds + RING_OFF, g, S, E);
        if (BOTH(6)) GRID_BAR(); }
    if (IN(7)) for (int rep_ = 0; rep_ < REPS(7); ++rep_) { refresh(F);
        pg8::Gemm g{(const bf16*)(ws + WS_KV6), (const bf16*)(ws + W_C1), 1024, 2048, 512}; ep::CmpOrder S{F.G, cblk};
        ep::EpiCPart E{(float*)(ws + WS_CPART)};
        pg8::gemm_phase(F.lds + RING_OFF, g, S, E);
        if (BOTH(7)) GRID_BAR(); }
    if (IN(8)) for (int rep_ = 0; rep_ < REPS(8); ++rep_) { refresh(F); compress_finish_phase(F); if (BOTH(8)) GRID_BAR(); }
    if (IN(9)) for (int rep_ = 0; rep_ < REPS(9); ++rep_) { refresh(F); att::attn_phase(F); if (BOTH(9)) GRID_BAR(); }
    if (IN(10)) for (int rep_ = 0; rep_ < REPS(10); ++rep_) { refresh(F);
        pg8::Gemm g{(const bf16*)(ws + WS_AO), (const bf16*)(ws + W_OUT), D, D, D}; ep::DenseOrder S{T / 256, D / 256, F.G, cblk, (size_t)256 * D * 2, (size_t)256 * D * 2};
        ep::EpiResid E{R0};
        pg8::gemm_phase(F.lds + RING_OFF, g, S, E);
        if (BOTH(10)) GRID_BAR(); }
    if (IN(11)) for (int rep_ = 0; rep_ < REPS(11); ++rep_) { refresh(F); ln_router_phase(F, R0, F.inp(I_LNG) + 2 * D, F.inp(I_LNB) + 2 * D, XB); if (BOTH(11)) GRID_BAR(); }
    if (IN(12)) for (int rep_ = 0; rep_ < REPS(12); ++rep_) { refresh(F); moe_dispatch_phase(F); if (BOTH(12)) GRID_BAR(); }
    for (int ch = 0; ch < MOE_NCH; ++ch) {
        const int p1 = 13 + 2 * ch, p2 = p1 + 1;
        const LAS int* mt = (const LAS int*)(F.lds + MOET_OFF);
        if (IN(p1)) for (int rep_ = 0; rep_ < REPS(p1); ++rep_) { refresh(F);
            if (lo == p1) moe_tables(F);
            const int NT = mt[24], tile0 = MOE_CH * ch, nM = (NT - tile0) < MOE_CH ? (NT - tile0) : MOE_CH;
            if (nM > 0) {
                pg8::Gemm g{(const bf16*)(ws + WS_XS), (const bf16*)(ws + W_MGU), D, D, D};
                ep::MoeOrder<2 * DFE / 256> S{nM, F.G, cblk, tile0, mt + 32, (size_t)256 * D * 2, (size_t)2 * DFE * D * 2, (size_t)256 * D * 2, false};
                ep::EpiSwiGLU E{(bf16*)(ws + WS_H2), DFE, tile0};
                pg8::gemm_phase(F.lds + RING_OFF, g, S, E);
                if (BOTH(p1)) GRID_BAR(); } }
        if (IN(p2)) for (int rep_ = 0; rep_ < REPS(p2); ++rep_) { refresh(F);
            if (lo == p2) moe_tables(F);
            const int NT = mt[24], tile0 = MOE_CH * ch, nM = (NT - tile0) < MOE_CH ? (NT - tile0) : MOE_CH;
            if (nM > 0) {
                pg8::Gemm g{(const bf16*)(ws + WS_H2), (const bf16*)(ws + W_MDN), DFE, DFE, DFE};
                ep::MoeOrder<D / 256> S{nM, F.G, cblk, tile0, mt + 32, (size_t)256 * DFE * 2, (size_t)D * DFE * 2, (size_t)256 * DFE * 2, true};
                ep::EpiMoeDown E{(bf16*)(ws + WS_Y), (const int*)(ws + WS_SDST), (const float*)(ws + WS_SW)};
                pg8::gemm_phase(F.lds + RING_OFF, g, S, E);
                if (BOTH(p2)) GRID_BAR(); } }
    }
    if (IN(23)) for (int rep_ = 0; rep_ < REPS(23); ++rep_) { refresh(F); final_phase(F, R0, F.inp(I_LNG) + 3 * D, F.inp(I_LNB) + 3 * D, F.out); }
#undef IN
#undef BOTH
#undef GRID_BAR
}

extern "C" void kernel_launch(void* const* d_in, const int* in_sizes, int n_in, void* d_out, int out_size, void* d_ws, size_t ws_size, hipStream_t stream) {
    static int grid = 0;
    if (grid == 0) {
        if (n_in != 18 || in_sizes[0] != T * D || out_size != T * D || ws_size < WS_END) { fprintf(stderr, "kernel_launch: shape/workspace mismatch (n_in %d, ws %zu)\n", n_in, ws_size); grid = -1; return; }
        int dev = 0, cus = 0, per_cu = 0;
        if (hipGetDevice(&dev) != hipSuccess || hipDeviceGetAttribute(&cus, hipDeviceAttributeMultiprocessorCount, dev) != hipSuccess) { grid = -1; return; }
        if (hipFuncSetAttribute((const void*)fwd_kernel, hipFuncAttributeMaxDynamicSharedMemorySize, LDS_BYTES) != hipSuccess) { fprintf(stderr, "kernel_launch: hipFuncSetAttribute failed\n"); grid = -1; return; }
        if (hipOccupancyMaxActiveBlocksPerMultiprocessor(&per_cu, (const void*)fwd_kernel, NWAVES * 64, LDS_BYTES) != hipSuccess || per_cu < 1) { fprintf(stderr, "kernel_launch: occupancy query says %d blocks per CU\n", per_cu); }
        (void)hipGetLastError();
        if (cus != 256) { fprintf(stderr, "kernel_launch: built for 256 CUs, device has %d\n", cus); grid = -1; return; }
        grid = 256;
    }
    if (grid < 0) return;
    if (hipMemsetAsync((char*)d_ws + WS_CTL, 0, CTL_ZERO_BYTES, stream) != hipSuccess) return;
    Args a{};
    for (int i = 0; i < 18; ++i) a.in[i] = (const float*)d_in[i];
    a.out = (float*)d_out; a.ws = (unsigned char*)d_ws;
#if MK_PER_PHASE
    for (int p = 0; p < N_PHASES; ++p) { a.ph_lo = p; a.ph_hi = p + 1; a.li = p; hipLaunchKernelGGL(fwd_kernel, dim3(grid), dim3(NWAVES * 64), LDS_BYTES, stream, a); }
#else
    a.ph_lo = 0; a.ph_hi = N_PHASES; a.li = 0;
    hipLaunchKernelGGL(fwd_kernel, dim3(grid), dim3(NWAVES * 64), LDS_BYTES, stream, a);
#endif
}
```

```cpp
#include <hip/hip_runtime.h>
#include <cstdio>
#include <cstdint>

namespace pg8 {
#define PG8_LAS __attribute__((address_space(3)))
typedef unsigned short bf16_t;
typedef short bf16x8 __attribute__((ext_vector_type(8)));
typedef float f32x4 __attribute__((ext_vector_type(4)));
typedef float f32x2 __attribute__((ext_vector_type(2)));
typedef unsigned u32x4 __attribute__((ext_vector_type(4)));
typedef unsigned u32x2 __attribute__((ext_vector_type(2)));
constexpr int BM = 256, BK = 64, HALF = 128, HTB = HALF * BK * 2  , STAGE_BYTES = 8 * HTB, NXCD = 8, WGM = 8;

__host__ __device__ __forceinline__ int lds_byte(int r, int c) { const int st = (r >> 4) * 2 + (c >> 5), rr = r & 15, cc = c & 31, ob = rr * 64 + cc * 2; return st * 1024 + (ob ^ (((ob >> 9) & 1) << 5)); }
__host__ __device__ __forceinline__ void stage_rc(int b, int& R, int& C) { const int st = b / 1024, sb = b % 1024, swz = sb ^ (((sb >> 9) & 1) << 5); R = (st >> 1) * 16 + swz / 64; C = (st & 1) * 32 + (swz % 64) / 2; }
__host__ __device__ __forceinline__ int perm32(int rho) { const int n = rho >> 4, i = rho & 15; return 8 * (i >> 2) + 4 * n + (i & 3); }

struct Unit { int pm, pn; size_t aoff, boff; };
struct Gemm { const bf16_t* A; const bf16_t* Bt; int lda, ldb, K; };

__device__ __forceinline__ void order_tile(int L, int nM, int nN, int& pm, int& pn) {
    const int nwg = nM * nN; int wgid = L;
    { const int q = nwg / NXCD, r = nwg % NXCD, xcd = wgid % NXCD, off = wgid / NXCD; wgid = (xcd < r ? xcd * (q + 1) : r * (q + 1) + (xcd - r) * q) + off; }
    const int nig = WGM * nN, gid = wgid / nig, fm = gid * WGM, gsz = (nM - fm) < WGM ? (nM - fm) : WGM;
    pm = fm + ((wgid % nig) % gsz); pn = (wgid % nig) / gsz;
}

__device__ __forceinline__ unsigned cvt_pk_bf16(float lo, float hi) { unsigned r; asm volatile("v_cvt_pk_bf16_f32 %0, %1, %2" : "=v"(r) : "v"(lo), "v"(hi)); return r; }

template <class Epi, class Sched, bool ALIGN_EPI = true, bool SP2 = true>
__device__ __forceinline__ void gemm_phase(PG8_LAS unsigned char* lds, const Gemm g, const Sched& S, const Epi& E) {
    int tid = threadIdx.x; asm volatile("" : "+v"(tid));
    const int wid = __builtin_amdgcn_readfirstlane(tid >> 6), lane = tid & 63, wr = wid >> 2, wc = wid & 3, fr = lane & 15, fq = lane >> 4;
    const int K = g.K, nt = K / BK;
    unsigned voffA[2], voffB[2];
#pragma unroll
    for (int i = 0; i < 2; ++i) { int R, C; stage_rc(tid * 16 + i * 8192, R, C); const int Rb = Epi::PERM ? ((R & ~31) + perm32(R & 31)) : R;
        voffA[i] = (unsigned)(R * g.lda + C) * 2u; voffB[i] = (unsigned)(Rb * g.ldb + C) * 2u; }
    const size_t kstep = (size_t)(BK * 2);
    const size_t hstepA = (size_t)HALF * g.lda * 2, hstepB = (size_t)HALF * g.ldb * 2;
    const unsigned ldsw = (unsigned)wid * 1024u;
    const int aoff = lds_byte(wr * 64 + fr, fq * 8), boff = lds_byte(wc * 32 + fr, fq * 8);
#define PG8_SA(b, h) (((b) * 2 + (h)) * HTB)
#define PG8_SB(b, h) ((4 + (b) * 2 + (h)) * HTB)
#define PG8_STAGE(bufoff, gbase, voff) do { _Pragma("unroll") for (int _i = 0; _i < 2; ++_i) \
        __builtin_amdgcn_global_load_lds((const unsigned*)((const char*)(gbase) + (voff)[_i]), (PG8_LAS unsigned*)(lds + (bufoff) + ldsw + _i * 8192), 16, 0, 0); } while (0)
#define PG8_LDA(dst, b, h) do { _Pragma("unroll") for (int m = 0; m < 4; ++m) _Pragma("unroll") for (int k = 0; k < 2; ++k) dst[m][k] = *(const PG8_LAS bf16x8*)(lds + PG8_SA(b, h) + aoff + m * 2048 + k * 1024); } while (0)
#define PG8_LDB(dst, b, h) do { _Pragma("unroll") for (int n = 0; n < 2; ++n) _Pragma("unroll") for (int k = 0; k < 2; ++k) dst[n][k] = *(const PG8_LAS bf16x8*)(lds + PG8_SB(b, h) + boff + n * 2048 + k * 1024); } while (0)
#define PG8_MMA(ai, bj, At, Bt) do { __builtin_amdgcn_s_setprio(1); _Pragma("unroll") for (int m = 0; m < 4; ++m) _Pragma("unroll") for (int n = 0; n < 2; ++n) _Pragma("unroll") for (int k = 0; k < 2; ++k) \
        acc[ai][bj][m][n] = __builtin_amdgcn_mfma_f32_16x16x32_bf16(Bt[n][k], At[m][k], acc[ai][bj][m][n], 0, 0, 0); __builtin_amdgcn_s_setprio(0); } while (0)
#define PG8_WAIT_V(n) asm volatile("s_waitcnt vmcnt(" #n ")" ::: "memory")
#define PG8_WAIT_L(n) asm volatile("s_waitcnt lgkmcnt(" #n ")" ::: "memory")
#define PG8_BAR __builtin_amdgcn_s_barrier()
#define PG8_SCHED __builtin_amdgcn_sched_barrier(0)
    Unit cur, nxt; int ui = 0;
    if (!S.next(0, cur)) return;
    f32x4 acc[2][2][4][2];
#pragma unroll
    for (int a = 0; a < 2; ++a)
#pragma unroll
        for (int b = 0; b < 2; ++b)
#pragma unroll
            for (int m = 0; m < 4; ++m)
#pragma unroll
                for (int n = 0; n < 2; ++n) acc[a][b][m][n] = (f32x4){0.f, 0.f, 0.f, 0.f};
    bf16x8 At[4][2], B0[2][2], B1[2][2];
    const char* cA = (const char*)g.A + cur.aoff; const char* cB = (const char*)g.Bt + cur.boff;
    if constexpr (SP2) {
        PG8_STAGE(PG8_SB(0, 0), cB, voffB); PG8_STAGE(PG8_SB(0, 1), cB + hstepB, voffB); PG8_STAGE(PG8_SA(0, 0), cA, voffA); PG8_STAGE(PG8_SA(0, 1), cA + hstepA, voffA);
        if (wr == 1) PG8_BAR;
        PG8_WAIT_V(2); PG8_BAR;
        PG8_STAGE(PG8_SB(1, 0), cB + kstep, voffB); PG8_STAGE(PG8_SA(1, 0), cA + kstep, voffA); PG8_STAGE(PG8_SB(1, 1), cB + hstepB + kstep, voffB);
        PG8_WAIT_V(6); PG8_BAR;
    } else {
        PG8_STAGE(PG8_SB(0, 0), cB, voffB); PG8_STAGE(PG8_SA(0, 0), cA, voffA); PG8_STAGE(PG8_SB(0, 1), cB + hstepB, voffB); PG8_STAGE(PG8_SA(0, 1), cA + hstepA, voffA);
        if (wr == 1) PG8_BAR;
        PG8_WAIT_V(4); PG8_BAR;
        PG8_STAGE(PG8_SB(1, 0), cB + kstep, voffB); PG8_STAGE(PG8_SA(1, 0), cA + kstep, voffA); PG8_STAGE(PG8_SB(1, 1), cB + hstepB + kstep, voffB);
        PG8_WAIT_V(6); PG8_BAR;
    }
    for (;;) {
        const bool has_next = S.next(ui + 1, nxt);
        const char* nA = has_next ? (const char*)g.A + nxt.aoff : cA; const char* nB = has_next ? (const char*)g.Bt + nxt.boff : cB;
        for (int t = 0; t < nt; t += 2) {
            const bool last = (t == nt - 2);
            const char* a1 = cA + (size_t)(t + 1) * kstep;
            const char* a2 = last ? nA : cA + (size_t)(t + 2) * kstep; const char* b2 = last ? nB : cB + (size_t)(t + 2) * kstep;
            const char* a3 = a2 + kstep; const char* b3 = b2 + kstep;
            if constexpr (SP2) {
            PG8_LDB(B0, 0, 0); PG8_LDB(B1, 0, 1); PG8_SCHED; PG8_LDA(At, 0, 0); PG8_STAGE(PG8_SA(1, 1), a1 + hstepA, voffA);
            PG8_WAIT_V(8); PG8_WAIT_L(0); PG8_BAR; PG8_MMA(0, 0, At, B0); PG8_MMA(0, 1, At, B1); PG8_BAR; PG8_SCHED;
            PG8_LDA(At, 0, 1); PG8_STAGE(PG8_SB(0, 0), b2, voffB); PG8_STAGE(PG8_SB(0, 1), b2 + hstepB, voffB); PG8_STAGE(PG8_SA(0, 0), a2, voffA);
            PG8_WAIT_V(8); PG8_WAIT_L(0); PG8_BAR; PG8_MMA(1, 0, At, B0); PG8_MMA(1, 1, At, B1); PG8_BAR; PG8_SCHED;
            PG8_LDB(B0, 1, 0); PG8_LDB(B1, 1, 1); PG8_SCHED; PG8_LDA(At, 1, 0); PG8_STAGE(PG8_SA(0, 1), a2 + hstepA, voffA);
            PG8_WAIT_V(8); PG8_WAIT_L(0); PG8_BAR; PG8_MMA(0, 0, At, B0); PG8_MMA(0, 1, At, B1); PG8_BAR; PG8_SCHED;
            PG8_LDA(At, 1, 1); PG8_STAGE(PG8_SB(1, 0), b3, voffB); PG8_STAGE(PG8_SB(1, 1), b3 + hstepB, voffB); PG8_STAGE(PG8_SA(1, 0), a3, voffA);
            PG8_WAIT_V(8); PG8_WAIT_L(0); PG8_BAR; PG8_MMA(1, 0, At, B0); PG8_MMA(1, 1, At, B1); PG8_BAR; PG8_SCHED;
            } else {
            PG8_LDB(B0, 0, 0); PG8_SCHED; PG8_LDA(At, 0, 0); PG8_STAGE(PG8_SA(1, 1), a1 + hstepA, voffA);
            PG8_WAIT_L(8); PG8_BAR; PG8_WAIT_L(0); PG8_MMA(0, 0, At, B0); PG8_BAR; PG8_SCHED;
            PG8_LDB(B1, 0, 1); PG8_STAGE(PG8_SB(0, 0), b2, voffB);
            PG8_BAR; PG8_WAIT_L(0); PG8_MMA(0, 1, At, B1); PG8_BAR;
            PG8_LDA(At, 0, 1); PG8_STAGE(PG8_SA(0, 0), a2, voffA);
            PG8_BAR; PG8_WAIT_L(0); PG8_MMA(1, 0, At, B0); PG8_BAR; PG8_SCHED;
            PG8_STAGE(PG8_SB(0, 1), b2 + hstepB, voffB);
            PG8_WAIT_V(6); PG8_BAR; PG8_MMA(1, 1, At, B1); PG8_BAR;
            PG8_LDB(B0, 1, 0); PG8_SCHED; PG8_LDA(At, 1, 0); PG8_STAGE(PG8_SA(0, 1), a2 + hstepA, voffA);
            PG8_WAIT_L(8); PG8_BAR; PG8_WAIT_L(0); PG8_MMA(0, 0, At, B0); PG8_BAR; PG8_SCHED;
            PG8_LDB(B1, 1, 1); PG8_STAGE(PG8_SB(1, 0), b3, voffB);
            PG8_BAR; PG8_WAIT_L(0); PG8_MMA(0, 1, At, B1); PG8_BAR;
            PG8_LDA(At, 1, 1); PG8_STAGE(PG8_SA(1, 0), a3, voffA);
            PG8_BAR; PG8_WAIT_L(0); PG8_MMA(1, 0, At, B0); PG8_BAR; PG8_SCHED;
            PG8_STAGE(PG8_SB(1, 1), b3 + hstepB, voffB);
            PG8_WAIT_V(6); PG8_BAR; PG8_MMA(1, 1, At, B1); PG8_BAR;
            }
        }
        if constexpr (ALIGN_EPI) { if (wr == 0) PG8_BAR; }
        E(acc, cur, wr, wc, fr, fq);
        if (!has_next) break;
#pragma unroll
        for (int a = 0; a < 2; ++a)
#pragma unroll
            for (int b = 0; b < 2; ++b)
#pragma unroll
                for (int m = 0; m < 4; ++m)
#pragma unroll
                    for (int n = 0; n < 2; ++n) acc[a][b][m][n] = (f32x4){0.f, 0.f, 0.f, 0.f};
        cur = nxt; cA = nA; cB = nB; ++ui;
        if constexpr (ALIGN_EPI) { if (wr == 1) PG8_BAR; }
    }
    PG8_WAIT_V(0);
    if constexpr (!ALIGN_EPI) { if (wr == 0) PG8_BAR; }
    PG8_BAR;
#undef PG8_SA
#undef PG8_SB
#undef PG8_STAGE
#undef PG8_LDA
#undef PG8_LDB
#undef PG8_MMA
#undef PG8_WAIT_V
#undef PG8_WAIT_L
#undef PG8_BAR
#undef PG8_SCHED
}
}

constexpr int NWAVES = 8;
constexpr int BATCH = 8, SEQ = 4096, D = 1024, T = BATCH * SEQ;
constexpr int DFF = 2816, NE = 8, DFE = 3584, INP = 2608, INP_PAD = 2816;
constexpr int NH = 16, NG = 4, HD = 64;
constexpr float LN_EPS = 1e-5f;
constexpr float ALPHA = 1.4142135623730951f;
constexpr float QSCALE = 0.125f * 1.4426950408889634f;
constexpr int MOE_CH = 64;
constexpr int MOE_MAXT = 264;
constexpr int MOE_NCH = 5;

constexpr size_t MiB = 1u << 20;
constexpr size_t WS_CTL = 0, CTL_ZERO_BYTES = 1 * MiB;
constexpr size_t WS_ROPE = 1 * MiB;
constexpr size_t WS_MISC = 2 * MiB;
constexpr size_t WS_SEL = 3 * MiB;
constexpr size_t WS_SDST = 4 * MiB;
constexpr size_t WS_SW = 5 * MiB;
constexpr size_t WS_KVC = 6 * MiB;
constexpr size_t WS_CPART = 8 * MiB;
constexpr size_t WS_GATES = 40 * MiB;
constexpr size_t W_POOL = 48 * MiB, W_FGU = 49 * MiB, W_FDN = 60 * MiB, W_IN = 66 * MiB, W_C1 = 72 * MiB, W_OUT = 74 * MiB, W_MGU = 76 * MiB, W_MDN = 188 * MiB;
constexpr size_t WS_R0 = 256 * MiB;
constexpr size_t WS_XB = 384 * MiB;
constexpr size_t WS_BIG = 448 * MiB;
constexpr size_t WS_APOOL = WS_BIG, WS_H1 = 512 * MiB;
constexpr size_t WS_Q = WS_BIG, WS_KV6 = 512 * MiB, WS_AO = 616 * MiB;
constexpr size_t WS_XS = WS_BIG, WS_H2 = 580 * MiB, WS_Y = 692 * MiB;
constexpr size_t WS_END = 820 * MiB;
constexpr size_t KV6_STRIDE = (size_t)T * 256;
static_assert(W_MGU + (size_t)NE * 2 * DFE * D * 2 <= W_MDN && W_MDN + (size_t)NE * D * DFE * 2 <= WS_R0, "weights map");
static_assert(WS_H1 + (size_t)T * DFF * 2 <= WS_END && WS_XS + (size_t)MOE_MAXT * 256 * D * 2 <= WS_H2 && WS_H2 + (size_t)MOE_CH * 256 * DFE * 2 <= WS_Y && WS_Y + (size_t)T * 2 * D * 2 <= WS_END, "big map");
constexpr int CW_TMO = 0, CW_BAR = 4096;
constexpr int N_BAR_REGIONS = 28;

constexpr int RING_OFF = 0, RING_BYTES = 155648;
constexpr int LDSCTL_OFF = RING_BYTES, MISC_OFF = LDSCTL_OFF + 320;
constexpr int PTR_OFF = RING_BYTES + 512;
constexpr int MOET_OFF = RING_BYTES + 1024;
constexpr int LDS_BYTES = 163840;

#define GAS __attribute__((address_space(1)))
#define LAS __attribute__((address_space(3)))
typedef unsigned short bf16;
typedef unsigned v4u __attribute__((ext_vector_type(4)));
typedef unsigned v2u __attribute__((ext_vector_type(2)));
typedef float f32x4 __attribute__((ext_vector_type(4)));
typedef float f32x2 __attribute__((ext_vector_type(2)));
typedef short bf16x8 __attribute__((ext_vector_type(8)));
typedef GAS unsigned gu32;
#define RLX_AGENT __ATOMIC_RELAXED, __HIP_MEMORY_SCOPE_AGENT
#define LDS_WAIT() asm volatile("s_waitcnt lgkmcnt(0)" ::: "memory")
#define VM_WAIT() asm volatile("s_waitcnt vmcnt(0)" ::: "memory")
__device__ __forceinline__ unsigned f2bf(float f) { unsigned u = __builtin_bit_cast(unsigned, f); return (u + 0x7fffu + ((u >> 16) & 1u)) >> 16; }
__device__ __forceinline__ unsigned pk2(float lo, float hi) { return f2bf(lo) | (f2bf(hi) << 16); }
__device__ __forceinline__ float bf2f(unsigned h) { return __builtin_bit_cast(float, h << 16); }

#define XB_TMO      128
#define XB_XCNT(j)  (256  + 64 * (j))
#define XB_XSUB(j)  (1280 + 64 * (j))
#define XB_XGEN(j)  (2304 + 64 * (j))
#define XB_TOP      3328
#define XB_TOPGEN   3392
#define XCD_BAR_WORDS 3456
#define XB_SPIN_CAP (1u << 18)
__device__ __forceinline__ unsigned xb_ld(unsigned* p)              { return __hip_atomic_load(p, __ATOMIC_RELAXED, __HIP_MEMORY_SCOPE_AGENT); }
__device__ __forceinline__ unsigned xb_add(unsigned* p, unsigned v) { return __hip_atomic_fetch_add(p, v, __ATOMIC_RELAXED, __HIP_MEMORY_SCOPE_AGENT); }
__device__ __forceinline__ unsigned xb_xcc_id() { return (unsigned)__builtin_amdgcn_s_getreg((3 << 11) | 20) & 0xFu; }
#define XB_SPIN(cond, bar) do { unsigned _sp = 0; while (cond) { __builtin_amdgcn_s_sleep(1); \
    if ((++_sp & 255u) == 0u) { if (xb_ld(&(bar)[XB_TMO])) break; if (_sp > XB_SPIN_CAP) { atomicAdd(&(bar)[XB_TMO], 1u); break; } } } } while (0)
struct XcdBarrier { unsigned* bar; unsigned x; volatile LAS unsigned* st; };
__device__ __forceinline__ XcdBarrier xcd_barrier_post(unsigned* bar, volatile LAS unsigned* st) {
    XcdBarrier b; b.bar = bar; b.x = xb_xcc_id(); b.st = st;
    if (threadIdx.x == 0) (void)xb_add(&bar[XB_XCNT(b.x)], 1u);
    return b;
}
__device__ __forceinline__ void xcd_barrier_complete(unsigned* bar, unsigned x, unsigned& nloc, unsigned& nx) {
    const unsigned G = gridDim.x * gridDim.y * gridDim.z;
    unsigned sum, cnt, mine, sp = 0u;
    for (;;) {
        sum = 0u; cnt = 0u; mine = 0u;
#pragma unroll
        for (unsigned j = 0; j < 16; ++j) { const unsigned c = xb_ld(&bar[XB_XCNT(j)]); sum += c; cnt += (c > 0u) ? 1u : 0u; mine = (j == x) ? c : mine; }
        if (sum == G) break;
        __builtin_amdgcn_s_sleep(1);
        if ((++sp & 255u) == 0u) { if (xb_ld(&bar[XB_TMO])) break; if (sp > XB_SPIN_CAP) { atomicAdd(&bar[XB_TMO], 1u); break; } }
    }
    nloc = mine > 0u ? mine : 1u; nx = cnt > 0u ? cnt : 1u;
}
__device__ __forceinline__ void xcd_barrier(const XcdBarrier& b) {
    asm volatile("s_waitcnt vmcnt(0)" ::: "memory");
    __syncthreads();
    if (threadIdx.x == 0) {
        unsigned* bar = b.bar;
        __builtin_amdgcn_s_waitcnt(0);
        unsigned nloc = b.st[0], nx = b.st[1];
        if (nloc == 0u) { xcd_barrier_complete(bar, b.x, nloc, nx); b.st[0] = nloc; b.st[1] = nx; }
        const unsigned old = xb_add(&bar[XB_XSUB(b.x)], 1u);
        const unsigned gen = old / nloc;
        if (old + 1u == (gen + 1u) * nloc) {
            __builtin_amdgcn_fence(__ATOMIC_RELEASE, "agent");
            asm volatile("s_waitcnt vmcnt(0)" ::: "memory");
            const unsigned og = xb_add(&bar[XB_TOP], 1u);
            const unsigned tg = og / nx;
            if (og + 1u == (tg + 1u) * nx) xb_add(&bar[XB_TOPGEN], 1u);
            else XB_SPIN(xb_ld(&bar[XB_TOPGEN]) == tg, bar);
            __builtin_amdgcn_fence(__ATOMIC_ACQUIRE, "agent");
            xb_add(&bar[XB_XGEN(b.x)], 1u);
            asm volatile("s_waitcnt vmcnt(0)" ::: "memory");
        } else {
            XB_SPIN(xb_ld(&bar[XB_XGEN(b.x)]) == gen, bar);
            __builtin_amdgcn_fence(__ATOMIC_ACQUIRE, "agent");
            asm volatile("s_waitcnt vmcnt(0)" ::: "memory");
        }
    }
    __syncthreads();
}

struct Frame {
    LAS unsigned char* lds;
    volatile LAS unsigned* MISC;
    gu32* ctl;
    unsigned char* ws;
    int tid, lane, wave;
    int vcu, G;
    float* out;
    __device__ __forceinline__ const float* inp(int i) const {
        const unsigned long long v = ((const LAS unsigned long long*)(lds + PTR_OFF))[i];
        const unsigned lo = __builtin_amdgcn_readfirstlane((unsigned)v), hi = __builtin_amdgcn_readfirstlane((unsigned)(v >> 32));
        return (const float*)(((unsigned long long)hi << 32) | lo); }
};
enum { I_X = 0, I_LNG, I_LNB, I_POOLW, I_POOLS, I_WIN, I_PEK, I_W1K, I_W2K, I_PEV, I_W1V, I_W2V, I_WOUT, I_FGU, I_FDN, I_ROUTER, I_MGU, I_MDN };

__device__ __forceinline__ void refresh(Frame& F) { int t = threadIdx.x; asm volatile("" : "+v"(t)); F.tid = t; F.lane = t & 63; F.wave = __builtin_amdgcn_readfirstlane(t >> 6); }
__device__ __forceinline__ float wave_sum(float v) {
#pragma unroll
    for (int o = 1; o < 64; o <<= 1) v += __shfl_xor(v, o);
    return v;
}
__device__ __forceinline__ float silu_f(float x) { return x * __builtin_amdgcn_rcpf(1.0f + __builtin_amdgcn_exp2f(-1.4426950408889634f * x)); }

__device__ __forceinline__ int wrow_map(int mode, int n, int Npad) {
    if (mode == 0) return n;
    if (mode == 1) { const int half = Npad >> 1; return n < half ? ((n >> 7) << 8) + (n & 127) : (((n - half) >> 7) << 8) + 128 + ((n - half) & 127); }
    const int tile = n >> 8, o = n & 255, head = o >> 6, hf = (o >> 5) & 1, i = o & 31;
    return (tile << 8) + 128 * (head >> 1) + 32 * (2 * (head & 1) + (i >> 4)) + 16 * hf + (i & 15);
}
struct WItem { const float* W; bf16* WT; int K, Nreal, Npad, mode, k0, n0; };
constexpr int W_NITEMS_POOL = 4 * 4 * 4, W_NI_FG = (D / 64) * (2 * DFF / 64), W_NI_FD = (DFF / 64) * (D / 64), W_NI_IN = (D / 64) * (INP_PAD / 64), W_NI_C1 = (2048 / 64) * (256 / 64), W_NI_WO = (D / 64) * (D / 64);
constexpr int W_NI_MG = (D / 64) * (2 * DFE / 64), W_NI_MD = (DFE / 64) * (D / 64);
constexpr int W_NITEMS = W_NITEMS_POOL + W_NI_FG + W_NI_FD + W_NI_IN + 2 * W_NI_C1 + W_NI_WO + NE * W_NI_MG + NE * W_NI_MD;
__device__ __forceinline__ WItem witem_decode(const Frame& F, int it) {
    WItem w; int r = it; int sub;
    unsigned char* ws = F.ws;
    if (r < W_NITEMS_POOL) { const int g = r / 16; sub = r % 16; w = WItem{F.inp(I_POOLW) + (size_t)g * 65536, (bf16*)(ws + W_POOL) + (size_t)g * 65536, 256, 256, 256, 0, 0, 0}; }
    else if ((r -= W_NITEMS_POOL) < W_NI_FG) { sub = r; w = WItem{F.inp(I_FGU), (bf16*)(ws + W_FGU), D, 2 * DFF, 2 * DFF, 1, 0, 0}; }
    else if ((r -= W_NI_FG) < W_NI_FD) { sub = r; w = WItem{F.inp(I_FDN), (bf16*)(ws + W_FDN), DFF, D, D, 0, 0, 0}; }
    else if ((r -= W_NI_FD) < W_NI_IN) { sub = r; w = WItem{F.inp(I_WIN), (bf16*)(ws + W_IN), D, INP, INP_PAD, 2, 0, 0}; }
    else if ((r -= W_NI_IN) < 2 * W_NI_C1) { const int kv = r / W_NI_C1; sub = r % W_NI_C1; w = WItem{F.inp(kv ? I_W1V : I_W1K), (bf16*)(ws + W_C1) + (size_t)kv * 256 * 2048, 2048, 128, 256, 0, 0, 0}; }
    else if ((r -= 2 * W_NI_C1) < W_NI_WO) { sub = r; w = WItem{F.inp(I_WOUT), (bf16*)(ws + W_OUT), D, D, D, 0, 0, 0}; }
    else if ((r -= W_NI_WO) < NE * W_NI_MG) { const int e = r / W_NI_MG; sub = r % W_NI_MG; w = WItem{F.inp(I_MGU) + (size_t)e * D * 2 * DFE, (bf16*)(ws + W_MGU) + (size_t)e * 2 * DFE * D, D, 2 * DFE, 2 * DFE, 1, 0, 0}; }
    else { r -= NE * W_NI_MG; const int e = r / W_NI_MD; sub = r % W_NI_MD; w = WItem{F.inp(I_MDN) + (size_t)e * DFE * D, (bf16*)(ws + W_MDN) + (size_t)e * D * DFE, DFE, D, D, 0, 0, 0}; }
    const int nblk = w.Npad / 64; w.k0 = 64 * (sub / nblk); w.n0 = 64 * (sub % nblk);
    return w;
}
__device__ __forceinline__ void witem_load(const WItem& w, int lane, f32x4 (&ld)[16]) {
    const int nn = w.n0 + 4 * (lane & 15); const bool ok = nn < w.Nreal;
    const float* base = w.W + (size_t)(w.k0 + 2 * (lane >> 4)) * w.Nreal + nn;
#pragma unroll
    for (int j = 0; j < 16; ++j) { const int kk = 8 * (j >> 1) + (j & 1); ld[j] = ok ? *(const GAS f32x4*)(base + (size_t)kk * w.Nreal) : (f32x4){0.f, 0.f, 0.f, 0.f}; }
}
__device__ __forceinline__ void witem_store(const WItem& w, int lane, const f32x4 (&ld)[16], LAS unsigned* scr) {
#pragma unroll
    for (int m = 0; m < 8; ++m) { const f32x4 a = ld[2 * m], b = ld[2 * m + 1]; LAS unsigned* d = scr + (4 * m + (lane >> 4)) * 66 + 4 * (lane & 15);
        *(LAS v2u*)d = (v2u){pg8::cvt_pk_bf16(a[0], b[0]), pg8::cvt_pk_bf16(a[1], b[1])}; *(LAS v2u*)(d + 2) = (v2u){pg8::cvt_pk_bf16(a[2], b[2]), pg8::cvt_pk_bf16(a[3], b[3])}; }
    LDS_WAIT(); asm volatile("" ::: "memory");
    const int c = lane & 7;
#pragma unroll
    for (int j = 0; j < 8; ++j) { const int n = (lane >> 3) + 8 * j; const LAS unsigned* s = scr + (4 * c) * 66 + n;
        const v4u o = (v4u){s[0], s[66], s[132], s[198]};
        *(GAS v4u*)(w.WT + (size_t)wrow_map(w.mode, w.n0 + n, w.Npad) * w.K + w.k0 + 8 * c) = o; }
    LDS_WAIT(); asm volatile("" ::: "memory");
}

__device__ __forceinline__ void p0_pool_operand(Frame& F) {
    const float* x = F.inp(I_X); bf16* AP = (bf16*)(F.ws + WS_APOOL);
    LAS f32x4* tile = (LAS f32x4*)(F.lds + RING_OFF);
    for (int unit = F.vcu; unit < (T / 64) * 4; unit += F.G) {
        const int rb = unit >> 2, g = unit & 3, w = 2 << g, t0 = rb * 64, s0 = t0 & (SEQ - 1);
        const int halo = (w - 1) < s0 ? (w - 1) : s0;
        __syncthreads();
        for (int idx = F.tid; idx < (64 + halo) * 64; idx += NWAVES * 64) { const int row = idx >> 6, c4 = idx & 63;
            tile[row * 64 + c4] = *(const GAS f32x4*)(x + (size_t)(t0 - halo + row) * D + g * 256 + c4 * 4); }
        __syncthreads();
#pragma unroll 2
        for (int k = 0; k < 8; ++k) { const int o = F.tid + k * 512, r = o >> 6, c4 = o & 63, s = s0 + r;
            const int cnt = (s + 1) < w ? (s + 1) : w;
            f32x4 sum = (f32x4){0.f, 0.f, 0.f, 0.f};
            for (int j = 0; j < cnt; ++j) sum += tile[(halo + r - j) * 64 + c4];
            const f32x4 cur = tile[(halo + r) * 64 + c4]; const float fc = (float)cnt;
            const f32x4 v = (f32x4){sum.x / fc, sum.y / fc, sum.z / fc, sum.w / fc} - cur;
            v2u pk; pk.x = pk2(v.x, v.y); pk.y = pk2(v.z, v.w);
            *(GAS v2u*)(AP + (size_t)(t0 + r) * D + g * 256 + c4 * 4) = pk; }
    }
    __syncthreads();
}

__device__ __forceinline__ void p0_prologue(Frame& F) {
    const int gw = F.vcu * NWAVES + F.wave, NGW = F.G * NWAVES;
    { float* rc = (float*)(F.ws + WS_ROPE); float* rs = rc + SEQ * 32;
      for (int idx = F.vcu * 512 + F.tid; idx < SEQ * 32; idx += F.G * 512) { const int pos = idx >> 5, i = idx & 31;
          const float fr = powf(10000.0f, -(float)i / 32.0f);
          const double ang = (double)((float)pos * fr);
          const double k = __builtin_rint(ang * 0.15915494309189535); const double r = ang - k * 6.283185307179586476925287, r2 = r * r;
          double sn = 1.0, cs = 1.0;
#pragma unroll
          for (int q = 12; q >= 1; --q) { sn = 1.0 - r2 * (1.0 / (double)((2 * q) * (2 * q + 1))) * sn; cs = 1.0 - r2 * (1.0 / (double)((2 * q - 1) * (2 * q))) * cs; }
          rc[idx] = (float)cs; rs[idx] = (float)(r * sn); } }
    if (F.vcu < 256) { const int kv = F.vcu >> 7, cc = F.vcu & 127; const float* pe = F.inp(kv == 0 ? I_PEK : I_PEV); const float* w1 = F.inp(kv == 0 ? I_W1K : I_W1V);
        LAS float* red = (LAS float*)(F.lds + RING_OFF + 98304);
        float s = 0.f;
#pragma unroll
        for (int q = 0; q < 4; ++q) { const int r = F.tid + 512 * q; s += pe[r] * w1[(size_t)r * 128 + cc]; }
        s = wave_sum(s); if (F.lane == 0) red[F.wave] = s; __syncthreads();
        if (F.tid == 0) ((float*)(F.ws + WS_MISC))[kv * 128 + cc] = ((red[0] + red[1]) + (red[2] + red[3])) + ((red[4] + red[5]) + (red[6] + red[7]));
        __syncthreads(); }
    p0_pool_operand(F);
    LAS unsigned* scr = (LAS unsigned*)(F.lds + RING_OFF + F.wave * 16384);
    int it = gw;
    if (it < W_NITEMS) {
        WItem cur = witem_decode(F, it); f32x4 la[16], lb[16]; witem_load(cur, F.lane, la);
        for (;;) {
            const int nx = it + NGW; const bool more = nx < W_NITEMS; WItem nxt = cur;
            if (more) { nxt = witem_decode(F, nx); witem_load(nxt, F.lane, lb); }
            witem_store(cur, F.lane, la, scr);
            if (!more) break;
#pragma unroll
            for (int j = 0; j < 16; ++j) la[j] = lb[j];
            cur = nxt; it = nx;
        }
    }
}

__device__ __forceinline__ void ln_phase(Frame& F, const float* src, const float* gam, const float* bet, float* dstf, bf16* dstb) {
    const int gw = F.vcu * NWAVES + F.wave, NGW = F.G * NWAVES;
    f32x4 gv[4], bv[4];
#pragma unroll
    for (int j = 0; j < 4; ++j) { gv[j] = *((const GAS f32x4*)gam + F.lane + 64 * j); bv[j] = *((const GAS f32x4*)bet + F.lane + 64 * j); }
    for (int m = gw; m < T; m += NGW) {
        const GAS f32x4* xr = (const GAS f32x4*)(src + (size_t)m * D) + F.lane;
        f32x4 v[4]; float s = 0.f;
#pragma unroll
        for (int j = 0; j < 4; ++j) { v[j] = xr[64 * j]; s += (v[j].x + v[j].y) + (v[j].z + v[j].w); }
        const float mean = wave_sum(s) * (1.f / D); float s2 = 0.f;
#pragma unroll
        for (int j = 0; j < 4; ++j) { v[j] = v[j] - mean; s2 += (v[j].x * v[j].x + v[j].y * v[j].y) + (v[j].z * v[j].z + v[j].w * v[j].w); }
        const float rstd = 1.f / sqrtf(wave_sum(s2) * (1.f / D) + LN_EPS);
        GAS f32x4* of = (GAS f32x4*)(dstf + (size_t)m * D) + F.lane;
#pragma unroll
        for (int j = 0; j < 4; ++j) { v[j] = v[j] * rstd * gv[j] + bv[j]; of[64 * j] = v[j]; }
        if (dstb) { GAS v2u* ob = (GAS v2u*)(dstb + (size_t)m * D) + F.lane;
#pragma unroll
            for (int j = 0; j < 4; ++j) { v2u pk; pk.x = pk2(v[j].x, v[j].y); pk.y = pk2(v[j].z, v[j].w); ob[64 * j] = pk; } }
    }
}

__device__ __forceinline__ void ln_router_phase(Frame& F, float* R0, const float* gam, const float* bet, bf16* dstb) {
    LAS float* rt = (LAS float*)(F.lds + RING_OFF);
    LAS unsigned* cnt = (LAS unsigned*)(F.lds + RING_OFF + 32768);
    const float* router = F.inp(I_ROUTER);
    for (int idx = F.tid; idx < 8192; idx += 512) { const int c = idx >> 3, e = idx & 7; rt[e * 1024 + c] = router[idx]; }
    if (F.tid < 8) cnt[F.tid] = 0u;
    __syncthreads();
    f32x4 gv[4], bv[4];
#pragma unroll
    for (int j = 0; j < 4; ++j) { gv[j] = *((const GAS f32x4*)gam + F.lane + 64 * j); bv[j] = *((const GAS f32x4*)bet + F.lane + 64 * j); }
    int* sel = (int*)(F.ws + WS_SEL);
    for (int k = 0; k < 16; ++k) {
        const int m = F.vcu * 128 + F.wave * 16 + k;
        const GAS f32x4* xr = (const GAS f32x4*)(R0 + (size_t)m * D) + F.lane;
        f32x4 v[4]; float s = 0.f;
#pragma unroll
        for (int j = 0; j < 4; ++j) { v[j] = xr[64 * j]; s += (v[j].x + v[j].y) + (v[j].z + v[j].w); }
        const float mean = wave_sum(s) * (1.f / D); float s2 = 0.f;
#pragma unroll
        for (int j = 0; j < 4; ++j) { v[j] = v[j] - mean; s2 += (v[j].x * v[j].x + v[j].y * v[j].y) + (v[j].z * v[j].z + v[j].w * v[j].w); }
        const float rstd = 1.f / sqrtf(wave_sum(s2) * (1.f / D) + LN_EPS);
        GAS f32x4* of = (GAS f32x4*)(R0 + (size_t)m * D) + F.lane;
        GAS v2u* ob = (GAS v2u*)(dstb + (size_t)m * D) + F.lane;
#pragma unroll
        for (int j = 0; j < 4; ++j) { v[j] = v[j] * rstd * gv[j] + bv[j]; of[64 * j] = v[j]; v2u pk; pk.x = pk2(v[j].x, v[j].y); pk.y = pk2(v[j].z, v[j].w); ob[64 * j] = pk; }
        float lg[8];
#pragma unroll
        for (int e = 0; e < 8; ++e) { float a = 0.f;
#pragma unroll
            for (int j = 0; j < 4; ++j) { const f32x4 r4 = *((const LAS f32x4*)(rt + e * 1024) + F.lane + 64 * j); a += (v[j].x * r4.x + v[j].y * r4.y) + (v[j].z * r4.z + v[j].w * r4.w); }
            lg[e] = wave_sum(a); }
        int i0 = 0; float v0 = lg[0];
#pragma unroll
        for (int e = 1; e < 8; ++e) if (lg[e] > v0) { v0 = lg[e]; i0 = e; }
        int i1 = -1; float v1 = -3.0e38f;
#pragma unroll
        for (int e = 0; e < 8; ++e) if (e != i0 && lg[e] > v1) { v1 = lg[e]; i1 = e; }
        const float ex = __expf(v1 - v0), w0 = 1.0f / (1.0f + ex), w1 = ex * w0;
        if (F.lane == 0) { *(GAS v4u*)(sel + (size_t)m * 4) = (v4u){(unsigned)i0, (unsigned)i1, __builtin_bit_cast(unsigned, w0), __builtin_bit_cast(unsigned, w1)};
            __hip_atomic_fetch_add(cnt + i0, 1u, __ATOMIC_RELAXED, __HIP_MEMORY_SCOPE_WORKGROUP); __hip_atomic_fetch_add(cnt + i1, 1u, __ATOMIC_RELAXED, __HIP_MEMORY_SCOPE_WORKGROUP); }
    }
    __syncthreads();
    if (F.tid < 8) ((unsigned*)(F.ws + WS_MISC + 4096))[F.vcu * 8 + F.tid] = cnt[F.tid];
}

__device__ __forceinline__ void moe_tables(Frame& F) {
    LAS int* cw = (LAS int*)(F.lds + RING_OFF + 65536);
    LAS int* mt = (LAS int*)(F.lds + MOET_OFF);
    const int* cg = (const int*)(F.ws + WS_MISC + 4096);
    __syncthreads();
    for (int idx = F.tid; idx < 2048; idx += 512) cw[idx] = __hip_atomic_load(cg + idx, RLX_AGENT);
    __syncthreads();
    { const int e = F.wave; int a[4]; int s = 0;
#pragma unroll
      for (int k = 0; k < 4; ++k) { a[k] = cw[(4 * F.lane + k) * 8 + e]; s += a[k]; }
      int inc = s;
#pragma unroll
      for (int o = 1; o < 64; o <<= 1) { const int y = __shfl_up(inc, o); if (F.lane >= o) inc += y; }
      if (F.lane == 63) mt[e] = inc;
      if (F.lane == (F.vcu >> 2)) { const int q = F.vcu & 3; mt[16 + e] = inc - s + (q > 0 ? a[0] : 0) + (q > 1 ? a[1] : 0) + (q > 2 ? a[2] : 0); } }
    __syncthreads();
    if (F.tid == 0) { int row = 0, tile = 0;
        for (int e = 0; e < 8; ++e) { mt[8 + e] = row; const int nt = (mt[e] + 255) >> 8; for (int i = 0; i < nt; ++i) mt[32 + tile + i] = e; tile += nt; row += nt << 8; }
        mt[24] = tile; }
    __syncthreads();
}

__device__ __forceinline__ void moe_dispatch_phase(Frame& F) {
    moe_tables(F);
    LAS int* mt = (LAS int*)(F.lds + MOET_OFF);
    LAS int* wcnt = (LAS int*)(F.lds + RING_OFF);
    LAS int* plist = (LAS int*)(F.lds + RING_OFF + 1024);
    const int* sel = (const int*)(F.ws + WS_SEL);
    int* sdst = (int*)(F.ws + WS_SDST); float* sw = (float*)(F.ws + WS_SW);
    const bf16* XB = (const bf16*)(F.ws + WS_XB); bf16* XS = (bf16*)(F.ws + WS_XS);
    int e = -1, rank = 0, t = 0, kk = 0; float wgt = 0.f;
    if (F.tid < 256) { const int tl = F.tid >> 1; kk = F.tid & 1; t = F.vcu * 128 + tl; e = sel[(size_t)t * 4 + kk]; wgt = __builtin_bit_cast(float, sel[(size_t)t * 4 + 2 + kk]);
#pragma unroll
        for (int ee = 0; ee < 8; ++ee) { const unsigned long long mk = __ballot(e == ee); if (e == ee) rank = __popcll(mk & ((1ull << F.lane) - 1ull)); if (F.lane == 0) wcnt[F.wave * 8 + ee] = __popcll(mk); } }
    __syncthreads();
    if (F.tid < 256) { int pre = 0; for (int w = 0; w < F.wave; ++w) pre += wcnt[w * 8 + e];
        const int pos = mt[8 + e] + mt[16 + e] + pre + rank;
        sdst[pos] = t * 2 + kk; sw[pos] = wgt; plist[F.tid] = pos; plist[256 + F.tid] = t; }
    __syncthreads();
    for (int q = F.wave * 32; q < F.wave * 32 + 32; ++q) { const int pos = plist[q], tt = plist[256 + q];
        const GAS v4u* s = (const GAS v4u*)(XB + (size_t)tt * D) + F.lane; GAS v4u* d = (GAS v4u*)(XS + (size_t)pos * D) + F.lane;
        const v4u a = s[0], b = s[64]; d[0] = a; d[64] = b; }
    if (F.vcu < 8) { const int ee = F.vcu, lo = mt[8 + ee] + mt[ee], hi = mt[8 + ee] + (((mt[ee] + 255) >> 8) << 8);
        for (int r = lo + F.wave; r < hi; r += NWAVES) { GAS v4u* d = (GAS v4u*)(XS + (size_t)r * D) + F.lane; d[0] = (v4u){0u, 0u, 0u, 0u}; d[64] = (v4u){0u, 0u, 0u, 0u}; if (F.lane == 0) { sdst[r] = -1; sw[r] = 0.f; } } }
}

__device__ __forceinline__ void final_phase(Frame& F, const float* R0, const float* gam, const float* bet, float* out) {
    const int gw = F.vcu * NWAVES + F.wave, NGW = F.G * NWAVES;
    const bf16* Y = (const bf16*)(F.ws + WS_Y);
    f32x4 gv[4], bv[4];
#pragma unroll
    for (int j = 0; j < 4; ++j) { gv[j] = *((const GAS f32x4*)gam + F.lane + 64 * j); bv[j] = *((const GAS f32x4*)bet + F.lane + 64 * j); }
    for (int m = gw; m < T; m += NGW) {
        const GAS f32x4* xr = (const GAS f32x4*)(R0 + (size_t)m * D) + F.lane;
        const GAS v2u* y0 = (const GAS v2u*)(Y + (size_t)m * 2 * D) + F.lane; const GAS v2u* y1 = y0 + 256;
        f32x4 v[4]; float s = 0.f;
#pragma unroll
        for (int j = 0; j < 4; ++j) { const v2u a = y0[64 * j], b = y1[64 * j]; v[j] = xr[64 * j] * ALPHA;
            v[j].x += bf2f(a.x & 0xffffu) + bf2f(b.x & 0xffffu); v[j].y += bf2f(a.x >> 16) + bf2f(b.x >> 16); v[j].z += bf2f(a.y & 0xffffu) + bf2f(b.y & 0xffffu); v[j].w += bf2f(a.y >> 16) + bf2f(b.y >> 16);
            s += (v[j].x + v[j].y) + (v[j].z + v[j].w); }
        const float mean = wave_sum(s) * (1.f / D); float s2 = 0.f;
#pragma unroll
        for (int j = 0; j < 4; ++j) { v[j] = v[j] - mean; s2 += (v[j].x * v[j].x + v[j].y * v[j].y) + (v[j].z * v[j].z + v[j].w * v[j].w); }
        const float rstd = 1.f / sqrtf(wave_sum(s2) * (1.f / D) + LN_EPS);
        GAS f32x4* of = (GAS f32x4*)(out + (size_t)m * D) + F.lane;
#pragma unroll
        for (int j = 0; j < 4; ++j) of[64 * j] = v[j] * rstd * gv[j] + bv[j];
    }
}

namespace ep {
using pg8::f32x4; using pg8::Unit; using pg8::u32x4; using pg8::u32x2; using pg8::cvt_pk_bf16;
constexpr int HALF = 128;

struct DenseOrder { int nM, nN, G, c; size_t astep, bstep;
    __device__ __forceinline__ bool next(int i, Unit& u) const { const long L = (long)i * G + c; if (L >= (long)nM * nN) return false;
        pg8::order_tile((int)L, nM, nN, u.pm, u.pn); u.aoff = (size_t)u.pm * astep; u.boff = (size_t)u.pn * bstep; return true; } };
struct PoolOrder { int G, c;
    __device__ __forceinline__ bool next(int i, Unit& u) const { const long L = (long)i * G + c; if (L >= (T / 256) * 4) return false;
        pg8::order_tile((int)L, T / 256, 4, u.pm, u.pn); u.aoff = (size_t)u.pm * 256 * D * 2 + (size_t)u.pn * 512; u.boff = (size_t)u.pn * 256 * 256 * 2; return true; } };
struct CmpOrder { int G, c;
    __device__ __forceinline__ bool next(int i, Unit& u) const { const long L = (long)i * G + c; if (L >= 256) return false;
        const int kv = (int)L >> 7, bg = ((int)L >> 2) & 31, kq = (int)L & 3; u.pm = bg; u.pn = kv * 4 + kq;
        u.aoff = ((size_t)kv * KV6_STRIDE + (size_t)bg * SEQ * 64 + (size_t)kq * 512) * 2; u.boff = ((size_t)kv * 256 * 2048 + (size_t)kq * 512) * 2; return true; } };
template <int NN> struct MoeOrder { int nM, G, c, tile0; const LAS int* tile_e; size_t a_tile, b_exp, b_tile; bool a_local;
    __device__ __forceinline__ bool next(int i, Unit& u) const { const int L = i * G + c; if (L >= nM * NN) return false;
        const int pml = L / NN; u.pn = L % NN; u.pm = tile0 + pml; const int e = __builtin_amdgcn_readfirstlane(tile_e[u.pm]);
        u.aoff = (size_t)(a_local ? pml : u.pm) * a_tile; u.boff = (size_t)e * b_exp + (size_t)u.pn * b_tile; return true; } };

struct EpiPool { static constexpr bool PERM = false; const float* x; const float* scale; float* out;
    __device__ __forceinline__ void operator()(const f32x4 (&acc)[2][2][4][2], const Unit& u, int wr, int wc, int fr, int fq) const {
        const int col0 = u.pn * 256 + wc * 32 + 4 * fq;
#pragma unroll
        for (int bj = 0; bj < 2; ++bj)
#pragma unroll
            for (int n = 0; n < 2; ++n) { const f32x4 sc = *(const f32x4*)(scale + col0 + bj * HALF + n * 16);
#pragma unroll
                for (int ai = 0; ai < 2; ++ai) {
#pragma unroll
                    for (int m = 0; m < 4; ++m) { const size_t off = (size_t)(u.pm * 256 + ai * HALF + wr * 64 + m * 16 + fr) * D + col0 + bj * HALF + n * 16;
                        const f32x4 xv = *(const f32x4*)(x + off); *(f32x4*)(out + off) = xv * ALPHA + acc[ai][bj][m][n] * sc; }
                    asm volatile("" ::: "memory"); } }
    } };
struct EpiResid { static constexpr bool PERM = false; float* R;
    __device__ __forceinline__ void operator()(const f32x4 (&acc)[2][2][4][2], const Unit& u, int wr, int wc, int fr, int fq) const {
        const int col0 = u.pn * 256 + wc * 32 + 4 * fq;
#pragma unroll
        for (int ai = 0; ai < 2; ++ai)
#pragma unroll
            for (int m = 0; m < 4; ++m) { const size_t off = (size_t)(u.pm * 256 + ai * HALF + wr * 64 + m * 16 + fr) * D + col0;
#pragma unroll
                for (int bj = 0; bj < 2; ++bj)
#pragma unroll
                    for (int n = 0; n < 2; ++n) { float* p = R + off + bj * HALF + n * 16; const f32x4 xv = *(const f32x4*)p; *(f32x4*)p = xv * ALPHA + acc[ai][bj][m][n]; }
                if (m & 1) asm volatile("" ::: "memory"); }
    } };
struct EpiSwiGLU { static constexpr bool PERM = true; bf16* O; int ldc; int pm0;
    __device__ __forceinline__ void operator()(const f32x4 (&acc)[2][2][4][2], const Unit& u, int wr, int wc, int fr, int fq) const {
        const int col0 = u.pn * 128 + wc * 32 + 8 * fq;
#pragma unroll
        for (int ai = 0; ai < 2; ++ai)
#pragma unroll
            for (int m = 0; m < 4; ++m) { bf16* rowp = O + (size_t)((u.pm - pm0) * 256 + ai * HALF + wr * 64 + m * 16 + fr) * ldc + col0;
                const f32x4 g0 = acc[ai][0][m][0], g1 = acc[ai][0][m][1], u0 = acc[ai][1][m][0], u1 = acc[ai][1][m][1];
                u32x4 w; w.x = cvt_pk_bf16(silu_f(g0[0]) * u0[0], silu_f(g0[1]) * u0[1]); w.y = cvt_pk_bf16(silu_f(g0[2]) * u0[2], silu_f(g0[3]) * u0[3]);
                w.z = cvt_pk_bf16(silu_f(g1[0]) * u1[0], silu_f(g1[1]) * u1[1]); w.w = cvt_pk_bf16(silu_f(g1[2]) * u1[2], silu_f(g1[3]) * u1[3]);
                *(u32x4*)rowp = w; }
    } };
struct EpiMoeDown { static constexpr bool PERM = true; bf16* Y; const int* sdst; const float* sw;
    __device__ __forceinline__ void operator()(const f32x4 (&acc)[2][2][4][2], const Unit& u, int wr, int wc, int fr, int fq) const {
        const int col0 = u.pn * 256 + wc * 32 + 8 * fq;
#pragma unroll
        for (int ai = 0; ai < 2; ++ai)
#pragma unroll
            for (int m = 0; m < 4; ++m) { const int sr = u.pm * 256 + ai * HALF + wr * 64 + m * 16 + fr; const int d = sdst[sr]; const float w = sw[sr];
                if (d >= 0) { bf16* rowp = Y + (size_t)d * D + col0;
#pragma unroll
                    for (int bj = 0; bj < 2; ++bj) { const f32x4 v0 = acc[ai][bj][m][0] * w, v1 = acc[ai][bj][m][1] * w;
                        u32x4 o; o.x = cvt_pk_bf16(v0[0], v0[1]); o.y = cvt_pk_bf16(v0[2], v0[3]); o.z = cvt_pk_bf16(v1[0], v1[1]); o.w = cvt_pk_bf16(v1[2], v1[3]);
                        *(u32x4*)(rowp + bj * HALF) = o; } } }
    } };
struct EpiCPart { static constexpr bool PERM = false; float* part;
    __device__ __forceinline__ void operator()(const f32x4 (&acc)[2][2][4][2], const Unit& u, int wr, int wc, int fr, int fq) const {
        const int col0 = wc * 32 + 4 * fq;
#pragma unroll
        for (int ai = 0; ai < 2; ++ai)
#pragma unroll
            for (int m = 0; m < 4; ++m) { float* rowp = part + ((size_t)u.pn * 8192 + u.pm * 256 + ai * HALF + wr * 64 + m * 16 + fr) * 128 + col0;
#pragma unroll
                for (int n = 0; n < 2; ++n) *(f32x4*)(rowp + n * 16) = acc[ai][0][m][n]; }
    } };
struct EpiInProj { static constexpr bool PERM = false; bf16* Q; bf16* KV6; float* gates; const float* rc; const float* rs;
    __device__ __forceinline__ void operator()(const f32x4 (&acc)[2][2][4][2], const Unit& u, int wr, int wc, int fr, int fq) const {
        const int pn = u.pn, i0 = 16 * (wc & 1) + 4 * fq;
        const bool rope = (pn < 4) || pn == 6 || pn == 8;
#pragma unroll
        for (int ai = 0; ai < 2; ++ai)
#pragma unroll
            for (int m = 0; m < 4; ++m) { const int row = u.pm * 256 + ai * HALF + wr * 64 + m * 16 + fr, pos = row & (SEQ - 1), bb = row >> 12;
                f32x4 cs = (f32x4){1.f, 1.f, 1.f, 1.f}, sn = (f32x4){0.f, 0.f, 0.f, 0.f};
                if (rope) { cs = *(const f32x4*)(rc + pos * 32 + i0); sn = *(const f32x4*)(rs + pos * 32 + i0); }
#pragma unroll
                for (int bj = 0; bj < 2; ++bj) { const int head = 2 * bj + (wc >> 1); const f32x4 x1 = acc[ai][bj][m][0], x2 = acc[ai][bj][m][1];
                    if (pn == 10) { if (head == 0) { float* gp = gates + (size_t)row * 48 + i0;
                            f32x4 s1; for (int j = 0; j < 4; ++j) s1[j] = 1.0f / (1.0f + __expf(-x1[j])); *(f32x4*)gp = s1;
                            if (i0 < 16) { f32x4 s2; for (int j = 0; j < 4; ++j) s2[j] = 1.0f / (1.0f + __expf(-x2[j])); *(f32x4*)(gp + 32) = s2; } } }
                    else { f32x4 o1 = x1 * cs - x2 * sn, o2 = x1 * sn + x2 * cs; bf16* dst;
                        if (pn < 4) { o1 = o1 * QSCALE; o2 = o2 * QSCALE; dst = Q + (size_t)row * D + (4 * pn + head) * 64 + i0; }
                        else if (pn < 6) dst = KV6 + (size_t)(pn - 4) * KV6_STRIDE + ((size_t)(bb * 4 + head) * SEQ + pos) * 64 + i0;
                        else { const int r = pos & 63;
                            const int sw = (pn & 1) ? ((r >> 4) * 512 + (r & 15) * 32 + i0) : ((i0 >> 3) * 512 + r * 8 + (i0 & 7));
                            dst = KV6 + (size_t)(pn - 4) * KV6_STRIDE + ((size_t)(bb * 4 + head) * SEQ + (pos & ~63)) * 64 + sw; }
                        u32x2 a, b; a.x = cvt_pk_bf16(o1[0], o1[1]); a.y = cvt_pk_bf16(o1[2], o1[3]); b.x = cvt_pk_bf16(o2[0], o2[1]); b.y = cvt_pk_bf16(o2[2], o2[3]);
                        *(u32x2*)dst = a; *(u32x2*)(dst + (pn >= 6 && pn < 10 ? 2048 : 32)) = b; } } }
    } };
}

__device__ __forceinline__ void compress_finish_phase(Frame& F) {
    LAS float* w2s = (LAS float*)(F.lds + RING_OFF);
    for (int idx = F.tid; idx < 2 * 8192; idx += 512) w2s[idx] = F.inp(idx < 8192 ? I_W2K : I_W2V)[idx & 8191];
    __syncthreads();
    const float* part = (const float*)(F.ws + WS_CPART); const float* cb = (const float*)(F.ws + WS_MISC);
    const float* rc = (const float*)(F.ws + WS_ROPE); const float* rs = rc + SEQ * 32;
    bf16* kvc = (bf16*)(F.ws + WS_KVC);
    const int gw = F.vcu * NWAVES + F.wave, NGW = F.G * NWAVES;
    for (int row = gw; row < 2 * 32 * 256; row += NGW) {
        const int kv = row >> 13, r = row & 8191, n = r & 255;
        const int r6 = n & 63; bf16* dst = kvc + (size_t)(row & ~63) * 64 + (kv == 0 ? (F.lane >> 3) * 512 + r6 * 8 + (F.lane & 7) : ((F.lane >> 5) * 4 + (r6 >> 4)) * 512 + (r6 & 15) * 32 + (F.lane & 31));
        if (n == 255) { *dst = 0; continue; }
        float h0 = cb[kv * 128 + F.lane], h1 = cb[kv * 128 + 64 + F.lane];
#pragma unroll
        for (int q = 0; q < 4; ++q) { const float* p = part + ((size_t)(kv * 4 + q) * 8192 + r) * 128; h0 += p[F.lane]; h1 += p[64 + F.lane]; }
        h0 = silu_f(h0); h1 = silu_f(h1);
        const LAS float* w2 = w2s + kv * 8192 + F.lane; float o = 0.f;
#pragma unroll
        for (int c = 0; c < 64; ++c) o += __builtin_bit_cast(float, __builtin_amdgcn_readlane(__builtin_bit_cast(int, h0), c)) * w2[c * 64];
#pragma unroll
        for (int c = 0; c < 64; ++c) o += __builtin_bit_cast(float, __builtin_amdgcn_readlane(__builtin_bit_cast(int, h1), c)) * w2[(64 + c) * 64];
        if (kv == 0) { const int pos = 16 * n + 31, i = F.lane & 31; const float other = __shfl_xor(o, 32), cs = rc[pos * 32 + i], sn = rs[pos * 32 + i];
            o = (F.lane < 32) ? o * cs - other * sn : other * sn + o * cs; }
        *dst = (bf16)f2bf(o);
    }
    __syncthreads();
}

namespace att {
using f32x16 = __attribute__((ext_vector_type(16))) float;
using s16x4 = __attribute__((ext_vector_type(4))) short;
constexpr int SLOTB = 8192;
constexpr int NSLOT = 4, LDS_K = 0, LDS_V = NSLOT * SLOTB, LDS_WS = 2 * NSLOT * SLOTB, LDS_OST = LDS_WS + NWAVES * 256, OSTR = 64  , LDS_IMP = LDS_OST + NWAVES * 32 * OSTR * 4, LDS_SM = LDS_IMP + NWAVES * 2048, LDS_END = LDS_SM + NWAVES * 64;
static_assert(LDS_END <= RING_BYTES, "attention LDS");
__device__ __forceinline__ int crow(int r, int hi) { return (r & 3) + 8 * (r >> 2) + 4 * hi; }
__device__ __forceinline__ float max3f(float a, float b, float c) { float r; asm("v_max3_f32 %0, %1, %2, %3" : "=v"(r) : "v"(a), "v"(b), "v"(c)); return r; }
__device__ __forceinline__ unsigned cvtpk(float lo, float hi) { unsigned r; asm("v_cvt_pk_bf16_f32 %0, %1, %2" : "=v"(r) : "v"(lo), "v"(hi)); return r; }
typedef short v4i16_t __attribute__((ext_vector_type(4)));
#define ATT_WAIT_BAR(N) asm volatile("s_waitcnt vmcnt(" #N ") lgkmcnt(0)\n\ts_barrier" ::: "memory")
#define ATT_LGKM_BAR() asm volatile("s_waitcnt lgkmcnt(0)\n\ts_barrier" ::: "memory")

__device__ __forceinline__ void qkt(f32x16& p0, f32x16& p1, const LAS unsigned char* Kslot, const bf16x8* qr, int r32, int hi) {
    const LAS unsigned char* kb = Kslot + hi * 1024 + r32 * 16;
    p0 = f32x16{}; p1 = f32x16{};
#pragma unroll
    for (int d0 = 0; d0 < 4; ++d0) {
        const bf16x8 b0 = *(const LAS bf16x8*)(kb + d0 * 2048), b1 = *(const LAS bf16x8*)(kb + d0 * 2048 + 512);
        p0 = __builtin_amdgcn_mfma_f32_32x32x16_bf16(b0, qr[d0], p0, 0, 0, 0); p1 = __builtin_amdgcn_mfma_f32_32x32x16_bf16(b1, qr[d0], p1, 0, 0, 0); }
}
__device__ __forceinline__ float rowmax(const f32x16& p0, const f32x16& p1) {
    float a = max3f(p0[0], p0[1], p1[0]), b = max3f(p0[2], p0[3], p1[1]); a = max3f(a, p1[2], p1[3]);
#pragma unroll
    for (int r = 4; r < 16; r += 4) { a = max3f(a, p0[r], p0[r + 1]); b = max3f(b, p0[r + 2], p0[r + 3]); a = max3f(a, p1[r], p1[r + 1]); b = max3f(b, p1[r + 2], p1[r + 3]); }
    const float m = fmaxf(a, b);
    auto rr = __builtin_amdgcn_permlane32_swap(__float_as_uint(m), __float_as_uint(m), false, false);
    return fmaxf(__uint_as_float(rr[0]), __uint_as_float(rr[1]));
}
__device__ __forceinline__ float halfswap_add(float v) { auto rr = __builtin_amdgcn_permlane32_swap(__float_as_uint(v), __float_as_uint(v), false, false); return __uint_as_float(rr[0]) + __uint_as_float(rr[1]); }
__device__ __forceinline__ void pv(f32x16* o, int vb, bf16x8 pa0, bf16x8 pa1, bf16x8 pa2, bf16x8 pa3) {
#pragma unroll
    for (int d0 = 0; d0 < 2; ++d0) { s16x4 lo[4], hi[4];
#pragma unroll
        for (int ks = 0; ks < 4; ++ks) {
            asm volatile("ds_read_b64_tr_b16 %0,%1 offset:%c2" : "=&v"(lo[ks]) : "v"(vb), "i"(d0 * 4096 + ks * 1024) : "memory");
            asm volatile("ds_read_b64_tr_b16 %0,%1 offset:%c2" : "=&v"(hi[ks]) : "v"(vb), "i"(d0 * 4096 + ks * 1024 + 512) : "memory"); }
        asm volatile("s_waitcnt lgkmcnt(0)" ::: "memory"); __builtin_amdgcn_sched_barrier(0);
#define ATT_PK(k) (bf16x8){lo[k][0], lo[k][1], lo[k][2], lo[k][3], hi[k][0], hi[k][1], hi[k][2], hi[k][3]}
        o[d0] = __builtin_amdgcn_mfma_f32_32x32x16_bf16(pa0, ATT_PK(0), o[d0], 0, 0, 0);
        o[d0] = __builtin_amdgcn_mfma_f32_32x32x16_bf16(pa1, ATT_PK(1), o[d0], 0, 0, 0);
        o[d0] = __builtin_amdgcn_mfma_f32_32x32x16_bf16(pa2, ATT_PK(2), o[d0], 0, 0, 0);
        o[d0] = __builtin_amdgcn_mfma_f32_32x32x16_bf16(pa3, ATT_PK(3), o[d0], 0, 0, 0);
#undef ATT_PK
    }
}
__device__ __forceinline__ void mask_gt(f32x16& p0, f32x16& p1, int thr, int hi) {
    asm volatile("" : "+v"(thr));
#pragma unroll
    for (int r = 0; r < 16; ++r) { const int kv = crow(r, hi); if (kv > thr) p0[r] = -INFINITY; if (kv + 32 > thr) p1[r] = -INFINITY; } }
__device__ __forceinline__ void mask_le(f32x16& p0, f32x16& p1, int thr, int hi) {
    asm volatile("" : "+v"(thr));
#pragma unroll
    for (int r = 0; r < 16; ++r) { const int kv = crow(r, hi); if (kv <= thr) p0[r] = -INFINITY; if (kv + 32 <= thr) p1[r] = -INFINITY; } }
__device__ __forceinline__ void mask_all(f32x16& p0, f32x16& p1) {
#pragma unroll
    for (int r = 0; r < 16; ++r) { p0[r] = -INFINITY; p1[r] = -INFINITY; } }

struct Ctx { LAS unsigned char* shm; int wid, lane, r32, hi; LAS float* wsf; int vb0; unsigned koff, voff; };

__device__ __forceinline__ const char* uni_ptr(const void* p) { const unsigned long long v = (unsigned long long)p;
    return (const char*)(((unsigned long long)(unsigned)__builtin_amdgcn_readfirstlane((unsigned)(v >> 32)) << 32) | (unsigned)__builtin_amdgcn_readfirstlane((unsigned)v)); }
__device__ __forceinline__ void dma_k(const Ctx& c, const bf16* Kt, int slot) {
    __builtin_amdgcn_global_load_lds((const unsigned*)(uni_ptr(Kt) + c.koff), (LAS unsigned*)(c.shm + LDS_K + slot * SLOTB + c.wid * 1024), 16, 0, 0); }
__device__ __forceinline__ void dma_v(const Ctx& c, const bf16* Vt, int slot) {
    __builtin_amdgcn_global_load_lds((const unsigned*)(uni_ptr(Vt) + c.voff), (LAS unsigned*)(c.shm + LDS_V + slot * SLOTB + c.wid * 1024), 16, 0, 0); }

__device__ __forceinline__ void p_times_v(const Ctx& c, f32x16* o, const f32x16& p0, const f32x16& p1, int slot) {
    v4u pw0 = (v4u){cvtpk(p0[0], p0[1]), cvtpk(p0[2], p0[3]), cvtpk(p0[4], p0[5]), cvtpk(p0[6], p0[7])};
    v4u pw1 = (v4u){cvtpk(p0[8], p0[9]), cvtpk(p0[10], p0[11]), cvtpk(p0[12], p0[13]), cvtpk(p0[14], p0[15])};
    v4u pw2 = (v4u){cvtpk(p1[0], p1[1]), cvtpk(p1[2], p1[3]), cvtpk(p1[4], p1[5]), cvtpk(p1[6], p1[7])};
    v4u pw3 = (v4u){cvtpk(p1[8], p1[9]), cvtpk(p1[10], p1[11]), cvtpk(p1[12], p1[13]), cvtpk(p1[14], p1[15])};
    pv(o, c.vb0 + slot * SLOTB, __builtin_bit_cast(bf16x8, pw0), __builtin_bit_cast(bf16x8, pw1), __builtin_bit_cast(bf16x8, pw2), __builtin_bit_cast(bf16x8, pw3));
}
__device__ __forceinline__ void online_step(const Ctx& c, f32x16& p0, f32x16& p1, float& m, float& l, f32x16* o, int slot) {
    const float rm = rowmax(p0, p1);
    const float mn = fmaxf(fmaxf(m, rm), -1.0e30f);
    const float f = __builtin_amdgcn_exp2f(m - mn);
    float s = 0.f;
#pragma unroll
    for (int r = 0; r < 16; ++r) { p0[r] = __builtin_amdgcn_exp2f(p0[r] - mn); p1[r] = __builtin_amdgcn_exp2f(p1[r] - mn); s += p0[r] + p1[r]; }
    l = l * f + s; m = mn;
    if (__any(f != 1.0f)) { if (c.hi == 0) c.wsf[c.r32] = f; LDS_WAIT();
#pragma unroll
        for (int r = 0; r < 16; ++r) { const float fr = c.wsf[crow(r, c.hi)]; o[0][r] *= fr; o[1][r] *= fr; }
        LDS_WAIT(); }
    p_times_v(c, o, p0, p1, slot);
}
__device__ __forceinline__ void fold_out(const Ctx& c, LAS float* outacc, const f32x16* o, float fac) {
    if (c.hi == 0) c.wsf[32 + c.r32] = fac; LDS_WAIT();
    LAS float* pa = outacc + c.hi * (4 * OSTR + 32) + c.r32; LAS float* pb = outacc + c.hi * (4 * OSTR) + (1 - c.hi) * 32 + c.r32; const LAS float* fp = c.wsf + 32 + 4 * c.hi;
#pragma unroll
    for (int r = 0; r < 16; ++r) { const int ro = (r & 3) + 8 * (r >> 2); const float fr = fp[ro]; pa[ro * OSTR] += o[0][r] * fr; pb[ro * OSTR] += o[1][r] * fr; }
    LDS_WAIT();
}

typedef __attribute__((address_space(3))) const char* lds_cptr;
__device__ __forceinline__ void glds16(const void* gsrc, unsigned lds_dst) { unsigned keep;
    asm volatile("s_mov_b32 %0, m0\n\ts_mov_b32 m0, %2\n\ts_nop 0\n\tglobal_load_lds_dwordx4 %1, off\n\ts_mov_b32 m0, %0" : "=&s"(keep) : "v"(gsrc), "s"(lds_dst) : "memory"); }
__device__ __forceinline__ void kload8(bf16x8* kf, lds_cptr kp) {
    kf[0] = *(const LAS bf16x8*)(kp);        kf[1] = *(const LAS bf16x8*)(kp + 512);  kf[2] = *(const LAS bf16x8*)(kp + 2048); kf[3] = *(const LAS bf16x8*)(kp + 2560);
    kf[4] = *(const LAS bf16x8*)(kp + 4096); kf[5] = *(const LAS bf16x8*)(kp + 4608); kf[6] = *(const LAS bf16x8*)(kp + 6144); kf[7] = *(const LAS bf16x8*)(kp + 6656); }
__device__ __forceinline__ void kload2(bf16x8* kf, lds_cptr kp, int j) { kf[2 * j] = *(const LAS bf16x8*)(kp + j * 2048); kf[2 * j + 1] = *(const LAS bf16x8*)(kp + j * 2048 + 512); }
__device__ __forceinline__ s16x4 vtr(lds_cptr p) { return __builtin_bit_cast(s16x4, __builtin_amdgcn_ds_read_tr16_b64_v4i16((LAS v4i16_t*)p)); }
template <int THRL>
__device__ __forceinline__ void fast_seg(const Ctx& c, const bf16x8 (&qr)[4], int kind, int qb, int tok, unsigned long long mymask, const bf16* Kb, const bf16* Vb, int NTreal, float gate, LAS float* out) {
    const int NT = NTreal < 3 ? 4 : ((NTreal + 1) & ~1);
    const unsigned lds0 = (unsigned)(uintptr_t)c.shm;
    const unsigned kdst = lds0 + LDS_K + c.wid * 1024, vdst = lds0 + LDS_V + c.wid * 1024;
    const lds_cptr shm3 = (lds_cptr)c.shm; const lds_cptr kp0 = shm3 + LDS_K + c.hi * 1024 + c.r32 * 16;
    const lds_cptr vp0 = shm3 + LDS_V + ((c.lane >> 4) & 1) * 32 + (c.lane & 3) * 8 + (4 * c.hi + ((c.lane & 15) >> 2)) * 64;
    const int hi = c.hi, r32 = c.r32;
#define FS_BLK(t) ((t) < NTreal ? (kind == 0 ? (t) : qb - (t)) : (kind == 0 ? 0 : qb))
#define FS_DMA_K(t, slot) glds16(uni_ptr(Kb + (size_t)FS_BLK(t) * 4096) + c.koff, (unsigned)__builtin_amdgcn_readfirstlane(kdst + (slot)))
#define FS_DMA_V(t, slot) glds16(uni_ptr(Vb + (size_t)FS_BLK(t) * 4096) + c.koff, (unsigned)__builtin_amdgcn_readfirstlane(vdst + (slot)))
#define FS_WAIT_BAR(N) asm volatile("s_waitcnt vmcnt(" #N ") lgkmcnt(0)\n\ts_barrier" ::: "memory")
#define FS_SBAR() __builtin_amdgcn_sched_barrier(0)
#define FS_MASK(P0, P1, t) do { const int t_ = (t); \
        if (t_ >= NTreal) mask_all(P0, P1); \
        else if (kind == 0) { const bool sel_ = (mymask >> t_) & 1ull; if (__any(!sel_)) { if (!sel_) mask_all(P0, P1); } if (t_ == qb) mask_gt(P0, P1, tok, hi); } \
        else { if (t_ == 0) mask_gt(P0, P1, tok, hi); if (t_ == 8) mask_le(P0, P1, tok, hi); } } while (0)
    bf16x8 kfa, kfb, kfc, kfd;
    FS_DMA_K(0, 0); FS_DMA_V(0, 0); FS_DMA_K(1, SLOTB); FS_DMA_K(2, 2 * SLOTB);
    float mhat = 0.f, l_reg = 0.f; f32x16 o[2]; o[0] = f32x16{}; o[1] = f32x16{};
    bool resc = false;
    f32x16 pA0, pA1, pB0, pB1;
    int sl_prev = 0, sl_cur = 0, sl_next = SLOTB;
#define FS_ROT() do { sl_prev = sl_cur; sl_cur = sl_next; sl_next = (sl_next == 2 * SLOTB) ? 0 : sl_next + SLOTB; } while (0)
#define FS_RESC() do { if (resc) { asm volatile("s_waitcnt lgkmcnt(0)" ::: "memory"); \
        _Pragma("unroll") for (int d_ = 0; d_ < 2; ++d_) _Pragma("unroll") for (int r = 0; r < 16; ++r) o[d_][r] *= c.wsf[crow(r, hi)]; } } while (0)
    FS_WAIT_BAR(3);
    qkt(pA0, pA1, c.shm + LDS_K, qr, r32, hi);
    FS_MASK(pA0, pA1, 0);
    { float a = __builtin_fmaxf(__builtin_fmaxf(pA0[0], pA0[1]), pA1[0]);
#pragma unroll
      for (int r = 0; r < 16; ++r) a = __builtin_fmaxf(__builtin_fmaxf(a, pA0[r]), pA1[r]);
      { auto rr = __builtin_amdgcn_permlane32_swap(__float_as_uint(a), __float_as_uint(a), false, false); a = __builtin_fmaxf(__uint_as_float(rr[0]), __uint_as_float(rr[1])); }
      mhat = a;
#pragma unroll
      for (int r = 0; r < 16; ++r) { pA0[r] = __builtin_amdgcn_exp2f(pA0[r] - mhat); pA1[r] = __builtin_amdgcn_exp2f(pA1[r] - mhat); } }
    FS_WAIT_BAR(0);
    FS_DMA_K(3, 3 * SLOTB); FS_DMA_V(1, SLOTB);
    FS_ROT();
    kfa = *(const LAS bf16x8*)(kp0 + SLOTB); kfb = *(const LAS bf16x8*)(kp0 + SLOTB + 512);
    s16x4 vlo[8], vhi[8]; v4u pw0, pw1, pw2, pw3;
#define FS_PKW(P, B) cvtpk(P[B], P[(B) + 1])
#define FS_PAF(k) __builtin_bit_cast(bf16x8, pw##k)
#define FS_VFR(i) (bf16x8){vlo[i][0], vlo[i][1], vlo[i][2], vlo[i][3], vhi[i][0], vhi[i][1], vhi[i][2], vhi[i][3]}
#define FS_PIN(x) asm volatile("" : "+v"(x))
#define FS_MX3(a, b, c_) __builtin_fmaxf(__builtin_fmaxf((a), (b)), (c_))
#define FS_GAPA(MF, A0, A1, A2, A3, W0, W1, PW) do { MF; sacc += A0; sacc += A1; sacc += A2; sacc += A3; FS_PIN(sacc); W0; W1; FS_PIN(PW); FS_SBAR(); } while (0)
#define FS_EX(v) __builtin_amdgcn_exp2f((v) - mhat)
#define FS_GAPB(MF, X, B) do { MF; X[B] = FS_EX(X[B]); X[(B) + 1] = FS_EX(X[(B) + 1]); X[(B) + 2] = FS_EX(X[(B) + 2]); X[(B) + 3] = FS_EX(X[(B) + 3]); FS_PIN(X); FS_SBAR(); } while (0)
#define FS_VRD(i) do { vlo[i] = vtr(vp_ + (((i) >> 2) * 4096 + ((i) & 3) * 1024)); vhi[i] = vtr(vp_ + (((i) >> 2) * 4096 + ((i) & 3) * 1024 + 512)); } while (0)
#define FS_KL(off) (*(const LAS bf16x8*)(kq_ + (off)))
#define FS_Z f32x16{}
#define FS_STEP(C0, C1, P0, P1, t, GK, GV, GL) do { FS_SBAR(); \
    const lds_cptr vp_ = vp0 + sl_prev; const lds_cptr kq_ = kp0 + ((t) & 3) * SLOTB; \
    FS_VRD(0); kfc = FS_KL(2048); FS_SBAR(); float sacc = (P0[0] + P0[1]); \
    FS_GAPA(C0 = __builtin_amdgcn_mfma_f32_32x32x16_bf16(kfa, qr[0], FS_Z, 0, 0, 0), P0[2], P0[3], P0[4], P0[5],     pw0[0] = FS_PKW(P0, 0), pw0[1] = FS_PKW(P0, 2), pw0); \
    FS_VRD(4); kfd = FS_KL(2560); FS_SBAR(); FS_GAPA(C1 = __builtin_amdgcn_mfma_f32_32x32x16_bf16(kfb, qr[0], FS_Z, 0, 0, 0), P0[6], P0[7], P0[8], P0[9],     pw0[2] = FS_PKW(P0, 4), pw0[3] = FS_PKW(P0, 6), pw0); \
    FS_VRD(1); kfa = FS_KL(4096); FS_SBAR(); FS_GAPA(C0 = __builtin_amdgcn_mfma_f32_32x32x16_bf16(kfc, qr[1], C0, 0, 0, 0),   P0[10], P0[11], P0[12], P0[13], pw1[0] = FS_PKW(P0, 8), pw1[1] = FS_PKW(P0, 10), pw1); \
    FS_VRD(5); kfb = FS_KL(4608); FS_SBAR(); FS_GAPA(C1 = __builtin_amdgcn_mfma_f32_32x32x16_bf16(kfd, qr[1], C1, 0, 0, 0),   P0[14], P0[15], P1[0], P1[1],   pw1[2] = FS_PKW(P0, 12), pw1[3] = FS_PKW(P0, 14), pw1); \
    FS_VRD(2); kfc = FS_KL(6144); FS_SBAR(); FS_GAPA(C0 = __builtin_amdgcn_mfma_f32_32x32x16_bf16(kfa, qr[2], C0, 0, 0, 0),   P1[2], P1[3], P1[4], P1[5],     pw2[0] = FS_PKW(P1, 0), pw2[1] = FS_PKW(P1, 2), pw2); \
    FS_VRD(6); kfd = FS_KL(6656); FS_SBAR(); FS_GAPA(C1 = __builtin_amdgcn_mfma_f32_32x32x16_bf16(kfb, qr[2], C1, 0, 0, 0),   P1[6], P1[7], P1[8], P1[9],     pw2[2] = FS_PKW(P1, 4), pw2[3] = FS_PKW(P1, 6), pw2); \
    FS_VRD(3); FS_SBAR(); FS_GAPA(C0 = __builtin_amdgcn_mfma_f32_32x32x16_bf16(kfc, qr[3], C0, 0, 0, 0),   P1[10], P1[11], P1[12], P1[13], pw3[0] = FS_PKW(P1, 8), pw3[1] = FS_PKW(P1, 10), pw3); \
    FS_VRD(7); FS_SBAR(); FS_GAPA(C1 = __builtin_amdgcn_mfma_f32_32x32x16_bf16(kfd, qr[3], C1, 0, 0, 0),   P1[14], P1[15], 0.f, 0.f,       pw3[2] = FS_PKW(P1, 12), pw3[3] = FS_PKW(P1, 14), pw3); \
    l_reg += sacc; \
    if (GK) { FS_DMA_K((t) + 3, (((t) + 3) & 3) * SLOTB); } if (GV) { FS_DMA_V((t) + 1, sl_next); } \
    FS_MASK(C0, C1, t); \
    { float a = FS_MX3(C0[0], C0[1], C1[0]), b = FS_MX3(C0[2], C0[3], C1[1]); a = FS_MX3(a, C1[2], C1[3]); \
      _Pragma("unroll") for (int r = 4; r < 16; r += 4) { a = FS_MX3(a, C0[r], C0[r + 1]); b = FS_MX3(b, C0[r + 2], C0[r + 3]); a = FS_MX3(a, C1[r], C1[r + 1]); b = FS_MX3(b, C1[r + 2], C1[r + 3]); } \
      float rm = __builtin_fmaxf(a, b); { auto rr = __builtin_amdgcn_permlane32_swap(__float_as_uint(rm), __float_as_uint(rm), false, false); rm = __builtin_fmaxf(__uint_as_float(rr[0]), __uint_as_float(rr[1])); } \
      rm -= mhat; resc = false; \
      if (__builtin_expect(__any(rm > (float)THRL), 0)) { const float dl = __builtin_fmaxf(rm, 0.f); mhat += dl; \
        const float f = __builtin_amdgcn_exp2f(-dl); l_reg *= f; if (hi == 0) c.wsf[r32] = f; resc = true; } } \
    FS_SBAR(); \
    FS_GAPB(o[0] = __builtin_amdgcn_mfma_f32_32x32x16_bf16(FS_PAF(0), FS_VFR(0), o[0], 0, 0, 0), C0, 0); \
    FS_GAPB(o[1] = __builtin_amdgcn_mfma_f32_32x32x16_bf16(FS_PAF(0), FS_VFR(4), o[1], 0, 0, 0), C0, 4); \
    FS_GAPB(o[0] = __builtin_amdgcn_mfma_f32_32x32x16_bf16(FS_PAF(1), FS_VFR(1), o[0], 0, 0, 0), C0, 8); \
    FS_GAPB(o[1] = __builtin_amdgcn_mfma_f32_32x32x16_bf16(FS_PAF(1), FS_VFR(5), o[1], 0, 0, 0), C0, 12); \
    FS_GAPB(o[0] = __builtin_amdgcn_mfma_f32_32x32x16_bf16(FS_PAF(2), FS_VFR(2), o[0], 0, 0, 0), C1, 0); \
    FS_GAPB(o[1] = __builtin_amdgcn_mfma_f32_32x32x16_bf16(FS_PAF(2), FS_VFR(6), o[1], 0, 0, 0), C1, 4); \
    if (GL) { const lds_cptr kn_ = kp0 + (((t) + 1) & 3) * SLOTB; kfa = *(const LAS bf16x8*)(kn_); kfb = *(const LAS bf16x8*)(kn_ + 512); FS_SBAR(); } \
    FS_GAPB(o[0] = __builtin_amdgcn_mfma_f32_32x32x16_bf16(FS_PAF(3), FS_VFR(3), o[0], 0, 0, 0), C1, 8); \
    FS_GAPB(o[1] = __builtin_amdgcn_mfma_f32_32x32x16_bf16(FS_PAF(3), FS_VFR(7), o[1], 0, 0, 0), C1, 12); \
    } while (0)
    int t = 1;
    for (; t + 5 < NT; t += 2) {
        FS_STEP(pB0, pB1, pA0, pA1, t, true, true, true);     FS_WAIT_BAR(2); FS_RESC(); FS_ROT();
        FS_STEP(pA0, pA1, pB0, pB1, t + 1, true, true, true); FS_WAIT_BAR(2); FS_RESC(); FS_ROT();
    }
#define FS_ENDW(tt) do { if ((tt) + 3 < NT) { FS_WAIT_BAR(2); } else if ((tt) + 2 < NT) { FS_WAIT_BAR(1); } else { FS_WAIT_BAR(0); } } while (0)
    for (; t + 1 < NT; t += 2) {
        FS_STEP(pB0, pB1, pA0, pA1, t, (t + 3 < NT), (t + 1 < NT), (t + 1 < NT));         FS_ENDW(t);     FS_RESC(); FS_ROT();
        FS_STEP(pA0, pA1, pB0, pB1, t + 1, (t + 4 < NT), (t + 2 < NT), (t + 2 < NT));     FS_ENDW(t + 1); FS_RESC(); FS_ROT();
    }
    FS_STEP(pB0, pB1, pA0, pA1, NT - 1, false, false, false); FS_RESC();
    { float sacc = pB0[0] + pB0[1];
#pragma unroll
      for (int r = 2; r < 16; ++r) sacc += pB0[r];
#pragma unroll
      for (int r = 0; r < 16; ++r) sacc += pB1[r];
      l_reg += sacc;
      pw0 = (v4u){FS_PKW(pB0, 0), FS_PKW(pB0, 2), FS_PKW(pB0, 4), FS_PKW(pB0, 6)}; pw1 = (v4u){FS_PKW(pB0, 8), FS_PKW(pB0, 10), FS_PKW(pB0, 12), FS_PKW(pB0, 14)};
      pw2 = (v4u){FS_PKW(pB1, 0), FS_PKW(pB1, 2), FS_PKW(pB1, 4), FS_PKW(pB1, 6)}; pw3 = (v4u){FS_PKW(pB1, 8), FS_PKW(pB1, 10), FS_PKW(pB1, 12), FS_PKW(pB1, 14)};
      FS_SBAR(); pv(o, c.vb0 + sl_cur, FS_PAF(0), FS_PAF(1), FS_PAF(2), FS_PAF(3)); }
    const float lt = halfswap_add(l_reg);
    fold_out(c, out, o, lt > 0.f ? gate / lt : 0.f);
    asm volatile("s_waitcnt lgkmcnt(0)\n\ts_barrier" ::: "memory");
#undef FS_BLK
#undef FS_DMA_K
#undef FS_DMA_V
#undef FS_WAIT_BAR
#undef FS_SBAR
#undef FS_MASK
#undef FS_ROT
#undef FS_RESC
#undef FS_PKW
#undef FS_PAF
#undef FS_VFR
#undef FS_PIN
#undef FS_MX3
#undef FS_GAPA
#undef FS_EX
#undef FS_GAPB
#undef FS_VRD
#undef FS_KL
#undef FS_Z
#undef FS_STEP
#undef FS_ENDW
}

__device__ __forceinline__ void attn_unit(Frame& F, int b, int g, int qb) {
    Ctx c; c.shm = F.lds + RING_OFF; c.wid = F.wave; c.lane = F.lane; c.r32 = F.lane & 31; c.hi = F.lane >> 5;
    c.wsf = (LAS float*)(c.shm + LDS_WS) + c.wid * 64;
    c.vb0 = (int)(uintptr_t)(c.shm + LDS_V) + ((c.lane >> 4) & 1) * 32 + (c.lane & 3) * 8 + (4 * c.hi + ((c.lane & 15) >> 2)) * 64;
    c.koff = (unsigned)(c.wid * 1024 + c.lane * 16); c.voff = c.koff;
    const int tt = c.r32 & 7, hh = c.r32 >> 3, tok = 8 * c.wid + tt, t0 = 64 * qb, t = t0 + tok;
    const size_t grow = (size_t)b * SEQ + t;
    const bf16* Qp = (const bf16*)(F.ws + WS_Q) + grow * D + (4 * g + hh) * 64 + c.hi * 8;
    const bf16* KV6 = (const bf16*)(F.ws + WS_KV6) + (size_t)(b * 4 + g) * SEQ * 64;
    const bf16* KC = (const bf16*)(F.ws + WS_KVC) + (size_t)(b * 4 + g) * 256 * 64;
    VM_WAIT();
    bf16x8 qr[4];
#pragma unroll
    for (int d0 = 0; d0 < 4; ++d0) qr[d0] = *(const bf16x8*)(Qp + d0 * 16);
    const float* gp = (const float*)(F.ws + WS_GATES) + grow * 48 + (4 * g + hh) * 3;
    LAS float* out = (LAS float*)(c.shm + LDS_OST) + c.wid * 32 * OSTR;
#pragma unroll
    for (int k = 0; k < 32; ++k) out[k * OSTR + c.lane] = 0.f;
    LAS float* imp = (LAS float*)(c.shm + LDS_IMP) + c.wid * 512;
    LAS unsigned long long* smk = (LAS unsigned long long*)(c.shm + LDS_SM) + c.wid * 8;
    const bool need_sel = qb > 15;
    if (need_sel) {
#pragma unroll
        for (int k = 0; k < 8; ++k) imp[k * 64 + c.lane] = 0.f; }
    const int nmax = (t - 31) >> 4;
    const int nmax_min = (t0 - 31) >> 4;
    const int nct = ((4 * qb + 2) >> 6) + 1;
    const int e0 = nct, e1 = 2 * nct, e2 = e1, ntot = e1;
#define ATT_KPTR(ii_) ((ii_) < e1 ? KC + (size_t)((ii_) < e0 ? (ii_) : (ii_) - e0) * 4096 : (ii_) < e2 ? KV6 + 2 * KV6_STRIDE + (size_t)((ii_) - e1) * 4096 : KV6 + 4 * KV6_STRIDE + (size_t)(qb - ((ii_) - e2)) * 4096)
#define ATT_VPTR(ii_) (ATT_KPTR(ii_) + ((ii_) < e1 ? (size_t)32 * 256 * 64 : KV6_STRIDE))
    float m = -INFINITY, l = 0.f; f32x16 o[2]; o[0] = f32x16{}; o[1] = f32x16{};
    unsigned long long mymask = ~0ull;
    dma_k(c, ATT_KPTR(0), 0); dma_k(c, ATT_KPTR(1), 1); dma_v(c, ATT_VPTR(0), 0); dma_k(c, ATT_KPTR(2), 2); dma_v(c, ATT_VPTR(1), 1);
    ATT_WAIT_BAR(4);
    f32x16 p0, p1;
    qkt(p0, p1, c.shm + LDS_K, qr, c.r32, c.hi);
    for (int i = 0; i < ntot; ++i) {
        const int slot = i & 3;
        if (i + 2 < ntot) { ATT_WAIT_BAR(2); } else { ATT_WAIT_BAR(0); }
        if (i + 3 < ntot) dma_k(c, ATT_KPTR(i + 3), (i + 3) & 3);
        if (i + 2 < ntot) dma_v(c, ATT_VPTR(i + 2), (i + 2) & 3);
        const int mode = i < e0 ? 0 : i < e1 ? 1 : i < e2 ? 2 : 3;
        bool selrow = true;
        if (mode <= 1) { const int j = mode ? i - e0 : i; if (64 * j + 63 > nmax_min) mask_gt(p0, p1, nmax - 64 * j, c.hi); }
        else if (mode == 2) { const int j = i - e1; selrow = (mymask >> j) & 1ull; if (j == qb) mask_gt(p0, p1, tok, c.hi); }
        else { const int j = i - e2; if (j == 0) mask_gt(p0, p1, tok, c.hi); if (j == 8) mask_le(p0, p1, tok, c.hi); }
        float mn, f = 1.0f;
        if (mode == 1) mn = m;
        else { float rm = rowmax(p0, p1); if (!selrow) rm = -INFINITY; mn = fmaxf(fmaxf(m, rm), -1.0e30f); f = __builtin_amdgcn_exp2f(m - mn); m = mn; }
        const float sub = selrow ? mn : INFINITY;
        f32x16 n0 = f32x16{}, n1 = f32x16{}; float s = 0.f; v4u pw0, pw1, pw2, pw3;
        const bool do_imp = (mode == 1) && need_sel;
        LAS float* impr = imp + tt * 64 + 16 * (i - e0) + c.hi;
        { const LAS unsigned char* kb = c.shm + LDS_K + ((i + 1) & 3) * SLOTB + c.hi * 1024 + c.r32 * 16;
#define ATT_GRP(d0_, P_, B_, PW_) do { const bf16x8 b0_ = *(const LAS bf16x8*)(kb + (d0_) * 2048), b1_ = *(const LAS bf16x8*)(kb + (d0_) * 2048 + 512); \
            n0 = __builtin_amdgcn_mfma_f32_32x32x16_bf16(b0_, qr[d0_], n0, 0, 0, 0); n1 = __builtin_amdgcn_mfma_f32_32x32x16_bf16(b1_, qr[d0_], n1, 0, 0, 0); \
            float e_[8]; _Pragma("unroll") for (int r_ = 0; r_ < 8; ++r_) { e_[r_] = __builtin_amdgcn_exp2f(P_[(B_) + r_] - sub); s += e_[r_]; } \
            PW_ = (v4u){cvtpk(e_[0], e_[1]), cvtpk(e_[2], e_[3]), cvtpk(e_[4], e_[5]), cvtpk(e_[6], e_[7])}; \
            if (do_imp) { float qa = (e_[0] + e_[1]) + (e_[2] + e_[3]), qb_ = (e_[4] + e_[5]) + (e_[6] + e_[7]), la = e_[3], lb = e_[7]; \
                qa += __shfl_xor(qa, 8); qa += __shfl_xor(qa, 16); qb_ += __shfl_xor(qb_, 8); qb_ += __shfl_xor(qb_, 16); la += __shfl_xor(la, 8); la += __shfl_xor(la, 16); lb += __shfl_xor(lb, 8); lb += __shfl_xor(lb, 16); \
                if (hh == 0) { const int jo = 4 * ((d0_) & 1) + 8 * ((d0_) >> 1); impr[jo] += qa; impr[jo + 2] += qb_; LDS_WAIT(); \
                    if (16 * (i - e0) + c.hi + jo + 1 < 64) impr[jo + 1] += la; if (16 * (i - e0) + c.hi + jo + 3 < 64) impr[jo + 3] += lb; LDS_WAIT(); } } \
            __builtin_amdgcn_sched_barrier(0); } while (0)
          ATT_GRP(0, p0, 0, pw0); ATT_GRP(1, p0, 8, pw1); ATT_GRP(2, p1, 0, pw2); ATT_GRP(3, p1, 8, pw3);
#undef ATT_GRP
        }
        l = l * f + s;
        if (mode == 0) {
            if (i + 1 == e0) { const float lt = halfswap_add(l); m = lt > 0.f ? m + __builtin_amdgcn_logf(lt) : 0.f; l = 0.f; }
        } else {
            if (__any(f != 1.0f)) { if (c.hi == 0) c.wsf[c.r32] = f; LDS_WAIT();
#pragma unroll
                for (int r = 0; r < 16; ++r) { const float fr = c.wsf[crow(r, c.hi)]; o[0][r] *= fr; o[1][r] *= fr; }
                LDS_WAIT(); }
            pv(o, c.vb0 + slot * SLOTB, __builtin_bit_cast(bf16x8, pw0), __builtin_bit_cast(bf16x8, pw1), __builtin_bit_cast(bf16x8, pw2), __builtin_bit_cast(bf16x8, pw3));
            if (i + 1 == e1) {
                fold_out(c, out, o, gp[0]);
                if (need_sel) {
                    for (int k = 0; k < 8; ++k) {
                        const int jl = c.lane; const bool valid = jl <= qb; const bool forced = (jl == 0) || (jl == qb) || (jl == qb - 1);
                        const float sc = valid ? imp[k * 64 + jl] + (forced ? 1000.0f : 0.0f) : -1.0f;
                        int rank = 0;
#pragma unroll 4
                        for (int q = 0; q < 64; ++q) { const float sq = __builtin_bit_cast(float, __builtin_amdgcn_readlane(__builtin_bit_cast(int, sc), q)); rank += (sq > sc || (sq == sc && q < jl)) ? 1 : 0; }
                        const unsigned long long mk = __ballot(valid && rank < 16);
                        if (c.lane == 0) smk[k] = mk;
                    }
                    LDS_WAIT();
                    mymask = smk[tt];
                } else mymask = (2ull << qb) - 1ull;
                m = -INFINITY; l = 0.f; o[0] = f32x16{}; o[1] = f32x16{};
            }
        }
        p0 = n0; p1 = n1;
    }
#undef ATT_KPTR
#undef ATT_VPTR
    asm volatile("s_waitcnt lgkmcnt(0)\n\ts_barrier" ::: "memory");
    for (int kind = 0; kind < 2; ++kind) {
        const bf16* Kb = KV6 + (kind == 0 ? 2 : 4) * KV6_STRIDE; const bf16* Vb = Kb + KV6_STRIDE;
        fast_seg<8>(c, qr, kind, qb, tok, mymask, Kb, Vb, kind == 0 ? qb + 1 : (qb < 8 ? qb : 8) + 1, gp[1 + kind], out);
    }
    {
        LDS_WAIT();
        bf16* AO = (bf16*)(F.ws + WS_AO);
#pragma unroll
        for (int i = 0; i < 4; ++i) { const int row = i * 8 + (c.lane >> 3), ch = c.lane & 7; const LAS f32x4* sp = (const LAS f32x4*)(out + (c.lane >> 3) * OSTR + ((ch * 8) ^ (((c.lane >> 3) & 4) << 3)) + i * 8 * OSTR); const f32x4 a = sp[0], bq = sp[1];
            const v4u v = (v4u){cvtpk(a[0], a[1]), cvtpk(a[2], a[3]), cvtpk(bq[0], bq[1]), cvtpk(bq[2], bq[3])};
            *(v4u*)(AO + ((size_t)b * SEQ + t0 + 8 * c.wid + (row & 7)) * D + (4 * g + (row >> 3)) * 64 + ch * 8) = v; }
        LDS_WAIT();
    }
    asm volatile("s_waitcnt lgkmcnt(0)\n\ts_barrier" ::: "memory");
}
__device__ __forceinline__ void attn_phase(Frame& F) {
    const int bg = F.vcu >> 3, s = F.vcu & 7;
    for (int i = 0; i < 8; ++i) { const int base = (i >> 1) * 16; const int qb = (i & 1) ? base + 15 - s : base + s;
        attn_unit(F, bg >> 2, bg & 3, qb); }
}
#undef ATT_WAIT_BAR
#undef ATT_LGKM_BAR
}

#ifndef MK_PER_PHASE
#define MK_PER_PHASE 0
#endif
constexpr int N_PHASES = 24;
struct Args { const float* in[18]; float* out; unsigned char* ws; int ph_lo, ph_hi, li, pad; };

__global__ void __launch_bounds__(NWAVES * 64, 2) fwd_kernel(Args args) {
    extern __shared__ __attribute__((aligned(16))) unsigned char lds[];
    Frame F;
    F.lds = (LAS unsigned char*)lds;
    F.MISC = (volatile LAS unsigned*)(F.lds + MISC_OFF);
    refresh(F);
    F.G = gridDim.x; { const int bx = blockIdx.x; F.vcu = (F.G % 8 == 0) ? (bx % 8) * (F.G / 8) + bx / 8 : bx; }
    F.ws = args.ws; F.ctl = (gu32*)(args.ws + WS_CTL); F.out = args.out;
    for (int u = F.tid; u < (LDS_BYTES - LDSCTL_OFF) / 4; u += NWAVES * 64) ((LAS unsigned*)(F.lds + LDSCTL_OFF))[u] = 0u;
    __syncthreads();
    if (F.tid < 18) ((LAS unsigned long long*)(F.lds + PTR_OFF))[F.tid] = (unsigned long long)args.in[F.tid];
    __syncthreads();
    XcdBarrier bar = xcd_barrier_post((unsigned*)(F.ctl + CW_BAR) + args.li * XCD_BAR_WORDS, F.MISC + 8);
#define GRID_BAR() xcd_barrier(bar)
    const int lo = args.ph_lo, hi = args.ph_hi;
#ifndef PH_MASK
#define PH_MASK 0xFFFFFFu
#endif
#define IN(k) (((PH_MASK >> ((k) > 13 ? 13 + (((k) - 13) & 1) : (k))) & 1u) && lo <= (k) && (k) < hi)
#define BOTH(k) (IN(k) && IN((k) + 1))
#ifndef REP_MASK
#define REP_MASK 0u
#endif
#define REPS(k) (1 + (int)((REP_MASK >> ((k) > 13 ? 13 + (((k) - 13) & 1) : (k))) & 1u))
    unsigned char* ws = args.ws;
    float* R0 = (float*)(ws + WS_R0); bf16* XB = (bf16*)(ws + WS_XB);
    const int cblk = (int)blockIdx.x;

    if (IN(0)) for (int rep_ = 0; rep_ < REPS(0); ++rep_) { refresh(F); p0_prologue(F); if (BOTH(0)) GRID_BAR(); }
    if (IN(1)) for (int rep_ = 0; rep_ < REPS(1); ++rep_) { refresh(F);
        pg8::Gemm g{(const bf16*)(ws + WS_APOOL), (const bf16*)(ws + W_POOL), D, 256, 256}; ep::PoolOrder S{F.G, cblk};
        ep::EpiPool E{F.inp(I_X), F.inp(I_POOLS), R0};
        pg8::gemm_phase<ep::EpiPool, ep::PoolOrder, true, false>(F.lds + RING_OFF, g, S, E);
        if (BOTH(1)) GRID_BAR(); }
    if (IN(2)) for (int rep_ = 0; rep_ < REPS(2); ++rep_) { refresh(F); ln_phase(F, R0, F.inp(I_LNG) + 0 * D, F.inp(I_LNB) + 0 * D, R0, XB); if (BOTH(2)) GRID_BAR(); }
    if (IN(3)) for (int rep_ = 0; rep_ < REPS(3); ++rep_) { refresh(F);
        pg8::Gemm g{XB, (const bf16*)(ws + W_FGU), D, D, D}; ep::DenseOrder S{T / 256, 2 * DFF / 256, F.G, cblk, (size_t)256 * D * 2, (size_t)256 * D * 2};
        ep::EpiSwiGLU E{(bf16*)(ws + WS_H1), DFF, 0};
        pg8::gemm_phase(F.lds + RING_OFF, g, S, E);
        if (BOTH(3)) GRID_BAR(); }
    if (IN(4)) for (int rep_ = 0; rep_ < REPS(4); ++rep_) { refresh(F);
        pg8::Gemm g{(const bf16*)(ws + WS_H1), (const bf16*)(ws + W_FDN), DFF, DFF, DFF}; ep::DenseOrder S{T / 256, D / 256, F.G, cblk, (size_t)256 * DFF * 2, (size_t)256 * DFF * 2};
        ep::EpiResid E{R0};
        pg8::gemm_phase(F.lds + RING_OFF, g, S, E);
        if (BOTH(4)) GRID_BAR(); }
    if (IN(5)) for (int rep_ = 0; rep_ < REPS(5); ++rep_) { refresh(F); ln_phase(F, R0, F.inp(I_LNG) + 1 * D, F.inp(I_LNB) + 1 * D, R0, XB); if (BOTH(5)) GRID_BAR(); }
    if (IN(6)) for (int rep_ = 0; rep_ < REPS(6); ++rep_) { refresh(F);
        pg8::Gemm g{XB, (const bf16*)(ws + W_IN), D, D, D}; ep::DenseOrder S{T / 256, INP_PAD / 256, F.G, cblk, (size_t)256 * D * 2, (size_t)256 * D * 2};
        ep::EpiInProj E{(bf16*)(ws + WS_Q), (bf16*)(ws + WS_KV6), (float*)(ws + WS_GATES), (const float*)(ws + WS_ROPE), (const float*)(ws + WS_ROPE) + SEQ * 32};
        pg8::gemm_phase(F.lds + RING_OFF, g, S, E);
        if (BOTH(6)) GRID_BAR(); }
    if (IN(7)) for (int rep_ = 0; rep_ < REPS(7); ++rep_) { refresh(F);
        pg8::Gemm g{(const bf16*)(ws + WS_KV6), (const bf16*)(ws + W_C1), 1024, 2048, 512}; ep::CmpOrder S{F.G, cblk};
        ep::EpiCPart E{(float*)(ws + WS_CPART)};
        pg8::gemm_phase(F.lds + RING_OFF, g, S, E);
        if (BOTH(7)) GRID_BAR(); }
    if (IN(8)) for (int rep_ = 0; rep_ < REPS(8); ++rep_) { refresh(F); compress_finish_phase(F); if (BOTH(8)) GRID_BAR(); }
    if (IN(9)) for (int rep_ = 0; rep_ < REPS(9); ++rep_) { refresh(F); att::attn_phase(F); if (BOTH(9)) GRID_BAR(); }
    if (IN(10)) for (int rep_ = 0; rep_ < REPS(10); ++rep_) { refresh(F);
        pg8::Gemm g{(const bf16*)(ws + WS_AO), (const bf16*)(ws + W_OUT), D, D, D}; ep::DenseOrder S{T / 256, D / 256, F.G, cblk, (size_t)256 * D * 2, (size_t)256 * D * 2};
        ep::EpiResid E{R0};
        pg8::gemm_phase(F.lds + RING_OFF, g, S, E);
        if (BOTH(10)) GRID_BAR(); }
    if (IN(11)) for (int rep_ = 0; rep_ < REPS(11); ++rep_) { refresh(F); ln_router_phase(F, R0, F.inp(I_LNG) + 2 * D, F.inp(I_LNB) + 2 * D, XB); if (BOTH(11)) GRID_BAR(); }
    if (IN(12)) for (int rep_ = 0; rep_ < REPS(12); ++rep_) { refresh(F); moe_dispatch_phase(F); if (BOTH(12)) GRID_BAR(); }
    for (int ch = 0; ch < MOE_NCH; ++ch) {
        const int p1 = 13 + 2 * ch, p2 = p1 + 1;
        const LAS int* mt = (const LAS int*)(F.lds + MOET_OFF);
        if (IN(p1)) for (int rep_ = 0; rep_ < REPS(p1); ++rep_) { refresh(F);
            if (lo == p1) moe_tables(F);
            const int NT = mt[24], tile0 = MOE_CH * ch, nM = (NT - tile0) < MOE_CH ? (NT - tile0) : MOE_CH;
            if (nM > 0) {
                pg8::Gemm g{(const bf16*)(ws + WS_XS), (const bf16*)(ws + W_MGU), D, D, D};
                ep::MoeOrder<2 * DFE / 256> S{nM, F.G, cblk, tile0, mt + 32, (size_t)256 * D * 2, (size_t)2 * DFE * D * 2, (size_t)256 * D * 2, false};
                ep::EpiSwiGLU E{(bf16*)(ws + WS_H2), DFE, tile0};
                pg8::gemm_phase(F.lds + RING_OFF, g, S, E);
                if (BOTH(p1)) GRID_BAR(); } }
        if (IN(p2)) for (int rep_ = 0; rep_ < REPS(p2); ++rep_) { refresh(F);
            if (lo == p2) moe_tables(F);
            const int NT = mt[24], tile0 = MOE_CH * ch, nM = (NT - tile0) < MOE_CH ? (NT - tile0) : MOE_CH;
            if (nM > 0) {
                pg8::Gemm g{(const bf16*)(ws + WS_H2), (const bf16*)(ws + W_MDN), DFE, DFE, DFE};
                ep::MoeOrder<D / 256> S{nM, F.G, cblk, tile0, mt + 32, (size_t)256 * DFE * 2, (size_t)D * DFE * 2, (size_t)256 * DFE * 2, true};
                ep::EpiMoeDown E{(bf16*)(ws + WS_Y), (const int*)(ws + WS_SDST), (const float*)(ws + WS_SW)};
                pg8::gemm_phase(F.lds + RING_OFF, g, S, E);
                if (BOTH(p2)) GRID_BAR(); } }
    }
    if (IN(23)) for (int rep_ = 0; rep_ < REPS(23); ++rep_) { refresh(F); final_phase(F, R0, F.inp(I_LNG) + 3 * D, F.inp(I_LNB) + 3 * D, F.out); }
#undef IN
#undef BOTH
#undef GRID_BAR
}

extern "C" void kernel_launch(void* const* d_in, const int* in_sizes, int n_in, void* d_out, int out_size, void* d_ws, size_t ws_size, hipStream_t stream) {
    static int grid = 0;
    if (grid == 0) {
        if (n_in != 18 || in_sizes[0] != T * D || out_size != T * D || ws_size < WS_END) { fprintf(stderr, "kernel_launch: shape/workspace mismatch (n_in %d, ws %zu)\n", n_in, ws_size); grid = -1; return; }
        int dev = 0, cus = 0, per_cu = 0;
        if (hipGetDevice(&dev) != hipSuccess || hipDeviceGetAttribute(&cus, hipDeviceAttributeMultiprocessorCount, dev) != hipSuccess) { grid = -1; return; }
        if (hipFuncSetAttribute((const void*)fwd_kernel, hipFuncAttributeMaxDynamicSharedMemorySize, LDS_BYTES) != hipSuccess) { fprintf(stderr, "kernel_launch: hipFuncSetAttribute failed\n"); grid = -1; return; }
        if (hipOccupancyMaxActiveBlocksPerMultiprocessor(&per_cu, (const void*)fwd_kernel, NWAVES * 64, LDS_BYTES) != hipSuccess || per_cu < 1) { fprintf(stderr, "kernel_launch: occupancy query says %d blocks per CU\n", per_cu); }
        (void)hipGetLastError();
        if (cus != 256) { fprintf(stderr, "kernel_launch: built for 256 CUs, device has %d\n", cus); grid = -1; return; }
        grid = 256;
    }
    if (grid < 0) return;
    if (hipMemsetAsync((char*)d_ws + WS_CTL, 0, CTL_ZERO_BYTES, stream) != hipSuccess) return;
    Args a{};
    for (int i = 0; i < 18; ++i) a.in[i] = (const float*)d_in[i];
    a.out = (float*)d_out; a.ws = (unsigned char*)d_ws;
#if MK_PER_PHASE
    for (int p = 0; p < N_PHASES; ++p) { a.ph_lo = p; a.ph_hi = p + 1; a.li = p; hipLaunchKernelGGL(fwd_kernel, dim3(grid), dim3(NWAVES * 64), LDS_BYTES, stream, a); }
#else
    a.ph_lo = 0; a.ph_hi = N_PHASES; a.li = 0;
    hipLaunchKernelGGL(fwd_kernel, dim3(grid), dim3(NWAVES * 64), LDS_BYTES, stream, a);
#endif
}
```

```cpp
#include <hip/hip_runtime.h>
#include <cstdio>
#include <cstdint>

namespace pg8 {
#define PG8_LAS __attribute__((address_space(3)))
typedef unsigned short bf16_t;
typedef short bf16x8 __attribute__((ext_vector_type(8)));
typedef float f32x4 __attribute__((ext_vector_type(4)));
typedef float f32x2 __attribute__((ext_vector_type(2)));
typedef unsigned u32x4 __attribute__((ext_vector_type(4)));
typedef unsigned u32x2 __attribute__((ext_vector_type(2)));
constexpr int BM = 256, BK = 64, HALF = 128, HTB = HALF * BK * 2  , STAGE_BYTES = 8 * HTB, NXCD = 8, WGM = 8;

__host__ __device__ __forceinline__ int lds_byte(int r, int c) { const int st = (r >> 4) * 2 + (c >> 5), rr = r & 15, cc = c & 31, ob = rr * 64 + cc * 2; return st * 1024 + (ob ^ (((ob >> 9) & 1) << 5)); }
__host__ __device__ __forceinline__ void stage_rc(int b, int& R, int& C) { const int st = b / 1024, sb = b % 1024, swz = sb ^ (((sb >> 9) & 1) << 5); R = (st >> 1) * 16 + swz / 64; C = (st & 1) * 32 + (swz % 64) / 2; }
__host__ __device__ __forceinline__ int perm32(int rho) { const int n = rho >> 4, i = rho & 15; return 8 * (i >> 2) + 4 * n + (i & 3); }

struct Unit { int pm, pn; size_t aoff, boff; };
struct Gemm { const bf16_t* A; const bf16_t* Bt; int lda, ldb, K; };

__device__ __forceinline__ void order_tile(int L, int nM, int nN, int& pm, int& pn) {
    const int nwg = nM * nN; int wgid = L;
    { const int q = nwg / NXCD, r = nwg % NXCD, xcd = wgid % NXCD, off = wgid / NXCD; wgid = (xcd < r ? xcd * (q + 1) : r * (q + 1) + (xcd - r) * q) + off; }
    const int nig = WGM * nN, gid = wgid / nig, fm = gid * WGM, gsz = (nM - fm) < WGM ? (nM - fm) : WGM;
    pm = fm + ((wgid % nig) % gsz); pn = (wgid % nig) / gsz;
}

__device__ __forceinline__ unsigned cvt_pk_bf16(float lo, float hi) { unsigned r; asm volatile("v_cvt_pk_bf16_f32 %0, %1, %2" : "=v"(r) : "v"(lo), "v"(hi)); return r; }

template <class Epi, class Sched, bool ALIGN_EPI = true, bool SP2 = true>
__device__ __forceinline__ void gemm_phase(PG8_LAS unsigned char* lds, const Gemm g, const Sched& S, const Epi& E) {
    int tid = threadIdx.x; asm volatile("" : "+v"(tid));
    const int wid = __builtin_amdgcn_readfirstlane(tid >> 6), lane = tid & 63, wr = wid >> 2, wc = wid & 3, fr = lane & 15, fq = lane >> 4;
    const int K = g.K, nt = K / BK;
    unsigned voffA[2], voffB[2];
#pragma unroll
    for (int i = 0; i < 2; ++i) { int R, C; stage_rc(tid * 16 + i * 8192, R, C); const int Rb = Epi::PERM ? ((R & ~31) + perm32(R & 31)) : R;
        voffA[i] = (unsigned)(R * g.lda + C) * 2u; voffB[i] = (unsigned)(Rb * g.ldb + C) * 2u; }
    const size_t kstep = (size_t)(BK * 2);
    const size_t hstepA = (size_t)HALF * g.lda * 2, hstepB = (size_t)HALF * g.ldb * 2;
    const unsigned ldsw = (unsigned)wid * 1024u;
    const int aoff = lds_byte(wr * 64 + fr, fq * 8), boff = lds_byte(wc * 32 + fr, fq * 8);
#define PG8_SA(b, h) (((b) * 2 + (h)) * HTB)
#define PG8_SB(b, h) ((4 + (b) * 2 + (h)) * HTB)
#define PG8_STAGE(bufoff, gbase, voff) do { _Pragma("unroll") for (int _i = 0; _i < 2; ++_i) \
        __builtin_amdgcn_global_load_lds((const unsigned*)((const char*)(gbase) + (voff)[_i]), (PG8_LAS unsigned*)(lds + (bufoff) + ldsw + _i * 8192), 16, 0, 0); } while (0)
#define PG8_LDA(dst, b, h) do { _Pragma("unroll") for (int m = 0; m < 4; ++m) _Pragma("unroll") for (int k = 0; k < 2; ++k) dst[m][k] = *(const PG8_LAS bf16x8*)(lds + PG8_SA(b, h) + aoff + m * 2048 + k * 1024); } while (0)
#define PG8_LDB(dst, b, h) do { _Pragma("unroll") for (int n = 0; n < 2; ++n) _Pragma("unroll") for (int k = 0; k < 2; ++k) dst[n][k] = *(const PG8_LAS bf16x8*)(lds + PG8_SB(b, h) + boff + n * 2048 + k * 1024); } while (0)
#define PG8_MMA(ai, bj, At, Bt) do { __builtin_amdgcn_s_setprio(1); _Pragma("unroll") for (int m = 0; m < 4; ++m) _Pragma("unroll") for (int n = 0; n < 2; ++n) _Pragma("unroll") for (int k = 0; k < 2; ++k) \
        acc[ai][bj][m][n] = __builtin_amdgcn_mfma_f32_16x16x32_bf16(Bt[n][k], At[m][k], acc[ai][bj][m][n], 0, 0, 0); __builtin_amdgcn_s_setprio(0); } while (0)
#define PG8_WAIT_V(n) asm volatile("s_waitcnt vmcnt(" #n ")" ::: "memory")
#define PG8_WAIT_L(n) asm volatile("s_waitcnt lgkmcnt(" #n ")" ::: "memory")
#define PG8_BAR __builtin_amdgcn_s_barrier()
#define PG8_SCHED __builtin_amdgcn_sched_barrier(0)
    Unit cur, nxt; int ui = 0;
    if (!S.next(0, cur)) return;
    f32x4 acc[2][2][4][2];
#pragma unroll
    for (int a = 0; a < 2; ++a)
#pragma unroll
        for (int b = 0; b < 2; ++b)
#pragma unroll
            for (int m = 0; m < 4; ++m)
#pragma unroll
                for (int n = 0; n < 2; ++n) acc[a][b][m][n] = (f32x4){0.f, 0.f, 0.f, 0.f};
    bf16x8 At[4][2], B0[2][2], B1[2][2];
    const char* cA = (const char*)g.A + cur.aoff; const char* cB = (const char*)g.Bt + cur.boff;
    if constexpr (SP2) {
        PG8_STAGE(PG8_SB(0, 0), cB, voffB); PG8_STAGE(PG8_SB(0, 1), cB + hstepB, voffB); PG8_STAGE(PG8_SA(0, 0), cA, voffA); PG8_STAGE(PG8_SA(0, 1), cA + hstepA, voffA);
        if (wr == 1) PG8_BAR;
        PG8_WAIT_V(2); PG8_BAR;
        PG8_STAGE(PG8_SB(1, 0), cB + kstep, voffB); PG8_STAGE(PG8_SA(1, 0), cA + kstep, voffA); PG8_STAGE(PG8_SB(1, 1), cB + hstepB + kstep, voffB);
        PG8_WAIT_V(6); PG8_BAR;
    } else {
        PG8_STAGE(PG8_SB(0, 0), cB, voffB); PG8_STAGE(PG8_SA(0, 0), cA, voffA); PG8_STAGE(PG8_SB(0, 1), cB + hstepB, voffB); PG8_STAGE(PG8_SA(0, 1), cA + hstepA, voffA);
        if (wr == 1) PG8_BAR;
        PG8_WAIT_V(4); PG8_BAR;
        PG8_STAGE(PG8_SB(1, 0), cB + kstep, voffB); PG8_STAGE(PG8_SA(1, 0), cA + kstep, voffA); PG8_STAGE(PG8_SB(1, 1), cB + hstepB + kstep, voffB);
        PG8_WAIT_V(6); PG8_BAR;
    }
    for (;;) {
        const bool has_next = S.next(ui + 1, nxt);
        const char* nA = has_next ? (const char*)g.A + nxt.aoff : cA; const char* nB = has_next ? (const char*)g.Bt + nxt.boff : cB;
        for (int t = 0; t < nt; t += 2) {
            const bool last = (t == nt - 2);
            const char* a1 = cA + (size_t)(t + 1) * kstep;
            const char* a2 = last ? nA : cA + (size_t)(t + 2) * kstep; const char* b2 = last ? nB : cB + (size_t)(t + 2) * kstep;
            const char* a3 = a2 + kstep; const char* b3 = b2 + kstep;
            if constexpr (SP2) {
            PG8_LDB(B0, 0, 0); PG8_LDB(B1, 0, 1); PG8_SCHED; PG8_LDA(At, 0, 0); PG8_STAGE(PG8_SA(1, 1), a1 + hstepA, voffA);
            PG8_WAIT_V(8); PG8_WAIT_L(0); PG8_BAR; PG8_MMA(0, 0, At, B0); PG8_MMA(0, 1, At, B1); PG8_BAR; PG8_SCHED;
            PG8_LDA(At, 0, 1); PG8_STAGE(PG8_SB(0, 0), b2, voffB); PG8_STAGE(PG8_SB(0, 1), b2 + hstepB, voffB); PG8_STAGE(PG8_SA(0, 0), a2, voffA);
            PG8_WAIT_V(8); PG8_WAIT_L(0); PG8_BAR; PG8_MMA(1, 0, At, B0); PG8_MMA(1, 1, At, B1); PG8_BAR; PG8_SCHED;
            PG8_LDB(B0, 1, 0); PG8_LDB(B1, 1, 1); PG8_SCHED; PG8_LDA(At, 1, 0); PG8_STAGE(PG8_SA(0, 1), a2 + hstepA, voffA);
            PG8_WAIT_V(8); PG8_WAIT_L(0); PG8_BAR; PG8_MMA(0, 0, At, B0); PG8_MMA(0, 1, At, B1); PG8_BAR; PG8_SCHED;
            PG8_LDA(At, 1, 1); PG8_STAGE(PG8_SB(1, 0), b3, voffB); PG8_STAGE(PG8_SB(1, 1), b3 + hstepB, voffB); PG8_STAGE(PG8_SA(1, 0), a3, voffA);
            PG8_WAIT_V(8); PG8_WAIT_L(0); PG8_BAR; PG8_MMA(1, 0, At, B0); PG8_MMA(1, 1, At, B1); PG8_BAR; PG8_SCHED;
            } else {
            PG8_LDB(B0, 0, 0); PG8_SCHED; PG8_LDA(At, 0, 0); PG8_STAGE(PG8_SA(1, 1), a1 + hstepA, voffA);
            PG8_WAIT_L(8); PG8_BAR; PG8_WAIT_L(0); PG8_MMA(0, 0, At, B0); PG8_BAR; PG8_SCHED;
            PG8_LDB(B1, 0, 1); PG8_STAGE(PG8_SB(0, 0), b2, voffB);
            PG8_BAR; PG8_WAIT_L(0); PG8_MMA(0, 1, At, B1); PG8_BAR;
            PG8_LDA(At, 0, 1); PG8_STAGE(PG8_SA(0, 0), a2, voffA);
            PG8_BAR; PG8_WAIT_L(0); PG8_MMA(1, 0, At, B0); PG8_BAR; PG8_SCHED;
            PG8_STAGE(PG8_SB(0, 1), b2 + hstepB, voffB);
            PG8_WAIT_V(6); PG8_BAR; PG8_MMA(1, 1, At, B1); PG8_BAR;
            PG8_LDB(B0, 1, 0); PG8_SCHED; PG8_LDA(At, 1, 0); PG8_STAGE(PG8_SA(0, 1), a2 + hstepA, voffA);
            PG8_WAIT_L(8); PG8_BAR; PG8_WAIT_L(0); PG8_MMA(0, 0, At, B0); PG8_BAR; PG8_SCHED;
            PG8_LDB(B1, 1, 1); PG8_STAGE(PG8_SB(1, 0), b3, voffB);
            PG8_BAR; PG8_WAIT_L(0); PG8_MMA(0, 1, At, B1); PG8_BAR;
            PG8_LDA(At, 1, 1); PG8_STAGE(PG8_SA(1, 0), a3, voffA);
            PG8_BAR; PG8_WAIT_L(0); PG8_MMA(1, 0, At, B0); PG8_BAR; PG8_SCHED;
            PG8_STAGE(PG8_SB(1, 1), b3 + hstepB, voffB);
            PG8_WAIT_V(6); PG8_BAR; PG8_MMA(1, 1, At, B1); PG8_BAR;
            }
        }
        if constexpr (ALIGN_EPI) { if (wr == 0) PG8_BAR; }
        E(acc, cur, wr, wc, fr, fq);
        if (!has_next) break;
#pragma unroll
        for (int a = 0; a < 2; ++a)
#pragma unroll
            for (int b = 0; b < 2; ++b)
#pragma unroll
                for (int m = 0; m < 4; ++m)
#pragma unroll
                    for (int n = 0; n < 2; ++n) acc[a][b][m][n] = (f32x4){0.f, 0.f, 0.f, 0.f};
        cur = nxt; cA = nA; cB = nB; ++ui;
        if constexpr (ALIGN_EPI) { if (wr == 1) PG8_BAR; }
    }
    PG8_WAIT_V(0);
    if constexpr (!ALIGN_EPI) { if (wr == 0) PG8_BAR; }
    PG8_BAR;
#undef PG8_SA
#undef PG8_SB
#undef PG8_STAGE
#undef PG8_LDA
#undef PG8_LDB
#undef PG8_MMA
#undef PG8_WAIT_V
#undef PG8_WAIT_L
#undef PG8_BAR
#undef PG8_SCHED
}
}

constexpr int NWAVES = 8;
constexpr int BATCH = 8, SEQ = 4096, D = 1024, T = BATCH * SEQ;
constexpr int DFF = 2816, NE = 8, DFE = 3584, INP = 2608, INP_PAD = 2816;
constexpr int NH = 16, NG = 4, HD = 64;
constexpr float LN_EPS = 1e-5f;
constexpr float ALPHA = 1.4142135623730951f;
constexpr float QSCALE = 0.125f * 1.4426950408889634f;
constexpr int MOE_CH = 64;
constexpr int MOE_MAXT = 264;
constexpr int MOE_NCH = 5;

constexpr size_t MiB = 1u << 20;
constexpr size_t WS_CTL = 0, CTL_ZERO_BYTES = 1 * MiB;
constexpr size_t WS_ROPE = 1 * MiB;
constexpr size_t WS_MISC = 2 * MiB;
constexpr size_t WS_SEL = 3 * MiB;
constexpr size_t WS_SDST = 4 * MiB;
constexpr size_t WS_SW = 5 * MiB;
constexpr size_t WS_KVC = 6 * MiB;
constexpr size_t WS_CPART = 8 * MiB;
constexpr size_t WS_GATES = 40 * MiB;
constexpr size_t W_POOL = 48 * MiB, W_FGU = 49 * MiB, W_FDN = 60 * MiB, W_IN = 66 * MiB, W_C1 = 72 * MiB, W_OUT = 74 * MiB, W_MGU = 76 * MiB, W_MDN = 188 * MiB;
constexpr size_t WS_R0 = 256 * MiB;
constexpr size_t WS_XB = 384 * MiB;
constexpr size_t WS_BIG = 448 * MiB;
constexpr size_t WS_APOOL = WS_BIG, WS_H1 = 512 * MiB;
constexpr size_t WS_Q = WS_BIG, WS_KV6 = 512 * MiB, WS_AO = 616 * MiB;
constexpr size_t WS_XS = WS_BIG, WS_H2 = 580 * MiB, WS_Y = 692 * MiB;
constexpr size_t WS_END = 820 * MiB;
constexpr size_t KV6_STRIDE = (size_t)T * 256;
static_assert(W_MGU + (size_t)NE * 2 * DFE * D * 2 <= W_MDN && W_MDN + (size_t)NE * D * DFE * 2 <= WS_R0, "weights map");
static_assert(WS_H1 + (size_t)T * DFF * 2 <= WS_END && WS_XS + (size_t)MOE_MAXT * 256 * D * 2 <= WS_H2 && WS_H2 + (size_t)MOE_CH * 256 * DFE * 2 <= WS_Y && WS_Y + (size_t)T * 2 * D * 2 <= WS_END, "big map");
constexpr int CW_TMO = 0, CW_BAR = 4096;
constexpr int N_BAR_REGIONS = 28;

constexpr int RING_OFF = 0, RING_BYTES = 155648;
constexpr int LDSCTL_OFF = RING_BYTES, MISC_OFF = LDSCTL_OFF + 320;
constexpr int PTR_OFF = RING_BYTES + 512;
constexpr int MOET_OFF = RING_BYTES + 1024;
constexpr int LDS_BYTES = 163840;

#define GAS __attribute__((address_space(1)))
#define LAS __attribute__((address_space(3)))
typedef unsigned short bf16;
typedef unsigned v4u __attribute__((ext_vector_type(4)));
typedef unsigned v2u __attribute__((ext_vector_type(2)));
typedef float f32x4 __attribute__((ext_vector_type(4)));
typedef float f32x2 __attribute__((ext_vector_type(2)));
typedef short bf16x8 __attribute__((ext_vector_type(8)));
typedef GAS unsigned gu32;
#define RLX_AGENT __ATOMIC_RELAXED, __HIP_MEMORY_SCOPE_AGENT
#define LDS_WAIT() asm volatile("s_waitcnt lgkmcnt(0)" ::: "memory")
#define VM_WAIT() asm volatile("s_waitcnt vmcnt(0)" ::: "memory")
__device__ __forceinline__ unsigned f2bf(float f) { unsigned u = __builtin_bit_cast(unsigned, f); return (u + 0x7fffu + ((u >> 16) & 1u)) >> 16; }
__device__ __forceinline__ unsigned pk2(float lo, float hi) { return f2bf(lo) | (f2bf(hi) << 16); }
__device__ __forceinline__ float bf2f(unsigned h) { return __builtin_bit_cast(float, h << 16); }

#define XB_TMO      128
#define XB_XCNT(j)  (256  + 64 * (j))
#define XB_XSUB(j)  (1280 + 64 * (j))
#define XB_XGEN(j)  (2304 + 64 * (j))
#define XB_TOP      3328
#define XB_TOPGEN   3392
#define XCD_BAR_WORDS 3456
#define XB_SPIN_CAP (1u << 18)
__device__ __forceinline__ unsigned xb_ld(unsigned* p)              { return __hip_atomic_load(p, __ATOMIC_RELAXED, __HIP_MEMORY_SCOPE_AGENT); }
__device__ __forceinline__ unsigned xb_add(unsigned* p, unsigned v) { return __hip_atomic_fetch_add(p, v, __ATOMIC_RELAXED, __HIP_MEMORY_SCOPE_AGENT); }
__device__ __forceinline__ unsigned xb_xcc_id() { return (unsigned)__builtin_amdgcn_s_getreg((3 << 11) | 20) & 0xFu; }
#define XB_SPIN(cond, bar) do { unsigned _sp = 0; while (cond) { __builtin_amdgcn_s_sleep(1); \
    if ((++_sp & 255u) == 0u) { if (xb_ld(&(bar)[XB_TMO])) break; if (_sp > XB_SPIN_CAP) { atomicAdd(&(bar)[XB_TMO], 1u); break; } } } } while (0)
struct XcdBarrier { unsigned* bar; unsigned x; volatile LAS unsigned* st; };
__device__ __forceinline__ XcdBarrier xcd_barrier_post(unsigned* bar, volatile LAS unsigned* st) {
    XcdBarrier b; b.bar = bar; b.x = xb_xcc_id(); b.st = st;
    if (threadIdx.x == 0) (void)xb_add(&bar[XB_XCNT(b.x)], 1u);
    return b;
}
__device__ __forceinline__ void xcd_barrier_complete(unsigned* bar, unsigned x, unsigned& nloc, unsigned& nx) {
    const unsigned G = gridDim.x * gridDim.y * gridDim.z;
    unsigned sum, cnt, mine, sp = 0u;
    for (;;) {
        sum = 0u; cnt = 0u; mine = 0u;
#pragma unroll
        for (unsigned j = 0; j < 16; ++j) { const unsigned c = xb_ld(&bar[XB_XCNT(j)]); sum += c; cnt += (c > 0u) ? 1u : 0u; mine = (j == x) ? c : mine; }
        if (sum == G) break;
        __builtin_amdgcn_s_sleep(1);
        if ((++sp & 255u) == 0u) { if (xb_ld(&bar[XB_TMO])) break; if (sp > XB_SPIN_CAP) { atomicAdd(&bar[XB_TMO], 1u); break; } }
    }
    nloc = mine > 0u ? mine : 1u; nx = cnt > 0u ? cnt : 1u;
}
__device__ __forceinline__ void xcd_barrier(const XcdBarrier& b) {
    asm volatile("s_waitcnt vmcnt(0)" ::: "memory");
    __syncthreads();
    if (threadIdx.x == 0) {
        unsigned* bar = b.bar;
        __builtin_amdgcn_s_waitcnt(0);
        unsigned nloc = b.st[0], nx = b.st[1];
        if (nloc == 0u) { xcd_barrier_complete(bar, b.x, nloc, nx); b.st[0] = nloc; b.st[1] = nx; }
        const unsigned old = xb_add(&bar[XB_XSUB(b.x)], 1u);
        const unsigned gen = old / nloc;
        if (old + 1u == (gen + 1u) * nloc) {
            __builtin_amdgcn_fence(__ATOMIC_RELEASE, "agent");
            asm volatile("s_waitcnt vmcnt(0)" ::: "memory");
            const unsigned og = xb_add(&bar[XB_TOP], 1u);
            const unsigned tg = og / nx;
            if (og + 1u == (tg + 1u) * nx) xb_add(&bar[XB_TOPGEN], 1u);
            else XB_SPIN(xb_ld(&bar[XB_TOPGEN]) == tg, bar);
            __builtin_amdgcn_fence(__ATOMIC_ACQUIRE, "agent");
            xb_add(&bar[XB_XGEN(b.x)], 1u);
            asm volatile("s_waitcnt vmcnt(0)" ::: "memory");
        } else {
            XB_SPIN(xb_ld(&bar[XB_XGEN(b.x)]) == gen, bar);
            __builtin_amdgcn_fence(__ATOMIC_ACQUIRE, "agent");
            asm volatile("s_waitcnt vmcnt(0)" ::: "memory");
        }
    }
    __syncthreads();
}

struct Frame {
    LAS unsigned char* lds;
    volatile LAS unsigned* MISC;
    gu32* ctl;
    unsigned char* ws;
    int tid, lane, wave;
    int vcu, G;
    float* out;
    __device__ __forceinline__ const float* inp(int i) const {
        const unsigned long long v = ((const LAS unsigned long long*)(lds + PTR_OFF))[i];
        const unsigned lo = __builtin_amdgcn_readfirstlane((unsigned)v), hi = __builtin_amdgcn_readfirstlane((unsigned)(v >> 32));
        return (const float*)(((unsigned long long)hi << 32) | lo); }
};
enum { I_X = 0, I_LNG, I_LNB, I_POOLW, I_POOLS, I_WIN, I_PEK, I_W1K, I_W2K, I_PEV, I_W1V, I_W2V, I_WOUT, I_FGU, I_FDN, I_ROUTER, I_MGU, I_MDN };

__device__ __forceinline__ void refresh(Frame& F) { int t = threadIdx.x; asm volatile("" : "+v"(t)); F.tid = t; F.lane = t & 63; F.wave = __builtin_amdgcn_readfirstlane(t >> 6); }
__device__ __forceinline__ float wave_sum(float v) {
#pragma unroll
    for (int o = 1; o < 64; o <<= 1) v += __shfl_xor(v, o);
    return v;
}
__device__ __forceinline__ float silu_f(float x) { return x * __builtin_amdgcn_rcpf(1.0f + __builtin_amdgcn_exp2f(-1.4426950408889634f * x)); }

__device__ __forceinline__ int wrow_map(int mode, int n, int Npad) {
    if (mode == 0) return n;
    if (mode == 1) { const int half = Npad >> 1; return n < half ? ((n >> 7) << 8) + (n & 127) : (((n - half) >> 7) << 8) + 128 + ((n - half) & 127); }
    const int tile = n >> 8, o = n & 255, head = o >> 6, hf = (o >> 5) & 1, i = o & 31;
    return (tile << 8) + 128 * (head >> 1) + 32 * (2 * (head & 1) + (i >> 4)) + 16 * hf + (i & 15);
}
struct WItem { const float* W; bf16* WT; int K, Nreal, Npad, mode, k0, n0; };
constexpr int W_NITEMS_POOL = 4 * 4 * 4, W_NI_FG = (D / 64) * (2 * DFF / 64), W_NI_FD = (DFF / 64) * (D / 64), W_NI_IN = (D / 64) * (INP_PAD / 64), W_NI_C1 = (2048 / 64) * (256 / 64), W_NI_WO = (D / 64) * (D / 64);
constexpr int W_NI_MG = (D / 64) * (2 * DFE / 64), W_NI_MD = (DFE / 64) * (D / 64);
constexpr int W_NITEMS = W_NITEMS_POOL + W_NI_FG + W_NI_FD + W_NI_IN + 2 * W_NI_C1 + W_NI_WO + NE * W_NI_MG + NE * W_NI_MD;
constexpr int W_MOE0 = W_NITEMS - NE * (W_NI_MG + W_NI_MD);
__device__ __forceinline__ WItem witem_decode(const Frame& F, int it) {
    WItem w; int r = it; int sub;
    unsigned char* ws = F.ws;
    if (r < W_NITEMS_POOL) { const int g = r / 16; sub = r % 16; w = WItem{F.inp(I_POOLW) + (size_t)g * 65536, (bf16*)(ws + W_POOL) + (size_t)g * 65536, 256, 256, 256, 0, 0, 0}; }
    else if ((r -= W_NITEMS_POOL) < W_NI_FG) { sub = r; w = WItem{F.inp(I_FGU), (bf16*)(ws + W_FGU), D, 2 * DFF, 2 * DFF, 1, 0, 0}; }
    else if ((r -= W_NI_FG) < W_NI_FD) { sub = r; w = WItem{F.inp(I_FDN), (bf16*)(ws + W_FDN), DFF, D, D, 0, 0, 0}; }
    else if ((r -= W_NI_FD) < W_NI_IN) { sub = r; w = WItem{F.inp(I_WIN), (bf16*)(ws + W_IN), D, INP, INP_PAD, 2, 0, 0}; }
    else if ((r -= W_NI_IN) < 2 * W_NI_C1) { const int kv = r / W_NI_C1; sub = r % W_NI_C1; w = WItem{F.inp(kv ? I_W1V : I_W1K), (bf16*)(ws + W_C1) + (size_t)kv * 256 * 2048, 2048, 128, 256, 0, 0, 0}; }
    else if ((r -= 2 * W_NI_C1) < W_NI_WO) { sub = r; w = WItem{F.inp(I_WOUT), (bf16*)(ws + W_OUT), D, D, D, 0, 0, 0}; }
    else if ((r -= W_NI_WO) < NE * W_NI_MG) { const int e = r / W_NI_MG; sub = r % W_NI_MG; w = WItem{F.inp(I_MGU) + (size_t)e * D * 2 * DFE, (bf16*)(ws + W_MGU) + (size_t)e * 2 * DFE * D, D, 2 * DFE, 2 * DFE, 1, 0, 0}; }
    else { r -= NE * W_NI_MG; const int e = r / W_NI_MD; sub = r % W_NI_MD; w = WItem{F.inp(I_MDN) + (size_t)e * DFE * D, (bf16*)(ws + W_MDN) + (size_t)e * D * DFE, DFE, D, D, 0, 0, 0}; }
    const int nblk = w.Npad / 64; w.k0 = 64 * (sub / nblk); w.n0 = 64 * (sub % nblk);
    return w;
}
__device__ __forceinline__ void witem_load(const WItem& w, int lane, f32x4 (&ld)[16]) {
    const int nn = w.n0 + 4 * (lane & 15); const bool ok = nn < w.Nreal;
    const float* base = w.W + (size_t)(w.k0 + 2 * (lane >> 4)) * w.Nreal + nn;
#pragma unroll
    for (int j = 0; j < 16; ++j) { const int kk = 8 * (j >> 1) + (j & 1); ld[j] = ok ? *(const GAS f32x4*)(base + (size_t)kk * w.Nreal) : (f32x4){0.f, 0.f, 0.f, 0.f}; }
}
__device__ __forceinline__ void witem_store(const WItem& w, int lane, const f32x4 (&ld)[16], LAS unsigned* scr) {
#pragma unroll
    for (int m = 0; m < 8; ++m) { const f32x4 a = ld[2 * m], b = ld[2 * m + 1]; LAS unsigned* d = scr + (4 * m + (lane >> 4)) * 66 + 4 * (lane & 15);
        *(LAS v2u*)d = (v2u){pg8::cvt_pk_bf16(a[0], b[0]), pg8::cvt_pk_bf16(a[1], b[1])}; *(LAS v2u*)(d + 2) = (v2u){pg8::cvt_pk_bf16(a[2], b[2]), pg8::cvt_pk_bf16(a[3], b[3])}; }
    LDS_WAIT(); asm volatile("" ::: "memory");
    const int c = lane & 7;
#pragma unroll
    for (int j = 0; j < 8; ++j) { const int n = (lane >> 3) + 8 * j; const LAS unsigned* s = scr + (4 * c) * 66 + n;
        const v4u o = (v4u){s[0], s[66], s[132], s[198]};
        *(GAS v4u*)(w.WT + (size_t)wrow_map(w.mode, w.n0 + n, w.Npad) * w.K + w.k0 + 8 * c) = o; }
    LDS_WAIT(); asm volatile("" ::: "memory");
}

__device__ __forceinline__ void p0_pool_operand(Frame& F) {
    const float* x = F.inp(I_X); bf16* AP = (bf16*)(F.ws + WS_APOOL);
    LAS f32x4* tile = (LAS f32x4*)(F.lds + RING_OFF);
    for (int unit = F.vcu; unit < (T / 64) * 4; unit += F.G) {
        const int rb = unit >> 2, g = unit & 3, w = 2 << g, t0 = rb * 64, s0 = t0 & (SEQ - 1);
        const int halo = (w - 1) < s0 ? (w - 1) : s0;
        __syncthreads();
        for (int idx = F.tid; idx < (64 + halo) * 64; idx += NWAVES * 64) { const int row = idx >> 6, c4 = idx & 63;
            tile[row * 64 + c4] = *(const GAS f32x4*)(x + (size_t)(t0 - halo + row) * D + g * 256 + c4 * 4); }
        __syncthreads();
#pragma unroll 2
        for (int k = 0; k < 8; ++k) { const int o = F.tid + k * 512, r = o >> 6, c4 = o & 63, s = s0 + r;
            const int cnt = (s + 1) < w ? (s + 1) : w;
            f32x4 sum = (f32x4){0.f, 0.f, 0.f, 0.f};
            for (int j = 0; j < cnt; ++j) sum += tile[(halo + r - j) * 64 + c4];
            const f32x4 cur = tile[(halo + r) * 64 + c4]; const float fc = (float)cnt;
            const f32x4 v = (f32x4){sum.x / fc, sum.y / fc, sum.z / fc, sum.w / fc} - cur;
            v2u pk; pk.x = pk2(v.x, v.y); pk.y = pk2(v.z, v.w);
            *(GAS v2u*)(AP + (size_t)(t0 + r) * D + g * 256 + c4 * 4) = pk; }
    }
    __syncthreads();
}

__device__ __forceinline__ void p0_prologue(Frame& F) {
    const int gw = F.vcu * NWAVES + F.wave, NGW = F.G * NWAVES;
    { float* rc = (float*)(F.ws + WS_ROPE); float* rs = rc + SEQ * 32;
      for (int idx = F.vcu * 512 + F.tid; idx < SEQ * 32; idx += F.G * 512) { const int pos = idx >> 5, i = idx & 31;
          const float fr = powf(10000.0f, -(float)i / 32.0f);
          const double ang = (double)((float)pos * fr);
          const double k = __builtin_rint(ang * 0.15915494309189535); const double r = ang - k * 6.283185307179586476925287, r2 = r * r;
          double sn = 1.0, cs = 1.0;
#pragma unroll
          for (int q = 12; q >= 1; --q) { sn = 1.0 - r2 * (1.0 / (double)((2 * q) * (2 * q + 1))) * sn; cs = 1.0 - r2 * (1.0 / (double)((2 * q - 1) * (2 * q))) * cs; }
          rc[idx] = (float)cs; rs[idx] = (float)(r * sn); } }
    if (F.vcu < 256) { const int kv = F.vcu >> 7, cc = F.vcu & 127; const float* pe = F.inp(kv == 0 ? I_PEK : I_PEV); const float* w1 = F.inp(kv == 0 ? I_W1K : I_W1V);
        LAS float* red = (LAS float*)(F.lds + RING_OFF + 98304);
        float s = 0.f;
#pragma unroll
        for (int q = 0; q < 4; ++q) { const int r = F.tid + 512 * q; s += pe[r] * w1[(size_t)r * 128 + cc]; }
        s = wave_sum(s); if (F.lane == 0) red[F.wave] = s; __syncthreads();
        if (F.tid == 0) ((float*)(F.ws + WS_MISC))[kv * 128 + cc] = ((red[0] + red[1]) + (red[2] + red[3])) + ((red[4] + red[5]) + (red[6] + red[7]));
        __syncthreads(); }
    p0_pool_operand(F);
    LAS unsigned* scr = (LAS unsigned*)(F.lds + RING_OFF + F.wave * 16384);
    int it = gw;
    if (it < W_MOE0) {
        WItem cur = witem_decode(F, it); f32x4 la[16], lb[16]; witem_load(cur, F.lane, la);
        for (;;) {
            const int nx = it + NGW; const bool more = nx < W_MOE0; WItem nxt = cur;
            if (more) { nxt = witem_decode(F, nx); witem_load(nxt, F.lane, lb); }
            witem_store(cur, F.lane, la, scr);
            if (!more) break;
#pragma unroll
            for (int j = 0; j < 16; ++j) la[j] = lb[j];
            cur = nxt; it = nx;
        }
    }
}

__device__ __forceinline__ void ln_phase(Frame& F, const float* src, const float* gam, const float* bet, float* dstf, bf16* dstb) {
    const int gw = F.vcu * NWAVES + F.wave, NGW = F.G * NWAVES;
    f32x4 gv[4], bv[4];
#pragma unroll
    for (int j = 0; j < 4; ++j) { gv[j] = *((const GAS f32x4*)gam + F.lane + 64 * j); bv[j] = *((const GAS f32x4*)bet + F.lane + 64 * j); }
    for (int m = gw; m < T; m += NGW) {
        const GAS f32x4* xr = (const GAS f32x4*)(src + (size_t)m * D) + F.lane;
        f32x4 v[4]; float s = 0.f;
#pragma unroll
        for (int j = 0; j < 4; ++j) { v[j] = xr[64 * j]; s += (v[j].x + v[j].y) + (v[j].z + v[j].w); }
        const float mean = wave_sum(s) * (1.f / D); float s2 = 0.f;
#pragma unroll
        for (int j = 0; j < 4; ++j) { v[j] = v[j] - mean; s2 += (v[j].x * v[j].x + v[j].y * v[j].y) + (v[j].z * v[j].z + v[j].w * v[j].w); }
        const float rstd = 1.f / sqrtf(wave_sum(s2) * (1.f / D) + LN_EPS);
        GAS f32x4* of = (GAS f32x4*)(dstf + (size_t)m * D) + F.lane;
#pragma unroll
        for (int j = 0; j < 4; ++j) { v[j] = v[j] * rstd * gv[j] + bv[j]; of[64 * j] = v[j]; }
        if (dstb) { GAS v2u* ob = (GAS v2u*)(dstb + (size_t)m * D) + F.lane;
#pragma unroll
            for (int j = 0; j < 4; ++j) { v2u pk; pk.x = pk2(v[j].x, v[j].y); pk.y = pk2(v[j].z, v[j].w); ob[64 * j] = pk; } }
    }
}

__device__ __forceinline__ void ln_router_phase(Frame& F, float* R0, const float* gam, const float* bet, bf16* dstb) {
    LAS float* rt = (LAS float*)(F.lds + RING_OFF);
    LAS unsigned* cnt = (LAS unsigned*)(F.lds + RING_OFF + 32768);
    const float* router = F.inp(I_ROUTER);
    for (int idx = F.tid; idx < 8192; idx += 512) { const int c = idx >> 3, e = idx & 7; rt[e * 1024 + c] = router[idx]; }
    if (F.tid < 8) cnt[F.tid] = 0u;
    __syncthreads();
    f32x4 gv[4], bv[4];
#pragma unroll
    for (int j = 0; j < 4; ++j) { gv[j] = *((const GAS f32x4*)gam + F.lane + 64 * j); bv[j] = *((const GAS f32x4*)bet + F.lane + 64 * j); }
    int* sel = (int*)(F.ws + WS_SEL);
    for (int k = 0; k < 16; ++k) {
        const int m = F.vcu * 128 + F.wave * 16 + k;
        const GAS f32x4* xr = (const GAS f32x4*)(R0 + (size_t)m * D) + F.lane;
        f32x4 v[4]; float s = 0.f;
#pragma unroll
        for (int j = 0; j < 4; ++j) { v[j] = xr[64 * j]; s += (v[j].x + v[j].y) + (v[j].z + v[j].w); }
        const float mean = wave_sum(s) * (1.f / D); float s2 = 0.f;
#pragma unroll
        for (int j = 0; j < 4; ++j) { v[j] = v[j] - mean; s2 += (v[j].x * v[j].x + v[j].y * v[j].y) + (v[j].z * v[j].z + v[j].w * v[j].w); }
        const float rstd = 1.f / sqrtf(wave_sum(s2) * (1.f / D) + LN_EPS);
        GAS f32x4* of = (GAS f32x4*)(R0 + (size_t)m * D) + F.lane;
        GAS v2u* ob = (GAS v2u*)(dstb + (size_t)m * D) + F.lane;
#pragma unroll
        for (int j = 0; j < 4; ++j) { v[j] = v[j] * rstd * gv[j] + bv[j]; of[64 * j] = v[j]; v2u pk; pk.x = pk2(v[j].x, v[j].y); pk.y = pk2(v[j].z, v[j].w); ob[64 * j] = pk; }
        float lg[8];
#pragma unroll
        for (int e = 0; e < 8; ++e) { float a = 0.f;
#pragma unroll
            for (int j = 0; j < 4; ++j) { const f32x4 r4 = *((const LAS f32x4*)(rt + e * 1024) + F.lane + 64 * j); a += (v[j].x * r4.x + v[j].y * r4.y) + (v[j].z * r4.z + v[j].w * r4.w); }
            lg[e] = wave_sum(a); }
        int i0 = 0; float v0 = lg[0];
#pragma unroll
        for (int e = 1; e < 8; ++e) if (lg[e] > v0) { v0 = lg[e]; i0 = e; }
        int i1 = -1; float v1 = -3.0e38f;
#pragma unroll
        for (int e = 0; e < 8; ++e) if (e != i0 && lg[e] > v1) { v1 = lg[e]; i1 = e; }
        const float ex = __expf(v1 - v0), w0 = 1.0f / (1.0f + ex), w1 = ex * w0;
        if (F.lane == 0) { *(GAS v4u*)(sel + (size_t)m * 4) = (v4u){(unsigned)i0, (unsigned)i1, __builtin_bit_cast(unsigned, w0), __builtin_bit_cast(unsigned, w1)};
            __hip_atomic_fetch_add(cnt + i0, 1u, __ATOMIC_RELAXED, __HIP_MEMORY_SCOPE_WORKGROUP); __hip_atomic_fetch_add(cnt + i1, 1u, __ATOMIC_RELAXED, __HIP_MEMORY_SCOPE_WORKGROUP); }
    }
    __syncthreads();
    if (F.tid < 8) ((unsigned*)(F.ws + WS_MISC + 4096))[F.vcu * 8 + F.tid] = cnt[F.tid];
}

__device__ __forceinline__ void moe_tables(Frame& F) {
    LAS int* cw = (LAS int*)(F.lds + RING_OFF + 65536);
    LAS int* mt = (LAS int*)(F.lds + MOET_OFF);
    const int* cg = (const int*)(F.ws + WS_MISC + 4096);
    __syncthreads();
    for (int idx = F.tid; idx < 2048; idx += 512) cw[idx] = __hip_atomic_load(cg + idx, RLX_AGENT);
    __syncthreads();
    { const int e = F.wave; int a[4]; int s = 0;
#pragma unroll
      for (int k = 0; k < 4; ++k) { a[k] = cw[(4 * F.lane + k) * 8 + e]; s += a[k]; }
      int inc = s;
#pragma unroll
      for (int o = 1; o < 64; o <<= 1) { const int y = __shfl_up(inc, o); if (F.lane >= o) inc += y; }
      if (F.lane == 63) mt[e] = inc;
      if (F.lane == (F.vcu >> 2)) { const int q = F.vcu & 3; mt[16 + e] = inc - s + (q > 0 ? a[0] : 0) + (q > 1 ? a[1] : 0) + (q > 2 ? a[2] : 0); } }
    __syncthreads();
    if (F.tid == 0) { int row = 0, tile = 0;
        for (int e = 0; e < 8; ++e) { mt[8 + e] = row; const int nt = (mt[e] + 255) >> 8; for (int i = 0; i < nt; ++i) mt[32 + tile + i] = e; tile += nt; row += nt << 8; }
        mt[24] = tile; }
    __syncthreads();
}

__device__ __forceinline__ void moe_dispatch_phase(Frame& F) {
    moe_tables(F);
    LAS int* mt = (LAS int*)(F.lds + MOET_OFF);
    LAS int* wcnt = (LAS int*)(F.lds + RING_OFF);
    LAS int* plist = (LAS int*)(F.lds + RING_OFF + 1024);
    const int* sel = (const int*)(F.ws + WS_SEL);
    int* sdst = (int*)(F.ws + WS_SDST); float* sw = (float*)(F.ws + WS_SW);
    const bf16* XB = (const bf16*)(F.ws + WS_XB); bf16* XS = (bf16*)(F.ws + WS_XS);
    int e = -1, rank = 0, t = 0, kk = 0; float wgt = 0.f;
    if (F.tid < 256) { const int tl = F.tid >> 1; kk = F.tid & 1; t = F.vcu * 128 + tl; e = sel[(size_t)t * 4 + kk]; wgt = __builtin_bit_cast(float, sel[(size_t)t * 4 + 2 + kk]);
#pragma unroll
        for (int ee = 0; ee < 8; ++ee) { const unsigned long long mk = __ballot(e == ee); if (e == ee) rank = __popcll(mk & ((1ull << F.lane) - 1ull)); if (F.lane == 0) wcnt[F.wave * 8 + ee] = __popcll(mk); } }
    __syncthreads();
    if (F.tid < 256) { int pre = 0; for (int w = 0; w < F.wave; ++w) pre += wcnt[w * 8 + e];
        const int pos = mt[8 + e] + mt[16 + e] + pre + rank;
        sdst[pos] = t * 2 + kk; sw[pos] = wgt; plist[F.tid] = pos; plist[256 + F.tid] = t; }
    __syncthreads();
    for (int q = F.wave * 32; q < F.wave * 32 + 32; ++q) { const int pos = plist[q], tt = plist[256 + q];
        const GAS v4u* s = (const GAS v4u*)(XB + (size_t)tt * D) + F.lane; GAS v4u* d = (GAS v4u*)(XS + (size_t)pos * D) + F.lane;
        const v4u a = s[0], b = s[64]; d[0] = a; d[64] = b; }
    if (F.vcu < 8) { const int ee = F.vcu, lo = mt[8 + ee] + mt[ee], hi = mt[8 + ee] + (((mt[ee] + 255) >> 8) << 8);
        for (int r = lo + F.wave; r < hi; r += NWAVES) { GAS v4u* d = (GAS v4u*)(XS + (size_t)r * D) + F.lane; d[0] = (v4u){0u, 0u, 0u, 0u}; d[64] = (v4u){0u, 0u, 0u, 0u}; if (F.lane == 0) { sdst[r] = -1; sw[r] = 0.f; } } }
}

__device__ __forceinline__ void final_phase(Frame& F, const float* R0, const float* gam, const float* bet, float* out) {
    const int gw = F.vcu * NWAVES + F.wave, NGW = F.G * NWAVES;
    const bf16* Y = (const bf16*)(F.ws + WS_Y);
    f32x4 gv[4], bv[4];
#pragma unroll
    for (int j = 0; j < 4; ++j) { gv[j] = *((const GAS f32x4*)gam + F.lane + 64 * j); bv[j] = *((const GAS f32x4*)bet + F.lane + 64 * j); }
    for (int m = gw; m < T; m += NGW) {
        const GAS f32x4* xr = (const GAS f32x4*)(R0 + (size_t)m * D) + F.lane;
        const GAS v2u* y0 = (const GAS v2u*)(Y + (size_t)m * 2 * D) + F.lane; const GAS v2u* y1 = y0 + 256;
        f32x4 v[4]; float s = 0.f;
#pragma unroll
        for (int j = 0; j < 4; ++j) { const v2u a = y0[64 * j], b = y1[64 * j]; v[j] = xr[64 * j] * ALPHA;
            v[j].x += bf2f(a.x & 0xffffu) + bf2f(b.x & 0xffffu); v[j].y += bf2f(a.x >> 16) + bf2f(b.x >> 16); v[j].z += bf2f(a.y & 0xffffu) + bf2f(b.y & 0xffffu); v[j].w += bf2f(a.y >> 16) + bf2f(b.y >> 16);
            s += (v[j].x + v[j].y) + (v[j].z + v[j].w); }
        const float mean = wave_sum(s) * (1.f / D); float s2 = 0.f;
#pragma unroll
        for (int j = 0; j < 4; ++j) { v[j] = v[j] - mean; s2 += (v[j].x * v[j].x + v[j].y * v[j].y) + (v[j].z * v[j].z + v[j].w * v[j].w); }
        const float rstd = 1.f / sqrtf(wave_sum(s2) * (1.f / D) + LN_EPS);
        GAS f32x4* of = (GAS f32x4*)(out + (size_t)m * D) + F.lane;
#pragma unroll
        for (int j = 0; j < 4; ++j) of[64 * j] = v[j] * rstd * gv[j] + bv[j];
    }
}

namespace ep {
using pg8::f32x4; using pg8::Unit; using pg8::u32x4; using pg8::u32x2; using pg8::cvt_pk_bf16;
constexpr int HALF = 128;

struct DenseOrder { int nM, nN, G, c; size_t astep, bstep;
    __device__ __forceinline__ bool next(int i, Unit& u) const { const long L = (long)i * G + c; if (L >= (long)nM * nN) return false;
        pg8::order_tile((int)L, nM, nN, u.pm, u.pn); u.aoff = (size_t)u.pm * astep; u.boff = (size_t)u.pn * bstep; return true; } };
struct PoolOrder { int G, c;
    __device__ __forceinline__ bool next(int i, Unit& u) const { const long L = (long)i * G + c; if (L >= (T / 256) * 4) return false;
        pg8::order_tile((int)L, T / 256, 4, u.pm, u.pn); u.aoff = (size_t)u.pm * 256 * D * 2 + (size_t)u.pn * 512; u.boff = (size_t)u.pn * 256 * 256 * 2; return true; } };
struct CmpOrder { int G, c;
    __device__ __forceinline__ bool next(int i, Unit& u) const { const long L = (long)i * G + c; if (L >= 256) return false;
        const int kv = (int)L >> 7, bg = ((int)L >> 2) & 31, kq = (int)L & 3; u.pm = bg; u.pn = kv * 4 + kq;
        u.aoff = ((size_t)kv * KV6_STRIDE + (size_t)bg * SEQ * 64 + (size_t)kq * 512) * 2; u.boff = ((size_t)kv * 256 * 2048 + (size_t)kq * 512) * 2; return true; } };
template <int NN> struct MoeOrder { int nM, G, c, tile0; const LAS int* tile_e; size_t a_tile, b_exp, b_tile; bool a_local;
    __device__ __forceinline__ bool next(int i, Unit& u) const { const int L = i * G + c; if (L >= nM * NN) return false;
        const int pml = L / NN; u.pn = L % NN; u.pm = tile0 + pml; const int e = __builtin_amdgcn_readfirstlane(tile_e[u.pm]);
        u.aoff = (size_t)(a_local ? pml : u.pm) * a_tile; u.boff = (size_t)e * b_exp + (size_t)u.pn * b_tile; return true; } };

struct EpiPool { static constexpr bool PERM = false; const float* x; const float* scale; float* out;
    __device__ __forceinline__ void operator()(const f32x4 (&acc)[2][2][4][2], const Unit& u, int wr, int wc, int fr, int fq) const {
        const int col0 = u.pn * 256 + wc * 32 + 4 * fq;
#pragma unroll
        for (int bj = 0; bj < 2; ++bj)
#pragma unroll
            for (int n = 0; n < 2; ++n) { const f32x4 sc = *(const f32x4*)(scale + col0 + bj * HALF + n * 16);
#pragma unroll
                for (int ai = 0; ai < 2; ++ai) {
#pragma unroll
                    for (int m = 0; m < 4; ++m) { const size_t off = (size_t)(u.pm * 256 + ai * HALF + wr * 64 + m * 16 + fr) * D + col0 + bj * HALF + n * 16;
                        const f32x4 xv = *(const f32x4*)(x + off); *(f32x4*)(out + off) = xv * ALPHA + acc[ai][bj][m][n] * sc; }
                    asm volatile("" ::: "memory"); } }
    } };
struct EpiResid { static constexpr bool PERM = false; float* R;
    __device__ __forceinline__ void operator()(const f32x4 (&acc)[2][2][4][2], const Unit& u, int wr, int wc, int fr, int fq) const {
        const int col0 = u.pn * 256 + wc * 32 + 4 * fq;
#pragma unroll
        for (int ai = 0; ai < 2; ++ai)
#pragma unroll
            for (int m = 0; m < 4; ++m) { const size_t off = (size_t)(u.pm * 256 + ai * HALF + wr * 64 + m * 16 + fr) * D + col0;
#pragma unroll
                for (int bj = 0; bj < 2; ++bj)
#pragma unroll
                    for (int n = 0; n < 2; ++n) { float* p = R + off + bj * HALF + n * 16; const f32x4 xv = *(const f32x4*)p; *(f32x4*)p = xv * ALPHA + acc[ai][bj][m][n]; }
                if (m & 1) asm volatile("" ::: "memory"); }
    } };
struct EpiSwiGLU { static constexpr bool PERM = true; bf16* O; int ldc; int pm0;
    __device__ __forceinline__ void operator()(const f32x4 (&acc)[2][2][4][2], const Unit& u, int wr, int wc, int fr, int fq) const {
        const int col0 = u.pn * 128 + wc * 32 + 8 * fq;
#pragma unroll
        for (int ai = 0; ai < 2; ++ai)
#pragma unroll
            for (int m = 0; m < 4; ++m) { bf16* rowp = O + (size_t)((u.pm - pm0) * 256 + ai * HALF + wr * 64 + m * 16 + fr) * ldc + col0;
                const f32x4 g0 = acc[ai][0][m][0], g1 = acc[ai][0][m][1], u0 = acc[ai][1][m][0], u1 = acc[ai][1][m][1];
                u32x4 w; w.x = cvt_pk_bf16(silu_f(g0[0]) * u0[0], silu_f(g0[1]) * u0[1]); w.y = cvt_pk_bf16(silu_f(g0[2]) * u0[2], silu_f(g0[3]) * u0[3]);
                w.z = cvt_pk_bf16(silu_f(g1[0]) * u1[0], silu_f(g1[1]) * u1[1]); w.w = cvt_pk_bf16(silu_f(g1[2]) * u1[2], silu_f(g1[3]) * u1[3]);
                *(u32x4*)rowp = w; }
    } };
struct EpiMoeDown { static constexpr bool PERM = true; bf16* Y; const int* sdst; const float* sw;
    __device__ __forceinline__ void operator()(const f32x4 (&acc)[2][2][4][2], const Unit& u, int wr, int wc, int fr, int fq) const {
        const int col0 = u.pn * 256 + wc * 32 + 8 * fq;
#pragma unroll
        for (int ai = 0; ai < 2; ++ai)
#pragma unroll
            for (int m = 0; m < 4; ++m) { const int sr = u.pm * 256 + ai * HALF + wr * 64 + m * 16 + fr; const int d = sdst[sr]; const float w = sw[sr];
                if (d >= 0) { bf16* rowp = Y + (size_t)d * D + col0;
#pragma unroll
                    for (int bj = 0; bj < 2; ++bj) { const f32x4 v0 = acc[ai][bj][m][0] * w, v1 = acc[ai][bj][m][1] * w;
                        u32x4 o; o.x = cvt_pk_bf16(v0[0], v0[1]); o.y = cvt_pk_bf16(v0[2], v0[3]); o.z = cvt_pk_bf16(v1[0], v1[1]); o.w = cvt_pk_bf16(v1[2], v1[3]);
                        *(u32x4*)(rowp + bj * HALF) = o; } } }
    } };
struct EpiCPart { static constexpr bool PERM = false; float* part;
    __device__ __forceinline__ void operator()(const f32x4 (&acc)[2][2][4][2], const Unit& u, int wr, int wc, int fr, int fq) const {
        const int col0 = wc * 32 + 4 * fq;
#pragma unroll
        for (int ai = 0; ai < 2; ++ai)
#pragma unroll
            for (int m = 0; m < 4; ++m) { float* rowp = part + ((size_t)u.pn * 8192 + u.pm * 256 + ai * HALF + wr * 64 + m * 16 + fr) * 128 + col0;
#pragma unroll
                for (int n = 0; n < 2; ++n) *(f32x4*)(rowp + n * 16) = acc[ai][0][m][n]; }
    } };
struct EpiInProj { static constexpr bool PERM = false; bf16* Q; bf16* KV6; float* gates; const float* rc; const float* rs;
    __device__ __forceinline__ void operator()(const f32x4 (&acc)[2][2][4][2], const Unit& u, int wr, int wc, int fr, int fq) const {
        const int pn = u.pn, i0 = 16 * (wc & 1) + 4 * fq;
        const bool rope = (pn < 4) || pn == 6 || pn == 8;
#pragma unroll
        for (int ai = 0; ai < 2; ++ai)
#pragma unroll
            for (int m = 0; m < 4; ++m) { const int row = u.pm * 256 + ai * HALF + wr * 64 + m * 16 + fr, pos = row & (SEQ - 1), bb = row >> 12;
                f32x4 cs = (f32x4){1.f, 1.f, 1.f, 1.f}, sn = (f32x4){0.f, 0.f, 0.f, 0.f};
                if (rope) { cs = *(const f32x4*)(rc + pos * 32 + i0); sn = *(const f32x4*)(rs + pos * 32 + i0); }
#pragma unroll
                for (int bj = 0; bj < 2; ++bj) { const int head = 2 * bj + (wc >> 1); const f32x4 x1 = acc[ai][bj][m][0], x2 = acc[ai][bj][m][1];
                    if (pn == 10) { if (head == 0) { float* gp = gates + (size_t)row * 48 + i0;
                            f32x4 s1; for (int j = 0; j < 4; ++j) s1[j] = 1.0f / (1.0f + __expf(-x1[j])); *(f32x4*)gp = s1;
                            if (i0 < 16) { f32x4 s2; for (int j = 0; j < 4; ++j) s2[j] = 1.0f / (1.0f + __expf(-x2[j])); *(f32x4*)(gp + 32) = s2; } } }
                    else { f32x4 o1 = x1 * cs - x2 * sn, o2 = x1 * sn + x2 * cs; bf16* dst;
                        if (pn < 4) { o1 = o1 * QSCALE; o2 = o2 * QSCALE; dst = Q + (size_t)row * D + (4 * pn + head) * 64 + i0; }
                        else if (pn < 6) dst = KV6 + (size_t)(pn - 4) * KV6_STRIDE + ((size_t)(bb * 4 + head) * SEQ + pos) * 64 + i0;
                        else { const int r = pos & 63;
                            const int sw = (pn & 1) ? ((r >> 4) * 512 + (r & 15) * 32 + i0) : ((i0 >> 3) * 512 + r * 8 + (i0 & 7));
                            dst = KV6 + (size_t)(pn - 4) * KV6_STRIDE + ((size_t)(bb * 4 + head) * SEQ + (pos & ~63)) * 64 + sw; }
                        u32x2 a, b; a.x = cvt_pk_bf16(o1[0], o1[1]); a.y = cvt_pk_bf16(o1[2], o1[3]); b.x = cvt_pk_bf16(o2[0], o2[1]); b.y = cvt_pk_bf16(o2[2], o2[3]);
                        *(u32x2*)dst = a; *(u32x2*)(dst + (pn >= 6 && pn < 10 ? 2048 : 32)) = b; } } }
    } };
}

__device__ __forceinline__ void compress_finish_phase(Frame& F) {
    LAS float* w2s = (LAS float*)(F.lds + RING_OFF);
    for (int idx = F.tid; idx < 2 * 8192; idx += 512) w2s[idx] = F.inp(idx < 8192 ? I_W2K : I_W2V)[idx & 8191];
    __syncthreads();
    const float* part = (const float*)(F.ws + WS_CPART); const float* cb = (const float*)(F.ws + WS_MISC);
    const float* rc = (const float*)(F.ws + WS_ROPE); const float* rs = rc + SEQ * 32;
    bf16* kvc = (bf16*)(F.ws + WS_KVC);
    const int gw = F.vcu * NWAVES + F.wave, NGW = F.G * NWAVES;
    for (int row = gw; row < 2 * 32 * 256; row += NGW) {
        const int kv = row >> 13, r = row & 8191, n = r & 255;
        const int r6 = n & 63; bf16* dst = kvc + (size_t)(row & ~63) * 64 + (kv == 0 ? (F.lane >> 3) * 512 + r6 * 8 + (F.lane & 7) : ((F.lane >> 5) * 4 + (r6 >> 4)) * 512 + (r6 & 15) * 32 + (F.lane & 31));
        if (n == 255) { *dst = 0; continue; }
        float h0 = cb[kv * 128 + F.lane], h1 = cb[kv * 128 + 64 + F.lane];
#pragma unroll
        for (int q = 0; q < 4; ++q) { const float* p = part + ((size_t)(kv * 4 + q) * 8192 + r) * 128; h0 += p[F.lane]; h1 += p[64 + F.lane]; }
        h0 = silu_f(h0); h1 = silu_f(h1);
        const LAS float* w2 = w2s + kv * 8192 + F.lane; float o = 0.f;
#pragma unroll
        for (int c = 0; c < 64; ++c) o += __builtin_bit_cast(float, __builtin_amdgcn_readlane(__builtin_bit_cast(int, h0), c)) * w2[c * 64];
#pragma unroll
        for (int c = 0; c < 64; ++c) o += __builtin_bit_cast(float, __builtin_amdgcn_readlane(__builtin_bit_cast(int, h1), c)) * w2[(64 + c) * 64];
        if (kv == 0) { const int pos = 16 * n + 31, i = F.lane & 31; const float other = __shfl_xor(o, 32), cs = rc[pos * 32 + i], sn = rs[pos * 32 + i];
            o = (F.lane < 32) ? o * cs - other * sn : other * sn + o * cs; }
        *dst = (bf16)f2bf(o);
    }
    __syncthreads();
}

namespace att {
using f32x16 = __attribute__((ext_vector_type(16))) float;
using s16x4 = __attribute__((ext_vector_type(4))) short;
constexpr int SLOTB = 8192;
constexpr int NSLOT = 4, LDS_K = 0, LDS_V = NSLOT * SLOTB, LDS_WS = 2 * NSLOT * SLOTB, LDS_OST = LDS_WS + NWAVES * 256, OSTR = 64  , LDS_IMP = LDS_OST + NWAVES * 32 * OSTR * 4, LDS_SM = LDS_IMP + NWAVES * 2048, LDS_END = LDS_SM + NWAVES * 64;
static_assert(LDS_END <= RING_BYTES, "attention LDS");
__device__ __forceinline__ int crow(int r, int hi) { return (r & 3) + 8 * (r >> 2) + 4 * hi; }
__device__ __forceinline__ float max3f(float a, float b, float c) { float r; asm("v_max3_f32 %0, %1, %2, %3" : "=v"(r) : "v"(a), "v"(b), "v"(c)); return r; }
__device__ __forceinline__ unsigned cvtpk(float lo, float hi) { unsigned r; asm("v_cvt_pk_bf16_f32 %0, %1, %2" : "=v"(r) : "v"(lo), "v"(hi)); return r; }
typedef short v4i16_t __attribute__((ext_vector_type(4)));
#define ATT_WAIT_BAR(N) asm volatile("s_waitcnt vmcnt(" #N ") lgkmcnt(0)\n\ts_barrier" ::: "memory")
#define ATT_LGKM_BAR() asm volatile("s_waitcnt lgkmcnt(0)\n\ts_barrier" ::: "memory")

__device__ __forceinline__ void qkt(f32x16& p0, f32x16& p1, const LAS unsigned char* Kslot, const bf16x8* qr, int r32, int hi) {
    const LAS unsigned char* kb = Kslot + hi * 1024 + r32 * 16;
    p0 = f32x16{}; p1 = f32x16{};
#pragma unroll
    for (int d0 = 0; d0 < 4; ++d0) {
        const bf16x8 b0 = *(const LAS bf16x8*)(kb + d0 * 2048), b1 = *(const LAS bf16x8*)(kb + d0 * 2048 + 512);
        p0 = __builtin_amdgcn_mfma_f32_32x32x16_bf16(b0, qr[d0], p0, 0, 0, 0); p1 = __builtin_amdgcn_mfma_f32_32x32x16_bf16(b1, qr[d0], p1, 0, 0, 0); }
}
__device__ __forceinline__ float rowmax(const f32x16& p0, const f32x16& p1) {
    float a = max3f(p0[0], p0[1], p1[0]), b = max3f(p0[2], p0[3], p1[1]); a = max3f(a, p1[2], p1[3]);
#pragma unroll
    for (int r = 4; r < 16; r += 4) { a = max3f(a, p0[r], p0[r + 1]); b = max3f(b, p0[r + 2], p0[r + 3]); a = max3f(a, p1[r], p1[r + 1]); b = max3f(b, p1[r + 2], p1[r + 3]); }
    const float m = fmaxf(a, b);
    auto rr = __builtin_amdgcn_permlane32_swap(__float_as_uint(m), __float_as_uint(m), false, false);
    return fmaxf(__uint_as_float(rr[0]), __uint_as_float(rr[1]));
}
__device__ __forceinline__ float halfswap_add(float v) { auto rr = __builtin_amdgcn_permlane32_swap(__float_as_uint(v), __float_as_uint(v), false, false); return __uint_as_float(rr[0]) + __uint_as_float(rr[1]); }
__device__ __forceinline__ void pv(f32x16* o, int vb, bf16x8 pa0, bf16x8 pa1, bf16x8 pa2, bf16x8 pa3) {
#pragma unroll
    for (int d0 = 0; d0 < 2; ++d0) { s16x4 lo[4], hi[4];
#pragma unroll
        for (int ks = 0; ks < 4; ++ks) {
            asm volatile("ds_read_b64_tr_b16 %0,%1 offset:%c2" : "=&v"(lo[ks]) : "v"(vb), "i"(d0 * 4096 + ks * 1024) : "memory");
            asm volatile("ds_read_b64_tr_b16 %0,%1 offset:%c2" : "=&v"(hi[ks]) : "v"(vb), "i"(d0 * 4096 + ks * 1024 + 512) : "memory"); }
        asm volatile("s_waitcnt lgkmcnt(0)" ::: "memory"); __builtin_amdgcn_sched_barrier(0);
#define ATT_PK(k) (bf16x8){lo[k][0], lo[k][1], lo[k][2], lo[k][3], hi[k][0], hi[k][1], hi[k][2], hi[k][3]}
        o[d0] = __builtin_amdgcn_mfma_f32_32x32x16_bf16(pa0, ATT_PK(0), o[d0], 0, 0, 0);
        o[d0] = __builtin_amdgcn_mfma_f32_32x32x16_bf16(pa1, ATT_PK(1), o[d0], 0, 0, 0);
        o[d0] = __builtin_amdgcn_mfma_f32_32x32x16_bf16(pa2, ATT_PK(2), o[d0], 0, 0, 0);
        o[d0] = __builtin_amdgcn_mfma_f32_32x32x16_bf16(pa3, ATT_PK(3), o[d0], 0, 0, 0);
#undef ATT_PK
    }
}
__device__ __forceinline__ void mask_gt(f32x16& p0, f32x16& p1, int thr, int hi) {
    asm volatile("" : "+v"(thr));
#pragma unroll
    for (int r = 0; r < 16; ++r) { const int kv = crow(r, hi); if (kv > thr) p0[r] = -INFINITY; if (kv + 32 > thr) p1[r] = -INFINITY; } }
__device__ __forceinline__ void mask_le(f32x16& p0, f32x16& p1, int thr, int hi) {
    asm volatile("" : "+v"(thr));
#pragma unroll
    for (int r = 0; r < 16; ++r) { const int kv = crow(r, hi); if (kv <= thr) p0[r] = -INFINITY; if (kv + 32 <= thr) p1[r] = -INFINITY; } }
__device__ __forceinline__ void mask_all(f32x16& p0, f32x16& p1) {
#pragma unroll
    for (int r = 0; r < 16; ++r) { p0[r] = -INFINITY; p1[r] = -INFINITY; } }

struct Ctx { LAS unsigned char* shm; int wid, lane, r32, hi; LAS float* wsf; int vb0; unsigned koff, voff; };

__device__ __forceinline__ const char* uni_ptr(const void* p) { const unsigned long long v = (unsigned long long)p;
    return (const char*)(((unsigned long long)(unsigned)__builtin_amdgcn_readfirstlane((unsigned)(v >> 32)) << 32) | (unsigned)__builtin_amdgcn_readfirstlane((unsigned)v)); }
__device__ __forceinline__ void dma_k(const Ctx& c, const bf16* Kt, int slot) {
    __builtin_amdgcn_global_load_lds((const unsigned*)(uni_ptr(Kt) + c.koff), (LAS unsigned*)(c.shm + LDS_K + slot * SLOTB + c.wid * 1024), 16, 0, 0); }
__device__ __forceinline__ void dma_v(const Ctx& c, const bf16* Vt, int slot) {
    __builtin_amdgcn_global_load_lds((const unsigned*)(uni_ptr(Vt) + c.voff), (LAS unsigned*)(c.shm + LDS_V + slot * SLOTB + c.wid * 1024), 16, 0, 0); }

__device__ __forceinline__ void p_times_v(const Ctx& c, f32x16* o, const f32x16& p0, const f32x16& p1, int slot) {
    v4u pw0 = (v4u){cvtpk(p0[0], p0[1]), cvtpk(p0[2], p0[3]), cvtpk(p0[4], p0[5]), cvtpk(p0[6], p0[7])};
    v4u pw1 = (v4u){cvtpk(p0[8], p0[9]), cvtpk(p0[10], p0[11]), cvtpk(p0[12], p0[13]), cvtpk(p0[14], p0[15])};
    v4u pw2 = (v4u){cvtpk(p1[0], p1[1]), cvtpk(p1[2], p1[3]), cvtpk(p1[4], p1[5]), cvtpk(p1[6], p1[7])};
    v4u pw3 = (v4u){cvtpk(p1[8], p1[9]), cvtpk(p1[10], p1[11]), cvtpk(p1[12], p1[13]), cvtpk(p1[14], p1[15])};
    pv(o, c.vb0 + slot * SLOTB, __builtin_bit_cast(bf16x8, pw0), __builtin_bit_cast(bf16x8, pw1), __builtin_bit_cast(bf16x8, pw2), __builtin_bit_cast(bf16x8, pw3));
}
__device__ __forceinline__ void online_step(const Ctx& c, f32x16& p0, f32x16& p1, float& m, float& l, f32x16* o, int slot) {
    const float rm = rowmax(p0, p1);
    const float mn = fmaxf(fmaxf(m, rm), -1.0e30f);
    const float f = __builtin_amdgcn_exp2f(m - mn);
    float s = 0.f;
#pragma unroll
    for (int r = 0; r < 16; ++r) { p0[r] = __builtin_amdgcn_exp2f(p0[r] - mn); p1[r] = __builtin_amdgcn_exp2f(p1[r] - mn); s += p0[r] + p1[r]; }
    l = l * f + s; m = mn;
    if (__any(f != 1.0f)) { if (c.hi == 0) c.wsf[c.r32] = f; LDS_WAIT();
#pragma unroll
        for (int r = 0; r < 16; ++r) { const float fr = c.wsf[crow(r, c.hi)]; o[0][r] *= fr; o[1][r] *= fr; }
        LDS_WAIT(); }
    p_times_v(c, o, p0, p1, slot);
}
__device__ __forceinline__ void fold_out(const Ctx& c, LAS float* outacc, const f32x16* o, float fac) {
    if (c.hi == 0) c.wsf[32 + c.r32] = fac; LDS_WAIT();
    LAS float* pa = outacc + c.hi * (4 * OSTR + 32) + c.r32; LAS float* pb = outacc + c.hi * (4 * OSTR) + (1 - c.hi) * 32 + c.r32; const LAS float* fp = c.wsf + 32 + 4 * c.hi;
#pragma unroll
    for (int r = 0; r < 16; ++r) { const int ro = (r & 3) + 8 * (r >> 2); const float fr = fp[ro]; pa[ro * OSTR] += o[0][r] * fr; pb[ro * OSTR] += o[1][r] * fr; }
    LDS_WAIT();
}

typedef __attribute__((address_space(3))) const char* lds_cptr;
__device__ __forceinline__ void glds16(const void* gsrc, unsigned lds_dst) { unsigned keep;
    asm volatile("s_mov_b32 %0, m0\n\ts_mov_b32 m0, %2\n\ts_nop 0\n\tglobal_load_lds_dwordx4 %1, off\n\ts_mov_b32 m0, %0" : "=&s"(keep) : "v"(gsrc), "s"(lds_dst) : "memory"); }
__device__ __forceinline__ void kload8(bf16x8* kf, lds_cptr kp) {
    kf[0] = *(const LAS bf16x8*)(kp);        kf[1] = *(const LAS bf16x8*)(kp + 512);  kf[2] = *(const LAS bf16x8*)(kp + 2048); kf[3] = *(const LAS bf16x8*)(kp + 2560);
    kf[4] = *(const LAS bf16x8*)(kp + 4096); kf[5] = *(const LAS bf16x8*)(kp + 4608); kf[6] = *(const LAS bf16x8*)(kp + 6144); kf[7] = *(const LAS bf16x8*)(kp + 6656); }
__device__ __forceinline__ void kload2(bf16x8* kf, lds_cptr kp, int j) { kf[2 * j] = *(const LAS bf16x8*)(kp + j * 2048); kf[2 * j + 1] = *(const LAS bf16x8*)(kp + j * 2048 + 512); }
__device__ __forceinline__ s16x4 vtr(lds_cptr p) { return __builtin_bit_cast(s16x4, __builtin_amdgcn_ds_read_tr16_b64_v4i16((LAS v4i16_t*)p)); }
template <int THRL>
__device__ __forceinline__ void fast_seg(const Ctx& c, const bf16x8 (&qr)[4], int kind, int qb, int tok, unsigned long long mymask, const bf16* Kb, const bf16* Vb, int NTreal, float gate, LAS float* out) {
    const int NT = NTreal < 3 ? 4 : ((NTreal + 1) & ~1);
    const unsigned lds0 = (unsigned)(uintptr_t)c.shm;
    const unsigned kdst = lds0 + LDS_K + c.wid * 1024, vdst = lds0 + LDS_V + c.wid * 1024;
    const lds_cptr shm3 = (lds_cptr)c.shm; const lds_cptr kp0 = shm3 + LDS_K + c.hi * 1024 + c.r32 * 16;
    const lds_cptr vp0 = shm3 + LDS_V + ((c.lane >> 4) & 1) * 32 + (c.lane & 3) * 8 + (4 * c.hi + ((c.lane & 15) >> 2)) * 64;
    const int hi = c.hi, r32 = c.r32;
#define FS_BLK(t) ((t) < NTreal ? (kind == 0 ? (t) : qb - (t)) : (kind == 0 ? 0 : qb))
#define FS_DMA_K(t, slot) glds16(uni_ptr(Kb + (size_t)FS_BLK(t) * 4096) + c.koff, (unsigned)__builtin_amdgcn_readfirstlane(kdst + (slot)))
#define FS_DMA_V(t, slot) glds16(uni_ptr(Vb + (size_t)FS_BLK(t) * 4096) + c.koff, (unsigned)__builtin_amdgcn_readfirstlane(vdst + (slot)))
#define FS_WAIT_BAR(N) asm volatile("s_waitcnt vmcnt(" #N ") lgkmcnt(0)\n\ts_barrier" ::: "memory")
#define FS_SBAR() __builtin_amdgcn_sched_barrier(0)
#define FS_MASK(P0, P1, t) do { const int t_ = (t); \
        if (t_ >= NTreal) mask_all(P0, P1); \
        else if (kind == 0) { const bool sel_ = (mymask >> t_) & 1ull; if (__any(!sel_)) { if (!sel_) mask_all(P0, P1); } if (t_ == qb) mask_gt(P0, P1, tok, hi); } \
        else { if (t_ == 0) mask_gt(P0, P1, tok, hi); if (t_ == 8) mask_le(P0, P1, tok, hi); } } while (0)
    bf16x8 kfa, kfb, kfc, kfd;
    FS_DMA_K(0, 0); FS_DMA_V(0, 0); FS_DMA_K(1, SLOTB); FS_DMA_K(2, 2 * SLOTB);
    float mhat = 0.f, l_reg = 0.f; f32x16 o[2]; o[0] = f32x16{}; o[1] = f32x16{};
    bool resc = false;
    f32x16 pA0, pA1, pB0, pB1;
    int sl_prev = 0, sl_cur = 0, sl_next = SLOTB;
#define FS_ROT() do { sl_prev = sl_cur; sl_cur = sl_next; sl_next = (sl_next == 2 * SLOTB) ? 0 : sl_next + SLOTB; } while (0)
#define FS_RESC() do { if (resc) { asm volatile("s_waitcnt lgkmcnt(0)" ::: "memory"); \
        _Pragma("unroll") for (int d_ = 0; d_ < 2; ++d_) _Pragma("unroll") for (int r = 0; r < 16; ++r) o[d_][r] *= c.wsf[crow(r, hi)]; } } while (0)
    FS_WAIT_BAR(3);
    qkt(pA0, pA1, c.shm + LDS_K, qr, r32, hi);
    FS_MASK(pA0, pA1, 0);
    { float a = __builtin_fmaxf(__builtin_fmaxf(pA0[0], pA0[1]), pA1[0]);
#pragma unroll
      for (int r = 0; r < 16; ++r) a = __builtin_fmaxf(__builtin_fmaxf(a, pA0[r]), pA1[r]);
      { auto rr = __builtin_amdgcn_permlane32_swap(__float_as_uint(a), __float_as_uint(a), false, false); a = __builtin_fmaxf(__uint_as_float(rr[0]), __uint_as_float(rr[1])); }
      mhat = a;
#pragma unroll
      for (int r = 0; r < 16; ++r) { pA0[r] = __builtin_amdgcn_exp2f(pA0[r] - mhat); pA1[r] = __builtin_amdgcn_exp2f(pA1[r] - mhat); } }
    FS_WAIT_BAR(0);
    FS_DMA_K(3, 3 * SLOTB); FS_DMA_V(1, SLOTB);
    FS_ROT();
    kfa = *(const LAS bf16x8*)(kp0 + SLOTB); kfb = *(const LAS bf16x8*)(kp0 + SLOTB + 512);
    s16x4 vlo[8], vhi[8]; v4u pw0, pw1, pw2, pw3;
#define FS_PKW(P, B) cvtpk(P[B], P[(B) + 1])
#define FS_PAF(k) __builtin_bit_cast(bf16x8, pw##k)
#define FS_VFR(i) (bf16x8){vlo[i][0], vlo[i][1], vlo[i][2], vlo[i][3], vhi[i][0], vhi[i][1], vhi[i][2], vhi[i][3]}
#define FS_PIN(x) asm volatile("" : "+v"(x))
#define FS_MX3(a, b, c_) __builtin_fmaxf(__builtin_fmaxf((a), (b)), (c_))
#define FS_GAPA(MF, A0, A1, A2, A3, W0, W1, PW) do { MF; sacc += A0; sacc += A1; sacc += A2; sacc += A3; FS_PIN(sacc); W0; W1; FS_PIN(PW); FS_SBAR(); } while (0)
#define FS_EX(v) __builtin_amdgcn_exp2f((v) - mhat)
#define FS_GAPB(MF, X, B) do { MF; X[B] = FS_EX(X[B]); X[(B) + 1] = FS_EX(X[(B) + 1]); X[(B) + 2] = FS_EX(X[(B) + 2]); X[(B) + 3] = FS_EX(X[(B) + 3]); FS_PIN(X); FS_SBAR(); } while (0)
#define FS_VRD(i) do { vlo[i] = vtr(vp_ + (((i) >> 2) * 4096 + ((i) & 3) * 1024)); vhi[i] = vtr(vp_ + (((i) >> 2) * 4096 + ((i) & 3) * 1024 + 512)); } while (0)
#define FS_KL(off) (*(const LAS bf16x8*)(kq_ + (off)))
#define FS_Z f32x16{}
#define FS_STEP(C0, C1, P0, P1, t, GK, GV, GL) do { FS_SBAR(); \
    const lds_cptr vp_ = vp0 + sl_prev; const lds_cptr kq_ = kp0 + ((t) & 3) * SLOTB; \
    FS_VRD(0); kfc = FS_KL(2048); FS_SBAR(); float sacc = (P0[0] + P0[1]); \
    FS_GAPA(C0 = __builtin_amdgcn_mfma_f32_32x32x16_bf16(kfa, qr[0], FS_Z, 0, 0, 0), P0[2], P0[3], P0[4], P0[5],     pw0[0] = FS_PKW(P0, 0), pw0[1] = FS_PKW(P0, 2), pw0); \
    FS_VRD(4); kfd = FS_KL(2560); FS_SBAR(); FS_GAPA(C1 = __builtin_amdgcn_mfma_f32_32x32x16_bf16(kfb, qr[0], FS_Z, 0, 0, 0), P0[6], P0[7], P0[8], P0[9],     pw0[2] = FS_PKW(P0, 4), pw0[3] = FS_PKW(P0, 6), pw0); \
    FS_VRD(1); kfa = FS_KL(4096); FS_SBAR(); FS_GAPA(C0 = __builtin_amdgcn_mfma_f32_32x32x16_bf16(kfc, qr[1], C0, 0, 0, 0),   P0[10], P0[11], P0[12], P0[13], pw1[0] = FS_PKW(P0, 8), pw1[1] = FS_PKW(P0, 10), pw1); \
    FS_VRD(5); kfb = FS_KL(4608); FS_SBAR(); FS_GAPA(C1 = __builtin_amdgcn_mfma_f32_32x32x16_bf16(kfd, qr[1], C1, 0, 0, 0),   P0[14], P0[15], P1[0], P1[1],   pw1[2] = FS_PKW(P0, 12), pw1[3] = FS_PKW(P0, 14), pw1); \
    FS_VRD(2); kfc = FS_KL(6144); FS_SBAR(); FS_GAPA(C0 = __builtin_amdgcn_mfma_f32_32x32x16_bf16(kfa, qr[2], C0, 0, 0, 0),   P1[2], P1[3], P1[4], P1[5],     pw2[0] = FS_PKW(P1, 0), pw2[1] = FS_PKW(P1, 2), pw2); \
    FS_VRD(6); kfd = FS_KL(6656); FS_SBAR(); FS_GAPA(C1 = __builtin_amdgcn_mfma_f32_32x32x16_bf16(kfb, qr[2], C1, 0, 0, 0),   P1[6], P1[7], P1[8], P1[9],     pw2[2] = FS_PKW(P1, 4), pw2[3] = FS_PKW(P1, 6), pw2); \
    FS_VRD(3); FS_SBAR(); FS_GAPA(C0 = __builtin_amdgcn_mfma_f32_32x32x16_bf16(kfc, qr[3], C0, 0, 0, 0),   P1[10], P1[11], P1[12], P1[13], pw3[0] = FS_PKW(P1, 8), pw3[1] = FS_PKW(P1, 10), pw3); \
    FS_VRD(7); FS_SBAR(); FS_GAPA(C1 = __builtin_amdgcn_mfma_f32_32x32x16_bf16(kfd, qr[3], C1, 0, 0, 0),   P1[14], P1[15], 0.f, 0.f,       pw3[2] = FS_PKW(P1, 12), pw3[3] = FS_PKW(P1, 14), pw3); \
    l_reg += sacc; \
    if (GK) { FS_DMA_K((t) + 3, (((t) + 3) & 3) * SLOTB); } if (GV) { FS_DMA_V((t) + 1, sl_next); } \
    FS_MASK(C0, C1, t); \
    { float a = FS_MX3(C0[0], C0[1], C1[0]), b = FS_MX3(C0[2], C0[3], C1[1]); a = FS_MX3(a, C1[2], C1[3]); \
      _Pragma("unroll") for (int r = 4; r < 16; r += 4) { a = FS_MX3(a, C0[r], C0[r + 1]); b = FS_MX3(b, C0[r + 2], C0[r + 3]); a = FS_MX3(a, C1[r], C1[r + 1]); b = FS_MX3(b, C1[r + 2], C1[r + 3]); } \
      float rm = __builtin_fmaxf(a, b); { auto rr = __builtin_amdgcn_permlane32_swap(__float_as_uint(rm), __float_as_uint(rm), false, false); rm = __builtin_fmaxf(__uint_as_float(rr[0]), __uint_as_float(rr[1])); } \
      rm -= mhat; resc = false; \
      if (__builtin_expect(__any(rm > (float)THRL), 0)) { const float dl = __builtin_fmaxf(rm, 0.f); mhat += dl; \
        const float f = __builtin_amdgcn_exp2f(-dl); l_reg *= f; if (hi == 0) c.wsf[r32] = f; resc = true; } } \
    FS_SBAR(); \
    FS_GAPB(o[0] = __builtin_amdgcn_mfma_f32_32x32x16_bf16(FS_PAF(0), FS_VFR(0), o[0], 0, 0, 0), C0, 0); \
    FS_GAPB(o[1] = __builtin_amdgcn_mfma_f32_32x32x16_bf16(FS_PAF(0), FS_VFR(4), o[1], 0, 0, 0), C0, 4); \
    FS_GAPB(o[0] = __builtin_amdgcn_mfma_f32_32x32x16_bf16(FS_PAF(1), FS_VFR(1), o[0], 0, 0, 0), C0, 8); \
    FS_GAPB(o[1] = __builtin_amdgcn_mfma_f32_32x32x16_bf16(FS_PAF(1), FS_VFR(5), o[1], 0, 0, 0), C0, 12); \
    FS_GAPB(o[0] = __builtin_amdgcn_mfma_f32_32x32x16_bf16(FS_PAF(2), FS_VFR(2), o[0], 0, 0, 0), C1, 0); \
    FS_GAPB(o[1] = __builtin_amdgcn_mfma_f32_32x32x16_bf16(FS_PAF(2), FS_VFR(6), o[1], 0, 0, 0), C1, 4); \
    if (GL) { const lds_cptr kn_ = kp0 + (((t) + 1) & 3) * SLOTB; kfa = *(const LAS bf16x8*)(kn_); kfb = *(const LAS bf16x8*)(kn_ + 512); FS_SBAR(); } \
    FS_GAPB(o[0] = __builtin_amdgcn_mfma_f32_32x32x16_bf16(FS_PAF(3), FS_VFR(3), o[0], 0, 0, 0), C1, 8); \
    FS_GAPB(o[1] = __builtin_amdgcn_mfma_f32_32x32x16_bf16(FS_PAF(3), FS_VFR(7), o[1], 0, 0, 0), C1, 12); \
    } while (0)
    int t = 1;
    for (; t + 5 < NT; t += 2) {
        FS_STEP(pB0, pB1, pA0, pA1, t, true, true, true);     FS_WAIT_BAR(2); FS_RESC(); FS_ROT();
        FS_STEP(pA0, pA1, pB0, pB1, t + 1, true, true, true); FS_WAIT_BAR(2); FS_RESC(); FS_ROT();
    }
#define FS_ENDW(tt) do { if ((tt) + 3 < NT) { FS_WAIT_BAR(2); } else if ((tt) + 2 < NT) { FS_WAIT_BAR(1); } else { FS_WAIT_BAR(0); } } while (0)
    for (; t + 1 < NT; t += 2) {
        FS_STEP(pB0, pB1, pA0, pA1, t, (t + 3 < NT), (t + 1 < NT), (t + 1 < NT));         FS_ENDW(t);     FS_RESC(); FS_ROT();
        FS_STEP(pA0, pA1, pB0, pB1, t + 1, (t + 4 < NT), (t + 2 < NT), (t + 2 < NT));     FS_ENDW(t + 1); FS_RESC(); FS_ROT();
    }
    FS_STEP(pB0, pB1, pA0, pA1, NT - 1, false, false, false); FS_RESC();
    { float sacc = pB0[0] + pB0[1];
#pragma unroll
      for (int r = 2; r < 16; ++r) sacc += pB0[r];
#pragma unroll
      for (int r = 0; r < 16; ++r) sacc += pB1[r];
      l_reg += sacc;
      pw0 = (v4u){FS_PKW(pB0, 0), FS_PKW(pB0, 2), FS_PKW(pB0, 4), FS_PKW(pB0, 6)}; pw1 = (v4u){FS_PKW(pB0, 8), FS_PKW(pB0, 10), FS_PKW(pB0, 12), FS_PKW(pB0, 14)};
      pw2 = (v4u){FS_PKW(pB1, 0), FS_PKW(pB1, 2), FS_PKW(pB1, 4), FS_PKW(pB1, 6)}; pw3 = (v4u){FS_PKW(pB1, 8), FS_PKW(pB1, 10), FS_PKW(pB1, 12), FS_PKW(pB1, 14)};
      FS_SBAR(); pv(o, c.vb0 + sl_cur, FS_PAF(0), FS_PAF(1), FS_PAF(2), FS_PAF(3)); }
    const float lt = halfswap_add(l_reg);
    fold_out(c, out, o, lt > 0.f ? gate / lt : 0.f);
    asm volatile("s_waitcnt lgkmcnt(0)\n\ts_barrier" ::: "memory");
#undef FS_BLK
#undef FS_DMA_K
#undef FS_DMA_V
#undef FS_WAIT_BAR
#undef FS_SBAR
#undef FS_MASK
#undef FS_ROT
#undef FS_RESC
#undef FS_PKW
#undef FS_PAF
#undef FS_VFR
#undef FS_PIN
#undef FS_MX3
#undef FS_GAPA
#undef FS_EX
#undef FS_GAPB
#undef FS_VRD
#undef FS_KL
#undef FS_Z
#undef FS_STEP
#undef FS_ENDW
}

__device__ __forceinline__ void attn_unit(Frame& F, int b, int g, int qb) {
    Ctx c; c.shm = F.lds + RING_OFF; c.wid = F.wave; c.lane = F.lane; c.r32 = F.lane & 31; c.hi = F.lane >> 5;
    c.wsf = (LAS float*)(c.shm + LDS_WS) + c.wid * 64;
    c.vb0 = (int)(uintptr_t)(c.shm + LDS_V) + ((c.lane >> 4) & 1) * 32 + (c.lane & 3) * 8 + (4 * c.hi + ((c.lane & 15) >> 2)) * 64;
    c.koff = (unsigned)(c.wid * 1024 + c.lane * 16); c.voff = c.koff;
    const int tt = c.r32 & 7, hh = c.r32 >> 3, tok = 8 * c.wid + tt, t0 = 64 * qb, t = t0 + tok;
    const size_t grow = (size_t)b * SEQ + t;
    const bf16* Qp = (const bf16*)(F.ws + WS_Q) + grow * D + (4 * g + hh) * 64 + c.hi * 8;
    const bf16* KV6 = (const bf16*)(F.ws + WS_KV6) + (size_t)(b * 4 + g) * SEQ * 64;
    const bf16* KC = (const bf16*)(F.ws + WS_KVC) + (size_t)(b * 4 + g) * 256 * 64;
    VM_WAIT();
    bf16x8 qr[4];
#pragma unroll
    for (int d0 = 0; d0 < 4; ++d0) qr[d0] = *(const bf16x8*)(Qp + d0 * 16);
    const float* gp = (const float*)(F.ws + WS_GATES) + grow * 48 + (4 * g + hh) * 3;
    LAS float* out = (LAS float*)(c.shm + LDS_OST) + c.wid * 32 * OSTR;
#pragma unroll
    for (int k = 0; k < 32; ++k) out[k * OSTR + c.lane] = 0.f;
    LAS float* imp = (LAS float*)(c.shm + LDS_IMP) + c.wid * 512;
    LAS unsigned long long* smk = (LAS unsigned long long*)(c.shm + LDS_SM) + c.wid * 8;
    const bool need_sel = qb > 15;
    if (need_sel) {
#pragma unroll
        for (int k = 0; k < 8; ++k) imp[k * 64 + c.lane] = 0.f; }
    const int nmax = (t - 31) >> 4;
    const int nmax_min = (t0 - 31) >> 4;
    const int nct = ((4 * qb + 2) >> 6) + 1;
    const int e0 = nct, e1 = 2 * nct, e2 = e1, ntot = e1;
#define ATT_KPTR(ii_) ((ii_) < e1 ? KC + (size_t)((ii_) < e0 ? (ii_) : (ii_) - e0) * 4096 : (ii_) < e2 ? KV6 + 2 * KV6_STRIDE + (size_t)((ii_) - e1) * 4096 : KV6 + 4 * KV6_STRIDE + (size_t)(qb - ((ii_) - e2)) * 4096)
#define ATT_VPTR(ii_) (ATT_KPTR(ii_) + ((ii_) < e1 ? (size_t)32 * 256 * 64 : KV6_STRIDE))
    float m = -INFINITY, l = 0.f; f32x16 o[2]; o[0] = f32x16{}; o[1] = f32x16{};
    unsigned long long mymask = ~0ull;
    dma_k(c, ATT_KPTR(0), 0); dma_k(c, ATT_KPTR(1), 1); dma_v(c, ATT_VPTR(0), 0); dma_k(c, ATT_KPTR(2), 2); dma_v(c, ATT_VPTR(1), 1);
    ATT_WAIT_BAR(4);
    f32x16 p0, p1;
    qkt(p0, p1, c.shm + LDS_K, qr, c.r32, c.hi);
    for (int i = 0; i < ntot; ++i) {
        const int slot = i & 3;
        if (i + 2 < ntot) { ATT_WAIT_BAR(2); } else { ATT_WAIT_BAR(0); }
        if (i + 3 < ntot) dma_k(c, ATT_KPTR(i + 3), (i + 3) & 3);
        if (i + 2 < ntot) dma_v(c, ATT_VPTR(i + 2), (i + 2) & 3);
        const int mode = i < e0 ? 0 : i < e1 ? 1 : i < e2 ? 2 : 3;
        bool selrow = true;
        if (mode <= 1) { const int j = mode ? i - e0 : i; if (64 * j + 63 > nmax_min) mask_gt(p0, p1, nmax - 64 * j, c.hi); }
        else if (mode == 2) { const int j = i - e1; selrow = (mymask >> j) & 1ull; if (j == qb) mask_gt(p0, p1, tok, c.hi); }
        else { const int j = i - e2; if (j == 0) mask_gt(p0, p1, tok, c.hi); if (j == 8) mask_le(p0, p1, tok, c.hi); }
        float mn, f = 1.0f;
        if (mode == 1) mn = m;
        else { float rm = rowmax(p0, p1); if (!selrow) rm = -INFINITY; mn = fmaxf(fmaxf(m, rm), -1.0e30f); f = __builtin_amdgcn_exp2f(m - mn); m = mn; }
        const float sub = selrow ? mn : INFINITY;
        f32x16 n0 = f32x16{}, n1 = f32x16{}; float s = 0.f; v4u pw0, pw1, pw2, pw3;
        const bool do_imp = (mode == 1) && need_sel;
        LAS float* impr = imp + tt * 64 + 16 * (i - e0) + c.hi;
        { const LAS unsigned char* kb = c.shm + LDS_K + ((i + 1) & 3) * SLOTB + c.hi * 1024 + c.r32 * 16;
#define ATT_GRP(d0_, P_, B_, PW_) do { const bf16x8 b0_ = *(const LAS bf16x8*)(kb + (d0_) * 2048), b1_ = *(const LAS bf16x8*)(kb + (d0_) * 2048 + 512); \
            n0 = __builtin_amdgcn_mfma_f32_32x32x16_bf16(b0_, qr[d0_], n0, 0, 0, 0); n1 = __builtin_amdgcn_mfma_f32_32x32x16_bf16(b1_, qr[d0_], n1, 0, 0, 0); \
            float e_[8]; _Pragma("unroll") for (int r_ = 0; r_ < 8; ++r_) { e_[r_] = __builtin_amdgcn_exp2f(P_[(B_) + r_] - sub); s += e_[r_]; } \
            PW_ = (v4u){cvtpk(e_[0], e_[1]), cvtpk(e_[2], e_[3]), cvtpk(e_[4], e_[5]), cvtpk(e_[6], e_[7])}; \
            if (do_imp) { float qa = (e_[0] + e_[1]) + (e_[2] + e_[3]), qb_ = (e_[4] + e_[5]) + (e_[6] + e_[7]), la = e_[3], lb = e_[7]; \
                qa += __shfl_xor(qa, 8); qa += __shfl_xor(qa, 16); qb_ += __shfl_xor(qb_, 8); qb_ += __shfl_xor(qb_, 16); la += __shfl_xor(la, 8); la += __shfl_xor(la, 16); lb += __shfl_xor(lb, 8); lb += __shfl_xor(lb, 16); \
                if (hh == 0) { const int jo = 4 * ((d0_) & 1) + 8 * ((d0_) >> 1); impr[jo] += qa; impr[jo + 2] += qb_; LDS_WAIT(); \
                    if (16 * (i - e0) + c.hi + jo + 1 < 64) impr[jo + 1] += la; if (16 * (i - e0) + c.hi + jo + 3 < 64) impr[jo + 3] += lb; LDS_WAIT(); } } \
            __builtin_amdgcn_sched_barrier(0); } while (0)
          ATT_GRP(0, p0, 0, pw0); ATT_GRP(1, p0, 8, pw1); ATT_GRP(2, p1, 0, pw2); ATT_GRP(3, p1, 8, pw3);
#undef ATT_GRP
        }
        l = l * f + s;
        if (mode == 0) {
            if (i + 1 == e0) { const float lt = halfswap_add(l); m = lt > 0.f ? m + __builtin_amdgcn_logf(lt) : 0.f; l = 0.f; }
        } else {
            if (__any(f != 1.0f)) { if (c.hi == 0) c.wsf[c.r32] = f; LDS_WAIT();
#pragma unroll
                for (int r = 0; r < 16; ++r) { const float fr = c.wsf[crow(r, c.hi)]; o[0][r] *= fr; o[1][r] *= fr; }
                LDS_WAIT(); }
            pv(o, c.vb0 + slot * SLOTB, __builtin_bit_cast(bf16x8, pw0), __builtin_bit_cast(bf16x8, pw1), __builtin_bit_cast(bf16x8, pw2), __builtin_bit_cast(bf16x8, pw3));
            if (i + 1 == e1) {
                fold_out(c, out, o, gp[0]);
                if (need_sel) {
                    for (int k = 0; k < 8; ++k) {
                        const int jl = c.lane; const bool valid = jl <= qb; const bool forced = (jl == 0) || (jl == qb) || (jl == qb - 1);
                        const float sc = valid ? imp[k * 64 + jl] + (forced ? 1000.0f : 0.0f) : -1.0f;
                        int rank = 0;
#pragma unroll 4
                        for (int q = 0; q < 64; ++q) { const float sq = __builtin_bit_cast(float, __builtin_amdgcn_readlane(__builtin_bit_cast(int, sc), q)); rank += (sq > sc || (sq == sc && q < jl)) ? 1 : 0; }
                        const unsigned long long mk = __ballot(valid && rank < 16);
                        if (c.lane == 0) smk[k] = mk;
                    }
                    LDS_WAIT();
                    mymask = smk[tt];
                } else mymask = (2ull << qb) - 1ull;
                m = -INFINITY; l = 0.f; o[0] = f32x16{}; o[1] = f32x16{};
            }
        }
        p0 = n0; p1 = n1;
    }
#undef ATT_KPTR
#undef ATT_VPTR
    asm volatile("s_waitcnt lgkmcnt(0)\n\ts_barrier" ::: "memory");
    for (int kind = 0; kind < 2; ++kind) {
        const bf16* Kb = KV6 + (kind == 0 ? 2 : 4) * KV6_STRIDE; const bf16* Vb = Kb + KV6_STRIDE;
        fast_seg<8>(c, qr, kind, qb, tok, mymask, Kb, Vb, kind == 0 ? qb + 1 : (qb < 8 ? qb : 8) + 1, gp[1 + kind], out);
    }
    {
        LDS_WAIT();
        bf16* AO = (bf16*)(F.ws + WS_AO);
#pragma unroll
        for (int i = 0; i < 4; ++i) { const int row = i * 8 + (c.lane >> 3), ch = c.lane & 7; const LAS f32x4* sp = (const LAS f32x4*)(out + (c.lane >> 3) * OSTR + ((ch * 8) ^ (((c.lane >> 3) & 4) << 3)) + i * 8 * OSTR); const f32x4 a = sp[0], bq = sp[1];
            const v4u v = (v4u){cvtpk(a[0], a[1]), cvtpk(a[2], a[3]), cvtpk(bq[0], bq[1]), cvtpk(bq[2], bq[3])};
            *(v4u*)(AO + ((size_t)b * SEQ + t0 + 8 * c.wid + (row & 7)) * D + (4 * g + (row >> 3)) * 64 + ch * 8) = v; }
        LDS_WAIT();
    }
    asm volatile("s_waitcnt lgkmcnt(0)\n\ts_barrier" ::: "memory");
}
__device__ __forceinline__ void attn_phase(Frame& F) {
    const int bg = F.vcu >> 3, s = F.vcu & 7;
    const int gw = F.vcu * NWAVES + F.wave, NGW = F.G * NWAVES;
    LAS unsigned* scr = (LAS unsigned*)(F.lds + RING_OFF + F.wave * 8448);
    static_assert(NWAVES * 8448 <= LDS_OST, "MoE weight items use the K/V ring region between attention units");
    for (int i = 0; i < 8; ++i) { const int base = (i >> 1) * 16; const int qb = (i & 1) ? base + 15 - s : base + s;
        attn_unit(F, bg >> 2, bg & 3, qb);
        for (int q = i; q < 16; q += 8) { const int it = W_MOE0 + gw + NGW * q;
            if (it < W_NITEMS) { const WItem w = witem_decode(F, it); f32x4 la[16]; witem_load(w, F.lane, la); witem_store(w, F.lane, la, scr); } }
        asm volatile("s_waitcnt vmcnt(0) lgkmcnt(0)\n\ts_barrier" ::: "memory");
    }
}
#undef ATT_WAIT_BAR
#undef ATT_LGKM_BAR
}

#ifndef MK_PER_PHASE
#define MK_PER_PHASE 0
#endif
constexpr int N_PHASES = 24;
struct Args { const float* in[18]; float* out; unsigned char* ws; int ph_lo, ph_hi, li, pad; };

__global__ void __launch_bounds__(NWAVES * 64, 2) fwd_kernel(Args args) {
    extern __shared__ __attribute__((aligned(16))) unsigned char lds[];
    Frame F;
    F.lds = (LAS unsigned char*)lds;
    F.MISC = (volatile LAS unsigned*)(F.lds + MISC_OFF);
    refresh(F);
    F.G = gridDim.x; { const int bx = blockIdx.x; F.vcu = (F.G % 8 == 0) ? (bx % 8) * (F.G / 8) + bx / 8 : bx; }
    F.ws = args.ws; F.ctl = (gu32*)(args.ws + WS_CTL); F.out = args.out;
    for (int u = F.tid; u < (LDS_BYTES - LDSCTL_OFF) / 4; u += NWAVES * 64) ((LAS unsigned*)(F.lds + LDSCTL_OFF))[u] = 0u;
    __syncthreads();
    if (F.tid < 18) ((LAS unsigned long long*)(F.lds + PTR_OFF))[F.tid] = (unsigned long long)args.in[F.tid];
    __syncthreads();
    XcdBarrier bar = xcd_barrier_post((unsigned*)(F.ctl + CW_BAR) + args.li * XCD_BAR_WORDS, F.MISC + 8);
#define GRID_BAR() xcd_barrier(bar)
    const int lo = args.ph_lo, hi = args.ph_hi;
#ifndef PH_MASK
#define PH_MASK 0xFFFFFFu
#endif
#define IN(k) (((PH_MASK >> ((k) > 13 ? 13 + (((k) - 13) & 1) : (k))) & 1u) && lo <= (k) && (k) < hi)
#define BOTH(k) (IN(k) && IN((k) + 1))
#ifndef REP_MASK
#define REP_MASK 0u
#endif
#define REPS(k) (1 + (int)((REP_MASK >> ((k) > 13 ? 13 + (((k) - 13) & 1) : (k))) & 1u))
    unsigned char* ws = args.ws;
    float* R0 = (float*)(ws + WS_R0); bf16* XB = (bf16*)(ws + WS_XB);
    const int cblk = (int)blockIdx.x;

    if (IN(0)) for (int rep_ = 0; rep_ < REPS(0); ++rep_) { refresh(F); p0_prologue(F); if (BOTH(0)) GRID_BAR(); }
    if (IN(1)) for (int rep_ = 0; rep_ < REPS(1); ++rep_) { refresh(F);
        pg8::Gemm g{(const bf16*)(ws + WS_APOOL), (const bf16*)(ws + W_POOL), D, 256, 256}; ep::PoolOrder S{F.G, cblk};
        ep::EpiPool E{F.inp(I_X), F.inp(I_POOLS), R0};
        pg8::gemm_phase<ep::EpiPool, ep::PoolOrder, true, false>(F.lds + RING_OFF, g, S, E);
        if (BOTH(1)) GRID_BAR(); }
    if (IN(2)) for (int rep_ = 0; rep_ < REPS(2); ++rep_) { refresh(F); ln_phase(F, R0, F.inp(I_LNG) + 0 * D, F.inp(I_LNB) + 0 * D, R0, XB); if (BOTH(2)) GRID_BAR(); }
    if (IN(3)) for (int rep_ = 0; rep_ < REPS(3); ++rep_) { refresh(F);
        pg8::Gemm g{XB, (const bf16*)(ws + W_FGU), D, D, D}; ep::DenseOrder S{T / 256, 2 * DFF / 256, F.G, cblk, (size_t)256 * D * 2, (size_t)256 * D * 2};
        ep::EpiSwiGLU E{(bf16*)(ws + WS_H1), DFF, 0};
        pg8::gemm_phase(F.lds + RING_OFF, g, S, E);
        if (BOTH(3)) GRID_BAR(); }
    if (IN(4)) for (int rep_ = 0; rep_ < REPS(4); ++rep_) { refresh(F);
        pg8::Gemm g{(const bf16*)(ws + WS_H1), (const bf16*)(ws + W_FDN), DFF, DFF, DFF}; ep::DenseOrder S{T / 256, D / 256, F.G, cblk, (size_t)256 * DFF * 2, (size_t)256 * DFF * 2};
        ep::EpiResid E{R0};
        pg8::gemm_phase(F.lds + RING_OFF, g, S, E);
        if (BOTH(4)) GRID_BAR(); }
    if (IN(5)) for (int rep_ = 0; rep_ < REPS(5); ++rep_) { refresh(F); ln_phase(F, R0, F.inp(I_LNG) + 1 * D, F.inp(I_LNB) + 1 * D, R0, XB); if (BOTH(5)) GRID_BAR(); }
    if (IN(6)) for (int rep_ = 0; rep_ < REPS(6); ++rep_) { refresh(F);
        pg8::Gemm g{XB, (const bf16*)(ws + W_IN), D, D, D}; ep::DenseOrder S{T / 256, INP_PAD / 256, F.G, cblk, (size_t)256 * D * 2, (size_t)256 * D * 2};
        ep::EpiInProj E{(bf16*)(ws + WS_Q), (bf16*)(ws + WS_KV6), (float*)(ws + WS_GATES), (const float*)(ws + WS_ROPE), (const float*)(ws + WS_ROPE) + SEQ * 32};
        pg8::gemm_phase(F.lds + RING_OFF, g, S, E);
        if (BOTH(6)) GRID_BAR(); }
    if (IN(7)) for (int rep_ = 0; rep_ < REPS(7); ++rep_) { refresh(F);
        pg8::Gemm g{(const bf16*)(ws + WS_KV6), (const bf16*)(ws + W_C1), 1024, 2048, 512}; ep::CmpOrder S{F.G, cblk};
        ep::EpiCPart E{(float*)(ws + WS_CPART)};
        pg8::gemm_phase(F.lds + RING_OFF, g, S, E);
        if (BOTH(7)) GRID_BAR(); }
    if (IN(8)) for (int rep_ = 0; rep_ < REPS(8); ++rep_) { refresh(F); compress_finish_phase(F); if (BOTH(8)) GRID_BAR(); }
    if (IN(9)) for (int rep_ = 0; rep_ < REPS(9); ++rep_) { refresh(F); att::attn_phase(F); if (BOTH(9)) GRID_BAR(); }
    if (IN(10)) for (int rep_ = 0; rep_ < REPS(10); ++rep_) { refresh(F);
        pg8::Gemm g{(const bf16*)(ws + WS_AO), (const bf16*)(ws + W_OUT), D, D, D}; ep::DenseOrder S{T / 256, D / 256, F.G, cblk, (size_t)256 * D * 2, (size_t)256 * D * 2};
        ep::EpiResid E{R0};
        pg8::gemm_phase(F.lds + RING_OFF, g, S, E);
        if (BOTH(10)) GRID_BAR(); }
    if (IN(11)) for (int rep_ = 0; rep_ < REPS(11); ++rep_) { refresh(F); ln_router_phase(F, R0, F.inp(I_LNG) + 2 * D, F.inp(I_LNB) + 2 * D, XB); if (BOTH(11)) GRID_BAR(); }
    if (IN(12)) for (int rep_ = 0; rep_ < REPS(12); ++rep_) { refresh(F); moe_dispatch_phase(F); if (BOTH(12)) GRID_BAR(); }
    for (int ch = 0; ch < MOE_NCH; ++ch) {
        const int p1 = 13 + 2 * ch, p2 = p1 + 1;
        const LAS int* mt = (const LAS int*)(F.lds + MOET_OFF);
        if (IN(p1)) for (int rep_ = 0; rep_ < REPS(p1); ++rep_) { refresh(F);
            if (lo == p1) moe_tables(F);
            const int NT = mt[24], tile0 = MOE_CH * ch, nM = (NT - tile0) < MOE_CH ? (NT - tile0) : MOE_CH;
            if (nM > 0) {
                pg8::Gemm g{(const bf16*)(ws + WS_XS), (const bf16*)(ws + W_MGU), D, D, D};
                ep::MoeOrder<2 * DFE / 256> S{nM, F.G, cblk, tile0, mt + 32, (size_t)256 * D * 2, (size_t)2 * DFE * D * 2, (size_t)256 * D * 2, false};
                ep::EpiSwiGLU E{(bf16*)(ws + WS_H2), DFE, tile0};
                pg8::gemm_phase(F.lds + RING_OFF, g, S, E);
                if (BOTH(p1)) GRID_BAR(); } }
        if (IN(p2)) for (int rep_ = 0; rep_ < REPS(p2); ++rep_) { refresh(F);
            if (lo == p2) moe_tables(F);
            const int NT = mt[24], tile0 = MOE_CH * ch, nM = (NT - tile0) < MOE_CH ? (NT - tile0) : MOE_CH;
            if (nM > 0) {
                pg8::Gemm g{(const bf16*)(ws + WS_H2), (const bf16*)(ws + W_MDN), DFE, DFE, DFE};
                ep::MoeOrder<D / 256> S{nM, F.G, cblk, tile0, mt + 32, (size_t)256 * DFE * 2, (size_t)D * DFE * 2, (size_t)256 * DFE * 2, true};
                ep::EpiMoeDown E{(bf16*)(ws + WS_Y), (const int*)(ws + WS_SDST), (const float*)(ws + WS_SW)};
                pg8::gemm_phase(F.lds + RING_OFF, g, S, E);
                if (BOTH(p2)) GRID_BAR(); } }
    }
    if (IN(23)) for (int rep_ = 0; rep_ < REPS(23); ++rep_) { refresh(F); final_phase(F, R0, F.inp(I_LNG) + 3 * D, F.inp(I_LNB) + 3 * D, F.out); }
#undef IN
#undef BOTH
#undef GRID_BAR
}

extern "C" void kernel_launch(void* const* d_in, const int* in_sizes, int n_in, void* d_out, int out_size, void* d_ws, size_t ws_size, hipStream_t stream) {
    static int grid = 0;
    if (grid == 0) {
        if (n_in != 18 || in_sizes[0] != T * D || out_size != T * D || ws_size < WS_END) { fprintf(stderr, "kernel_launch: shape/workspace mismatch (n_in %d, ws %zu)\n", n_in, ws_size); grid = -1; return; }
        int dev = 0, cus = 0, per_cu = 0;
        if (hipGetDevice(&dev) != hipSuccess || hipDeviceGetAttribute(&cus, hipDeviceAttributeMultiprocessorCount, dev) != hipSuccess) { grid = -1; return; }
        if (hipFuncSetAttribute((const void*)fwd_kernel, hipFuncAttributeMaxDynamicSharedMemorySize, LDS_BYTES) != hipSuccess) { fprintf(stderr, "kernel_launch: hipFuncSetAttribute failed\n"); grid = -1; return; }
        if (hipOccupancyMaxActiveBlocksPerMultiprocessor(&per_cu, (const void*)fwd_kernel, NWAVES * 64, LDS_BYTES) != hipSuccess || per_cu < 1) { fprintf(stderr, "kernel_launch: occupancy query says %d blocks per CU\n", per_cu); }
        (void)hipGetLastError();
        if (cus != 256) { fprintf(stderr, "kernel_launch: built for 256 CUs, device has %d\n", cus); grid = -1; return; }
        grid = 256;
    }
    if (grid < 0) return;
    if (hipMemsetAsync((char*)d_ws + WS_CTL, 0, CTL_ZERO_BYTES, stream) != hipSuccess) return;
    Args a{};
    for (int i = 0; i < 18; ++i) a.in[i] = (const float*)d_in[i];
    a.out = (float*)d_out; a.ws = (unsigned char*)d_ws;
#if MK_PER_PHASE
    for (int p = 0; p < N_PHASES; ++p) { a.ph_lo = p; a.ph_hi = p + 1; a.li = p; hipLaunchKernelGGL(fwd_kernel, dim3(grid), dim3(NWAVES * 64), LDS_BYTES, stream, a); }
#else
    a.ph_lo = 0; a.ph_hi = N_PHASES; a.li = 0;
    hipLaunchKernelGGL(fwd_kernel, dim3(grid), dim3(NWAVES * 64), LDS_BYTES, stream, a);
#endif
}
```

```cpp
#include <hip/hip_runtime.h>
#include <cstdio>
#include <cstdint>

namespace pg8 {
#define PG8_LAS __attribute__((address_space(3)))
typedef unsigned short bf16_t;
typedef short bf16x8 __attribute__((ext_vector_type(8)));
typedef float f32x4 __attribute__((ext_vector_type(4)));
typedef float f32x2 __attribute__((ext_vector_type(2)));
typedef unsigned u32x4 __attribute__((ext_vector_type(4)));
typedef unsigned u32x2 __attribute__((ext_vector_type(2)));
constexpr int BM = 256, BK = 64, HALF = 128, HTB = HALF * BK * 2  , STAGE_BYTES = 8 * HTB, NXCD = 8, WGM = 8;

__host__ __device__ __forceinline__ int lds_byte(int r, int c) { const int st = (r >> 4) * 2 + (c >> 5), rr = r & 15, cc = c & 31, ob = rr * 64 + cc * 2; return st * 1024 + (ob ^ (((ob >> 9) & 1) << 5)); }
__host__ __device__ __forceinline__ void stage_rc(int b, int& R, int& C) { const int st = b / 1024, sb = b % 1024, swz = sb ^ (((sb >> 9) & 1) << 5); R = (st >> 1) * 16 + swz / 64; C = (st & 1) * 32 + (swz % 64) / 2; }
__host__ __device__ __forceinline__ int perm32(int rho) { const int n = rho >> 4, i = rho & 15; return 8 * (i >> 2) + 4 * n + (i & 3); }

struct Unit { int pm, pn; size_t aoff, boff; };
struct Gemm { const bf16_t* A; const bf16_t* Bt; int lda, K; };

__device__ __forceinline__ void order_tile(int L, int nM, int nN, int& pm, int& pn) {
    const int nwg = nM * nN; int wgid = L;
    { const int q = nwg / NXCD, r = nwg % NXCD, xcd = wgid % NXCD, off = wgid / NXCD; wgid = (xcd < r ? xcd * (q + 1) : r * (q + 1) + (xcd - r) * q) + off; }
    const int nig = WGM * nN, gid = wgid / nig, fm = gid * WGM, gsz = (nM - fm) < WGM ? (nM - fm) : WGM;
    pm = fm + ((wgid % nig) % gsz); pn = (wgid % nig) / gsz;
}

__device__ __forceinline__ unsigned cvt_pk_bf16(float lo, float hi) { unsigned r; asm volatile("v_cvt_pk_bf16_f32 %0, %1, %2" : "=v"(r) : "v"(lo), "v"(hi)); return r; }

template <class Epi, class Sched, bool ALIGN_EPI = true, bool SP2 = true>
__device__ __forceinline__ void gemm_phase(PG8_LAS unsigned char* lds, const Gemm g, const Sched& S, const Epi& E) {
    int tid = threadIdx.x; asm volatile("" : "+v"(tid));
    const int wid = __builtin_amdgcn_readfirstlane(tid >> 6), lane = tid & 63, wr = wid >> 2, wc = wid & 3, fr = lane & 15, fq = lane >> 4;
    const int K = g.K, nt = K / BK;
    unsigned voffA[2], voffB[2];
#pragma unroll
    for (int i = 0; i < 2; ++i) { int R, C; stage_rc(tid * 16 + i * 8192, R, C); const int Rb = Epi::PERM ? ((R & ~31) + perm32(R & 31)) : R;
        voffA[i] = (unsigned)(R * g.lda + C) * 2u; voffB[i] = (unsigned)(tid * 16 + i * 8192); (void)Rb; }
    const size_t kstep = (size_t)(BK * 2), kstepB = 32768;
    const size_t hstepA = (size_t)HALF * g.lda * 2, hstepB = 16384;
    const unsigned ldsw = (unsigned)wid * 1024u;
    const int aoff = lds_byte(wr * 64 + fr, fq * 8), boff = lds_byte(wc * 32 + fr, fq * 8);
#define PG8_SA(b, h) (((b) * 2 + (h)) * HTB)
#define PG8_SB(b, h) ((4 + (b) * 2 + (h)) * HTB)
#define PG8_STAGE(bufoff, gbase, voff) do { _Pragma("unroll") for (int _i = 0; _i < 2; ++_i) \
        __builtin_amdgcn_global_load_lds((const unsigned*)((const char*)(gbase) + (voff)[_i]), (PG8_LAS unsigned*)(lds + (bufoff) + ldsw + _i * 8192), 16, 0, 0); } while (0)
#define PG8_LDA(dst, b, h) do { _Pragma("unroll") for (int m = 0; m < 4; ++m) _Pragma("unroll") for (int k = 0; k < 2; ++k) dst[m][k] = *(const PG8_LAS bf16x8*)(lds + PG8_SA(b, h) + aoff + m * 2048 + k * 1024); } while (0)
#define PG8_LDB(dst, b, h) do { _Pragma("unroll") for (int n = 0; n < 2; ++n) _Pragma("unroll") for (int k = 0; k < 2; ++k) dst[n][k] = *(const PG8_LAS bf16x8*)(lds + PG8_SB(b, h) + boff + n * 2048 + k * 1024); } while (0)
#define PG8_MMA(ai, bj, At, Bt) do { __builtin_amdgcn_s_setprio(1); _Pragma("unroll") for (int m = 0; m < 4; ++m) _Pragma("unroll") for (int n = 0; n < 2; ++n) _Pragma("unroll") for (int k = 0; k < 2; ++k) \
        acc[ai][bj][m][n] = __builtin_amdgcn_mfma_f32_16x16x32_bf16(Bt[n][k], At[m][k], acc[ai][bj][m][n], 0, 0, 0); __builtin_amdgcn_s_setprio(0); } while (0)
#define PG8_WAIT_V(n) asm volatile("s_waitcnt vmcnt(" #n ")" ::: "memory")
#define PG8_WAIT_L(n) asm volatile("s_waitcnt lgkmcnt(" #n ")" ::: "memory")
#define PG8_BAR __builtin_amdgcn_s_barrier()
#define PG8_SCHED __builtin_amdgcn_sched_barrier(0)
    Unit cur, nxt; int ui = 0;
    if (!S.next(0, cur)) return;
    f32x4 acc[2][2][4][2];
#pragma unroll
    for (int a = 0; a < 2; ++a)
#pragma unroll
        for (int b = 0; b < 2; ++b)
#pragma unroll
            for (int m = 0; m < 4; ++m)
#pragma unroll
                for (int n = 0; n < 2; ++n) acc[a][b][m][n] = (f32x4){0.f, 0.f, 0.f, 0.f};
    bf16x8 At[4][2], B0[2][2], B1[2][2];
    const char* cA = (const char*)g.A + cur.aoff; const char* cB = (const char*)g.Bt + cur.boff;
    if constexpr (SP2) {
        PG8_STAGE(PG8_SB(0, 0), cB, voffB); PG8_STAGE(PG8_SB(0, 1), cB + hstepB, voffB); PG8_STAGE(PG8_SA(0, 0), cA, voffA); PG8_STAGE(PG8_SA(0, 1), cA + hstepA, voffA);
        if (wr == 1) PG8_BAR;
        PG8_WAIT_V(2); PG8_BAR;
        PG8_STAGE(PG8_SB(1, 0), cB + kstepB, voffB); PG8_STAGE(PG8_SA(1, 0), cA + kstep, voffA); PG8_STAGE(PG8_SB(1, 1), cB + hstepB + kstepB, voffB);
        PG8_WAIT_V(6); PG8_BAR;
    } else {
        PG8_STAGE(PG8_SB(0, 0), cB, voffB); PG8_STAGE(PG8_SA(0, 0), cA, voffA); PG8_STAGE(PG8_SB(0, 1), cB + hstepB, voffB); PG8_STAGE(PG8_SA(0, 1), cA + hstepA, voffA);
        if (wr == 1) PG8_BAR;
        PG8_WAIT_V(4); PG8_BAR;
        PG8_STAGE(PG8_SB(1, 0), cB + kstepB, voffB); PG8_STAGE(PG8_SA(1, 0), cA + kstep, voffA); PG8_STAGE(PG8_SB(1, 1), cB + hstepB + kstepB, voffB);
        PG8_WAIT_V(6); PG8_BAR;
    }
    for (;;) {
        const bool has_next = S.next(ui + 1, nxt);
        const char* nA = has_next ? (const char*)g.A + nxt.aoff : cA; const char* nB = has_next ? (const char*)g.Bt + nxt.boff : cB;
        for (int t = 0; t < nt; t += 2) {
            const bool last = (t == nt - 2);
            const char* a1 = cA + (size_t)(t + 1) * kstep;
            const char* a2 = last ? nA : cA + (size_t)(t + 2) * kstep; const char* b2 = last ? nB : cB + (size_t)(t + 2) * kstepB;
            const char* a3 = a2 + kstep; const char* b3 = b2 + kstepB;
            if constexpr (SP2) {
            PG8_LDB(B0, 0, 0); PG8_LDB(B1, 0, 1); PG8_SCHED; PG8_LDA(At, 0, 0); PG8_STAGE(PG8_SA(1, 1), a1 + hstepA, voffA);
            PG8_WAIT_V(8); PG8_WAIT_L(0); PG8_BAR; PG8_MMA(0, 0, At, B0); PG8_MMA(0, 1, At, B1); PG8_BAR; PG8_SCHED;
            PG8_LDA(At, 0, 1); PG8_STAGE(PG8_SB(0, 0), b2, voffB); PG8_STAGE(PG8_SB(0, 1), b2 + hstepB, voffB); PG8_STAGE(PG8_SA(0, 0), a2, voffA);
            PG8_WAIT_V(8); PG8_WAIT_L(0); PG8_BAR; PG8_MMA(1, 0, At, B0); PG8_MMA(1, 1, At, B1); PG8_BAR; PG8_SCHED;
            PG8_LDB(B0, 1, 0); PG8_LDB(B1, 1, 1); PG8_SCHED; PG8_LDA(At, 1, 0); PG8_STAGE(PG8_SA(0, 1), a2 + hstepA, voffA);
            PG8_WAIT_V(8); PG8_WAIT_L(0); PG8_BAR; PG8_MMA(0, 0, At, B0); PG8_MMA(0, 1, At, B1); PG8_BAR; PG8_SCHED;
            PG8_LDA(At, 1, 1); PG8_STAGE(PG8_SB(1, 0), b3, voffB); PG8_STAGE(PG8_SB(1, 1), b3 + hstepB, voffB); PG8_STAGE(PG8_SA(1, 0), a3, voffA);
            PG8_WAIT_V(8); PG8_WAIT_L(0); PG8_BAR; PG8_MMA(1, 0, At, B0); PG8_MMA(1, 1, At, B1); PG8_BAR; PG8_SCHED;
            } else {
            PG8_LDB(B0, 0, 0); PG8_SCHED; PG8_LDA(At, 0, 0); PG8_STAGE(PG8_SA(1, 1), a1 + hstepA, voffA);
            PG8_WAIT_L(8); PG8_BAR; PG8_WAIT_L(0); PG8_MMA(0, 0, At, B0); PG8_BAR; PG8_SCHED;
            PG8_LDB(B1, 0, 1); PG8_STAGE(PG8_SB(0, 0), b2, voffB);
            PG8_BAR; PG8_WAIT_L(0); PG8_MMA(0, 1, At, B1); PG8_BAR;
            PG8_LDA(At, 0, 1); PG8_STAGE(PG8_SA(0, 0), a2, voffA);
            PG8_BAR; PG8_WAIT_L(0); PG8_MMA(1, 0, At, B0); PG8_BAR; PG8_SCHED;
            PG8_STAGE(PG8_SB(0, 1), b2 + hstepB, voffB);
            PG8_WAIT_V(6); PG8_BAR; PG8_MMA(1, 1, At, B1); PG8_BAR;
            PG8_LDB(B0, 1, 0); PG8_SCHED; PG8_LDA(At, 1, 0); PG8_STAGE(PG8_SA(0, 1), a2 + hstepA, voffA);
            PG8_WAIT_L(8); PG8_BAR; PG8_WAIT_L(0); PG8_MMA(0, 0, At, B0); PG8_BAR; PG8_SCHED;
            PG8_LDB(B1, 1, 1); PG8_STAGE(PG8_SB(1, 0), b3, voffB);
            PG8_BAR; PG8_WAIT_L(0); PG8_MMA(0, 1, At, B1); PG8_BAR;
            PG8_LDA(At, 1, 1); PG8_STAGE(PG8_SA(1, 0), a3, voffA);
            PG8_BAR; PG8_WAIT_L(0); PG8_MMA(1, 0, At, B0); PG8_BAR; PG8_SCHED;
            PG8_STAGE(PG8_SB(1, 1), b3 + hstepB, voffB);
            PG8_WAIT_V(6); PG8_BAR; PG8_MMA(1, 1, At, B1); PG8_BAR;
            }
        }
        if constexpr (ALIGN_EPI) { if (wr == 0) PG8_BAR; }
        E(acc, cur, wr, wc, fr, fq);
        if (!has_next) break;
#pragma unroll
        for (int a = 0; a < 2; ++a)
#pragma unroll
            for (int b = 0; b < 2; ++b)
#pragma unroll
                for (int m = 0; m < 4; ++m)
#pragma unroll
                    for (int n = 0; n < 2; ++n) acc[a][b][m][n] = (f32x4){0.f, 0.f, 0.f, 0.f};
        cur = nxt; cA = nA; cB = nB; ++ui;
        if constexpr (ALIGN_EPI) { if (wr == 1) PG8_BAR; }
    }
    PG8_WAIT_V(0);
    if constexpr (!ALIGN_EPI) { if (wr == 0) PG8_BAR; }
    PG8_BAR;
#undef PG8_SA
#undef PG8_SB
#undef PG8_STAGE
#undef PG8_LDA
#undef PG8_LDB
#undef PG8_MMA
#undef PG8_WAIT_V
#undef PG8_WAIT_L
#undef PG8_BAR
#undef PG8_SCHED
}
}

constexpr int NWAVES = 8;
constexpr int BATCH = 8, SEQ = 4096, D = 1024, T = BATCH * SEQ;
constexpr int DFF = 2816, NE = 8, DFE = 3584, INP = 2608, INP_PAD = 2816;
constexpr int NH = 16, NG = 4, HD = 64;
constexpr float LN_EPS = 1e-5f;
constexpr float ALPHA = 1.4142135623730951f;
constexpr float QSCALE = 0.125f * 1.4426950408889634f;
constexpr int MOE_CH = 64;
constexpr int MOE_MAXT = 264;
constexpr int MOE_NCH = 5;

constexpr size_t MiB = 1u << 20;
constexpr size_t WS_CTL = 0, CTL_ZERO_BYTES = 1 * MiB;
constexpr size_t WS_ROPE = 1 * MiB;
constexpr size_t WS_MISC = 2 * MiB;
constexpr size_t WS_SEL = 3 * MiB;
constexpr size_t WS_SDST = 4 * MiB;
constexpr size_t WS_SW = 5 * MiB;
constexpr size_t WS_KVC = 6 * MiB;
constexpr size_t WS_CPART = 8 * MiB;
constexpr size_t WS_GATES = 40 * MiB;
constexpr size_t W_POOL = 48 * MiB, W_FGU = 49 * MiB, W_FDN = 60 * MiB, W_IN = 66 * MiB, W_C1 = 72 * MiB, W_OUT = 74 * MiB, W_MGU = 76 * MiB, W_MDN = 188 * MiB;
constexpr size_t WS_R0 = 256 * MiB;
constexpr size_t WS_XB = 384 * MiB;
constexpr size_t WS_BIG = 448 * MiB;
constexpr size_t WS_APOOL = WS_BIG, WS_H1 = 512 * MiB;
constexpr size_t WS_Q = WS_BIG, WS_KV6 = 512 * MiB, WS_AO = 616 * MiB;
constexpr size_t WS_XS = WS_BIG, WS_H2 = 580 * MiB, WS_Y = 692 * MiB;
constexpr size_t WS_END = 820 * MiB;
constexpr size_t KV6_STRIDE = (size_t)T * 256;
static_assert(W_MGU + (size_t)NE * 2 * DFE * D * 2 <= W_MDN && W_MDN + (size_t)NE * D * DFE * 2 <= WS_R0, "weights map");
static_assert(WS_H1 + (size_t)T * DFF * 2 <= WS_END && WS_XS + (size_t)MOE_MAXT * 256 * D * 2 <= WS_H2 && WS_H2 + (size_t)MOE_CH * 256 * DFE * 2 <= WS_Y && WS_Y + (size_t)T * 2 * D * 2 <= WS_END, "big map");
constexpr int CW_TMO = 0, CW_BAR = 4096;
constexpr int N_BAR_REGIONS = 28;

constexpr int RING_OFF = 0, RING_BYTES = 155648;
constexpr int LDSCTL_OFF = RING_BYTES, MISC_OFF = LDSCTL_OFF + 320;
constexpr int PTR_OFF = RING_BYTES + 512;
constexpr int MOET_OFF = RING_BYTES + 1024;
constexpr int LDS_BYTES = 163840;

#define GAS __attribute__((address_space(1)))
#define LAS __attribute__((address_space(3)))
typedef unsigned short bf16;
typedef unsigned v4u __attribute__((ext_vector_type(4)));
typedef unsigned v2u __attribute__((ext_vector_type(2)));
typedef float f32x4 __attribute__((ext_vector_type(4)));
typedef float f32x2 __attribute__((ext_vector_type(2)));
typedef short bf16x8 __attribute__((ext_vector_type(8)));
typedef GAS unsigned gu32;
#define RLX_AGENT __ATOMIC_RELAXED, __HIP_MEMORY_SCOPE_AGENT
#define LDS_WAIT() asm volatile("s_waitcnt lgkmcnt(0)" ::: "memory")
#define VM_WAIT() asm volatile("s_waitcnt vmcnt(0)" ::: "memory")
__device__ __forceinline__ unsigned f2bf(float f) { unsigned u = __builtin_bit_cast(unsigned, f); return (u + 0x7fffu + ((u >> 16) & 1u)) >> 16; }
__device__ __forceinline__ unsigned pk2(float lo, float hi) { return f2bf(lo) | (f2bf(hi) << 16); }
__device__ __forceinline__ float bf2f(unsigned h) { return __builtin_bit_cast(float, h << 16); }

#define XB_TMO      128
#define XB_XCNT(j)  (256  + 64 * (j))
#define XB_XSUB(j)  (1280 + 64 * (j))
#define XB_XGEN(j)  (2304 + 64 * (j))
#define XB_TOP      3328
#define XB_TOPGEN   3392
#define XCD_BAR_WORDS 3456
#define XB_SPIN_CAP (1u << 18)
__device__ __forceinline__ unsigned xb_ld(unsigned* p)              { return __hip_atomic_load(p, __ATOMIC_RELAXED, __HIP_MEMORY_SCOPE_AGENT); }
__device__ __forceinline__ unsigned xb_add(unsigned* p, unsigned v) { return __hip_atomic_fetch_add(p, v, __ATOMIC_RELAXED, __HIP_MEMORY_SCOPE_AGENT); }
__device__ __forceinline__ unsigned xb_xcc_id() { return (unsigned)__builtin_amdgcn_s_getreg((3 << 11) | 20) & 0xFu; }
#define XB_SPIN(cond, bar) do { unsigned _sp = 0; while (cond) { __builtin_amdgcn_s_sleep(1); \
    if ((++_sp & 255u) == 0u) { if (xb_ld(&(bar)[XB_TMO])) break; if (_sp > XB_SPIN_CAP) { atomicAdd(&(bar)[XB_TMO], 1u); break; } } } } while (0)
struct XcdBarrier { unsigned* bar; unsigned x; volatile LAS unsigned* st; };
__device__ __forceinline__ XcdBarrier xcd_barrier_post(unsigned* bar, volatile LAS unsigned* st) {
    XcdBarrier b; b.bar = bar; b.x = xb_xcc_id(); b.st = st;
    if (threadIdx.x == 0) (void)xb_add(&bar[XB_XCNT(b.x)], 1u);
    return b;
}
__device__ __forceinline__ void xcd_barrier_complete(unsigned* bar, unsigned x, unsigned& nloc, unsigned& nx) {
    const unsigned G = gridDim.x * gridDim.y * gridDim.z;
    unsigned sum, cnt, mine, sp = 0u;
    for (;;) {
        sum = 0u; cnt = 0u; mine = 0u;
#pragma unroll
        for (unsigned j = 0; j < 16; ++j) { const unsigned c = xb_ld(&bar[XB_XCNT(j)]); sum += c; cnt += (c > 0u) ? 1u : 0u; mine = (j == x) ? c : mine; }
        if (sum == G) break;
        __builtin_amdgcn_s_sleep(1);
        if ((++sp & 255u) == 0u) { if (xb_ld(&bar[XB_TMO])) break; if (sp > XB_SPIN_CAP) { atomicAdd(&bar[XB_TMO], 1u); break; } }
    }
    nloc = mine > 0u ? mine : 1u; nx = cnt > 0u ? cnt : 1u;
}
__device__ __forceinline__ void xcd_barrier(const XcdBarrier& b) {
    asm volatile("s_waitcnt vmcnt(0)" ::: "memory");
    __syncthreads();
    if (threadIdx.x == 0) {
        unsigned* bar = b.bar;
        __builtin_amdgcn_s_waitcnt(0);
        unsigned nloc = b.st[0], nx = b.st[1];
        if (nloc == 0u) { xcd_barrier_complete(bar, b.x, nloc, nx); b.st[0] = nloc; b.st[1] = nx; }
        const unsigned old = xb_add(&bar[XB_XSUB(b.x)], 1u);
        const unsigned gen = old / nloc;
        if (old + 1u == (gen + 1u) * nloc) {
            __builtin_amdgcn_fence(__ATOMIC_RELEASE, "agent");
            asm volatile("s_waitcnt vmcnt(0)" ::: "memory");
            const unsigned og = xb_add(&bar[XB_TOP], 1u);
            const unsigned tg = og / nx;
            if (og + 1u == (tg + 1u) * nx) xb_add(&bar[XB_TOPGEN], 1u);
            else XB_SPIN(xb_ld(&bar[XB_TOPGEN]) == tg, bar);
            __builtin_amdgcn_fence(__ATOMIC_ACQUIRE, "agent");
            xb_add(&bar[XB_XGEN(b.x)], 1u);
            asm volatile("s_waitcnt vmcnt(0)" ::: "memory");
        } else {
            XB_SPIN(xb_ld(&bar[XB_XGEN(b.x)]) == gen, bar);
            __builtin_amdgcn_fence(__ATOMIC_ACQUIRE, "agent");
            asm volatile("s_waitcnt vmcnt(0)" ::: "memory");
        }
    }
    __syncthreads();
}

struct Frame {
    LAS unsigned char* lds;
    volatile LAS unsigned* MISC;
    gu32* ctl;
    unsigned char* ws;
    int tid, lane, wave;
    int vcu, G;
    float* out;
    __device__ __forceinline__ const float* inp(int i) const {
        const unsigned long long v = ((const LAS unsigned long long*)(lds + PTR_OFF))[i];
        const unsigned lo = __builtin_amdgcn_readfirstlane((unsigned)v), hi = __builtin_amdgcn_readfirstlane((unsigned)(v >> 32));
        return (const float*)(((unsigned long long)hi << 32) | lo); }
};
enum { I_X = 0, I_LNG, I_LNB, I_POOLW, I_POOLS, I_WIN, I_PEK, I_W1K, I_W2K, I_PEV, I_W1V, I_W2V, I_WOUT, I_FGU, I_FDN, I_ROUTER, I_MGU, I_MDN };

__device__ __forceinline__ void refresh(Frame& F) { int t = threadIdx.x; asm volatile("" : "+v"(t)); F.tid = t; F.lane = t & 63; F.wave = __builtin_amdgcn_readfirstlane(t >> 6); }
__device__ __forceinline__ float wave_sum(float v) {
#pragma unroll
    for (int o = 1; o < 64; o <<= 1) v += __shfl_xor(v, o);
    return v;
}
__device__ __forceinline__ float silu_f(float x) { return x * __builtin_amdgcn_rcpf(1.0f + __builtin_amdgcn_exp2f(-1.4426950408889634f * x)); }

__device__ __forceinline__ int wrow_map(int mode, int n, int Npad) {
    if (mode == 0) return n;
    if (mode == 1) { const int half = Npad >> 1; return n < half ? ((n >> 7) << 8) + (n & 127) : (((n - half) >> 7) << 8) + 128 + ((n - half) & 127); }
    const int tile = n >> 8, o = n & 255, head = o >> 6, hf = (o >> 5) & 1, i = o & 31;
    return (tile << 8) + 128 * (head >> 1) + 32 * (2 * (head & 1) + (i >> 4)) + 16 * hf + (i & 15);
}
struct WItem { const float* W; bf16* WT; int K, Nreal, Npad, mode, perm, k0, n0; };
constexpr int W_NITEMS_POOL = 4 * 4 * 2, W_NI_FG = (D / 64) * (2 * DFF / 128), W_NI_FD = (DFF / 64) * (D / 128), W_NI_IN = (D / 64) * (INP_PAD / 128), W_NI_C1 = (2048 / 64) * (256 / 128), W_NI_WO = (D / 64) * (D / 128);
constexpr int W_NI_MG = (D / 64) * (2 * DFE / 128), W_NI_MD = (DFE / 64) * (D / 128);
constexpr int W_NITEMS = W_NITEMS_POOL + W_NI_FG + W_NI_FD + W_NI_IN + 2 * W_NI_C1 + W_NI_WO + NE * W_NI_MG + NE * W_NI_MD;
constexpr int W_MOE0 = W_NITEMS - NE * (W_NI_MG + W_NI_MD);
__device__ __forceinline__ WItem witem_decode(const Frame& F, int it) {
    WItem w; int r = it; int sub;
    unsigned char* ws = F.ws;
    if (r < W_NITEMS_POOL) { const int g = r / 8; sub = r % 8; w = WItem{F.inp(I_POOLW) + (size_t)g * 65536, (bf16*)(ws + W_POOL) + (size_t)g * 65536, 256, 256, 256, 0, 0, 0, 0}; }
    else if ((r -= W_NITEMS_POOL) < W_NI_FG) { sub = r; w = WItem{F.inp(I_FGU), (bf16*)(ws + W_FGU), D, 2 * DFF, 2 * DFF, 1, 1, 0, 0}; }
    else if ((r -= W_NI_FG) < W_NI_FD) { sub = r; w = WItem{F.inp(I_FDN), (bf16*)(ws + W_FDN), DFF, D, D, 0, 0, 0, 0}; }
    else if ((r -= W_NI_FD) < W_NI_IN) { sub = r; w = WItem{F.inp(I_WIN), (bf16*)(ws + W_IN), D, INP, INP_PAD, 2, 0, 0, 0}; }
    else if ((r -= W_NI_IN) < 2 * W_NI_C1) { const int kv = r / W_NI_C1; sub = r % W_NI_C1; w = WItem{F.inp(kv ? I_W1V : I_W1K), (bf16*)(ws + W_C1) + (size_t)kv * 256 * 2048, 2048, 128, 256, 0, 0, 0, 0}; }
    else if ((r -= 2 * W_NI_C1) < W_NI_WO) { sub = r; w = WItem{F.inp(I_WOUT), (bf16*)(ws + W_OUT), D, D, D, 0, 0, 0, 0}; }
    else if ((r -= W_NI_WO) < NE * W_NI_MG) { const int e = r / W_NI_MG; sub = r % W_NI_MG; w = WItem{F.inp(I_MGU) + (size_t)e * D * 2 * DFE, (bf16*)(ws + W_MGU) + (size_t)e * 2 * DFE * D, D, 2 * DFE, 2 * DFE, 1, 1, 0, 0}; }
    else { r -= NE * W_NI_MG; const int e = r / W_NI_MD; sub = r % W_NI_MD; w = WItem{F.inp(I_MDN) + (size_t)e * DFE * D, (bf16*)(ws + W_MDN) + (size_t)e * D * DFE, DFE, D, D, 0, 1, 0, 0}; }
    const int nblk = w.Npad / 128; w.k0 = 64 * (sub / nblk); w.n0 = 128 * (sub % nblk);
    return w;
}
constexpr int W_SCR = 32 * 130 * 4;
__device__ __forceinline__ void witem_load(const WItem& w, int lane, f32x4 (&ld)[32]) {
    const int nn = w.n0 + 4 * (lane & 31); const bool ok = nn < w.Nreal;
    const float* base = w.W + (size_t)(w.k0 + 2 * (lane >> 5)) * w.Nreal + nn;
#pragma unroll
    for (int j = 0; j < 32; ++j) { const int kk = 4 * (j >> 1) + (j & 1); ld[j] = ok ? *(const GAS f32x4*)(base + (size_t)kk * w.Nreal) : (f32x4){0.f, 0.f, 0.f, 0.f}; }
}
__device__ __forceinline__ void witem_store(const WItem& w, int lane, const f32x4 (&ld)[32], LAS unsigned* scr) {
#pragma unroll
    for (int m = 0; m < 16; ++m) { const f32x4 a = ld[2 * m], b = ld[2 * m + 1]; LAS unsigned* d = scr + (2 * m + (lane >> 5)) * 130 + 4 * (lane & 31);
        *(LAS v2u*)d = (v2u){pg8::cvt_pk_bf16(a[0], b[0]), pg8::cvt_pk_bf16(a[1], b[1])}; *(LAS v2u*)(d + 2) = (v2u){pg8::cvt_pk_bf16(a[2], b[2]), pg8::cvt_pk_bf16(a[3], b[3])}; }
    LDS_WAIT(); asm volatile("" ::: "memory");
    const int c = lane & 7; const size_t kblk = (size_t)(w.k0 >> 6) * 32768; const size_t panel = (size_t)w.K * 512;
#pragma unroll
    for (int j = 0; j < 16; ++j) { const int n = (lane >> 3) + 8 * j; const LAS unsigned* s = scr + (4 * c) * 130 + n;
        const v4u o = (v4u){s[0], s[130], s[260], s[390]};
        const int p = wrow_map(w.mode, w.n0 + n, w.Npad), r128 = p & 127, x = r128 & 31;
        const int R = w.perm ? ((r128 & ~31) + 16 * ((x >> 2) & 1) + 4 * (x >> 3) + (x & 3)) : r128;
        *(GAS v4u*)((unsigned char*)w.WT + (size_t)(p >> 8) * panel + kblk + ((p >> 7) & 1) * 16384 + pg8::lds_byte(R, 8 * c)) = o; }
    LDS_WAIT(); asm volatile("" ::: "memory");
}

__device__ __forceinline__ void p0_pool_operand(Frame& F) {
    const float* x = F.inp(I_X); bf16* AP = (bf16*)(F.ws + WS_APOOL);
    LAS f32x4* tile = (LAS f32x4*)(F.lds + RING_OFF);
    for (int unit = F.vcu; unit < (T / 64) * 4; unit += F.G) {
        const int rb = unit >> 2, g = unit & 3, w = 2 << g, t0 = rb * 64, s0 = t0 & (SEQ - 1);
        const int halo = (w - 1) < s0 ? (w - 1) : s0;
        __syncthreads();
        for (int idx = F.tid; idx < (64 + halo) * 64; idx += NWAVES * 64) { const int row = idx >> 6, c4 = idx & 63;
            tile[row * 64 + c4] = *(const GAS f32x4*)(x + (size_t)(t0 - halo + row) * D + g * 256 + c4 * 4); }
        __syncthreads();
#pragma unroll 2
        for (int k = 0; k < 8; ++k) { const int o = F.tid + k * 512, r = o >> 6, c4 = o & 63, s = s0 + r;
            const int cnt = (s + 1) < w ? (s + 1) : w;
            f32x4 sum = (f32x4){0.f, 0.f, 0.f, 0.f};
            for (int j = 0; j < cnt; ++j) sum += tile[(halo + r - j) * 64 + c4];
            const f32x4 cur = tile[(halo + r) * 64 + c4]; const float fc = (float)cnt;
            const f32x4 v = (f32x4){sum.x / fc, sum.y / fc, sum.z / fc, sum.w / fc} - cur;
            v2u pk; pk.x = pk2(v.x, v.y); pk.y = pk2(v.z, v.w);
            *(GAS v2u*)(AP + (size_t)(t0 + r) * D + g * 256 + c4 * 4) = pk; }
    }
    __syncthreads();
}

__device__ __forceinline__ void p0_prologue(Frame& F) {
    const int gw = F.vcu * NWAVES + F.wave, NGW = F.G * NWAVES;
    { float* rc = (float*)(F.ws + WS_ROPE); float* rs = rc + SEQ * 32;
      for (int idx = F.vcu * 512 + F.tid; idx < SEQ * 32; idx += F.G * 512) { const int pos = idx >> 5, i = idx & 31;
          const float fr = powf(10000.0f, -(float)i / 32.0f);
          const double ang = (double)((float)pos * fr);
          const double k = __builtin_rint(ang * 0.15915494309189535); const double r = ang - k * 6.283185307179586476925287, r2 = r * r;
          double sn = 1.0, cs = 1.0;
#pragma unroll
          for (int q = 12; q >= 1; --q) { sn = 1.0 - r2 * (1.0 / (double)((2 * q) * (2 * q + 1))) * sn; cs = 1.0 - r2 * (1.0 / (double)((2 * q - 1) * (2 * q))) * cs; }
          rc[idx] = (float)cs; rs[idx] = (float)(r * sn); } }
    if (F.vcu < 256) { const int kv = F.vcu >> 7, cc = F.vcu & 127; const float* pe = F.inp(kv == 0 ? I_PEK : I_PEV); const float* w1 = F.inp(kv == 0 ? I_W1K : I_W1V);
        LAS float* red = (LAS float*)(F.lds + RING_OFF + 98304);
        float s = 0.f;
#pragma unroll
        for (int q = 0; q < 4; ++q) { const int r = F.tid + 512 * q; s += pe[r] * w1[(size_t)r * 128 + cc]; }
        s = wave_sum(s); if (F.lane == 0) red[F.wave] = s; __syncthreads();
        if (F.tid == 0) ((float*)(F.ws + WS_MISC))[kv * 128 + cc] = ((red[0] + red[1]) + (red[2] + red[3])) + ((red[4] + red[5]) + (red[6] + red[7]));
        __syncthreads(); }
    p0_pool_operand(F);
    LAS unsigned* scr = (LAS unsigned*)(F.lds + RING_OFF + F.wave * W_SCR);
    for (int it = gw; it < W_MOE0; it += NGW) { const WItem w = witem_decode(F, it); f32x4 la[32]; witem_load(w, F.lane, la); witem_store(w, F.lane, la, scr); }
}

__device__ __forceinline__ void ln_phase(Frame& F, const float* src, const float* gam, const float* bet, float* dstf, bf16* dstb) {
    const int gw = F.vcu * NWAVES + F.wave, NGW = F.G * NWAVES;
    f32x4 gv[4], bv[4];
#pragma unroll
    for (int j = 0; j < 4; ++j) { gv[j] = *((const GAS f32x4*)gam + F.lane + 64 * j); bv[j] = *((const GAS f32x4*)bet + F.lane + 64 * j); }
    for (int m = gw; m < T; m += NGW) {
        const GAS f32x4* xr = (const GAS f32x4*)(src + (size_t)m * D) + F.lane;
        f32x4 v[4]; float s = 0.f;
#pragma unroll
        for (int j = 0; j < 4; ++j) { v[j] = xr[64 * j]; s += (v[j].x + v[j].y) + (v[j].z + v[j].w); }
        const float mean = wave_sum(s) * (1.f / D); float s2 = 0.f;
#pragma unroll
        for (int j = 0; j < 4; ++j) { v[j] = v[j] - mean; s2 += (v[j].x * v[j].x + v[j].y * v[j].y) + (v[j].z * v[j].z + v[j].w * v[j].w); }
        const float rstd = 1.f / sqrtf(wave_sum(s2) * (1.f / D) + LN_EPS);
        GAS f32x4* of = (GAS f32x4*)(dstf + (size_t)m * D) + F.lane;
#pragma unroll
        for (int j = 0; j < 4; ++j) { v[j] = v[j] * rstd * gv[j] + bv[j]; of[64 * j] = v[j]; }
        if (dstb) { GAS v2u* ob = (GAS v2u*)(dstb + (size_t)m * D) + F.lane;
#pragma unroll
            for (int j = 0; j < 4; ++j) { v2u pk; pk.x = pk2(v[j].x, v[j].y); pk.y = pk2(v[j].z, v[j].w); ob[64 * j] = pk; } }
    }
}

__device__ __forceinline__ void ln_router_phase(Frame& F, float* R0, const float* gam, const float* bet, bf16* dstb) {
    LAS float* rt = (LAS float*)(F.lds + RING_OFF);
    LAS unsigned* cnt = (LAS unsigned*)(F.lds + RING_OFF + 32768);
    const float* router = F.inp(I_ROUTER);
    for (int idx = F.tid; idx < 8192; idx += 512) { const int c = idx >> 3, e = idx & 7; rt[e * 1024 + c] = router[idx]; }
    if (F.tid < 8) cnt[F.tid] = 0u;
    __syncthreads();
    f32x4 gv[4], bv[4];
#pragma unroll
    for (int j = 0; j < 4; ++j) { gv[j] = *((const GAS f32x4*)gam + F.lane + 64 * j); bv[j] = *((const GAS f32x4*)bet + F.lane + 64 * j); }
    int* sel = (int*)(F.ws + WS_SEL);
    for (int k = 0; k < 16; ++k) {
        const int m = F.vcu * 128 + F.wave * 16 + k;
        const GAS f32x4* xr = (const GAS f32x4*)(R0 + (size_t)m * D) + F.lane;
        f32x4 v[4]; float s = 0.f;
#pragma unroll
        for (int j = 0; j < 4; ++j) { v[j] = xr[64 * j]; s += (v[j].x + v[j].y) + (v[j].z + v[j].w); }
        const float mean = wave_sum(s) * (1.f / D); float s2 = 0.f;
#pragma unroll
        for (int j = 0; j < 4; ++j) { v[j] = v[j] - mean; s2 += (v[j].x * v[j].x + v[j].y * v[j].y) + (v[j].z * v[j].z + v[j].w * v[j].w); }
        const float rstd = 1.f / sqrtf(wave_sum(s2) * (1.f / D) + LN_EPS);
        GAS f32x4* of = (GAS f32x4*)(R0 + (size_t)m * D) + F.lane;
        GAS v2u* ob = (GAS v2u*)(dstb + (size_t)m * D) + F.lane;
#pragma unroll
        for (int j = 0; j < 4; ++j) { v[j] = v[j] * rstd * gv[j] + bv[j]; of[64 * j] = v[j]; v2u pk; pk.x = pk2(v[j].x, v[j].y); pk.y = pk2(v[j].z, v[j].w); ob[64 * j] = pk; }
        float lg[8];
#pragma unroll
        for (int e = 0; e < 8; ++e) { float a = 0.f;
#pragma unroll
            for (int j = 0; j < 4; ++j) { const f32x4 r4 = *((const LAS f32x4*)(rt + e * 1024) + F.lane + 64 * j); a += (v[j].x * r4.x + v[j].y * r4.y) + (v[j].z * r4.z + v[j].w * r4.w); }
            lg[e] = wave_sum(a); }
        int i0 = 0; float v0 = lg[0];
#pragma unroll
        for (int e = 1; e < 8; ++e) if (lg[e] > v0) { v0 = lg[e]; i0 = e; }
        int i1 = -1; float v1 = -3.0e38f;
#pragma unroll
        for (int e = 0; e < 8; ++e) if (e != i0 && lg[e] > v1) { v1 = lg[e]; i1 = e; }
        const float ex = __expf(v1 - v0), w0 = 1.0f / (1.0f + ex), w1 = ex * w0;
        if (F.lane == 0) { *(GAS v4u*)(sel + (size_t)m * 4) = (v4u){(unsigned)i0, (unsigned)i1, __builtin_bit_cast(unsigned, w0), __builtin_bit_cast(unsigned, w1)};
            __hip_atomic_fetch_add(cnt + i0, 1u, __ATOMIC_RELAXED, __HIP_MEMORY_SCOPE_WORKGROUP); __hip_atomic_fetch_add(cnt + i1, 1u, __ATOMIC_RELAXED, __HIP_MEMORY_SCOPE_WORKGROUP); }
    }
    __syncthreads();
    if (F.tid < 8) ((unsigned*)(F.ws + WS_MISC + 4096))[F.vcu * 8 + F.tid] = cnt[F.tid];
}

__device__ __forceinline__ void moe_tables(Frame& F) {
    LAS int* cw = (LAS int*)(F.lds + RING_OFF + 65536);
    LAS int* mt = (LAS int*)(F.lds + MOET_OFF);
    const int* cg = (const int*)(F.ws + WS_MISC + 4096);
    __syncthreads();
    for (int idx = F.tid; idx < 2048; idx += 512) cw[idx] = __hip_atomic_load(cg + idx, RLX_AGENT);
    __syncthreads();
    { const int e = F.wave; int a[4]; int s = 0;
#pragma unroll
      for (int k = 0; k < 4; ++k) { a[k] = cw[(4 * F.lane + k) * 8 + e]; s += a[k]; }
      int inc = s;
#pragma unroll
      for (int o = 1; o < 64; o <<= 1) { const int y = __shfl_up(inc, o); if (F.lane >= o) inc += y; }
      if (F.lane == 63) mt[e] = inc;
      if (F.lane == (F.vcu >> 2)) { const int q = F.vcu & 3; mt[16 + e] = inc - s + (q > 0 ? a[0] : 0) + (q > 1 ? a[1] : 0) + (q > 2 ? a[2] : 0); } }
    __syncthreads();
    if (F.tid == 0) { int row = 0, tile = 0;
        for (int e = 0; e < 8; ++e) { mt[8 + e] = row; const int nt = (mt[e] + 255) >> 8; for (int i = 0; i < nt; ++i) mt[32 + tile + i] = e; tile += nt; row += nt << 8; }
        mt[24] = tile; }
    __syncthreads();
}

__device__ __forceinline__ void moe_dispatch_phase(Frame& F) {
    moe_tables(F);
    LAS int* mt = (LAS int*)(F.lds + MOET_OFF);
    LAS int* wcnt = (LAS int*)(F.lds + RING_OFF);
    LAS int* plist = (LAS int*)(F.lds + RING_OFF + 1024);
    const int* sel = (const int*)(F.ws + WS_SEL);
    int* sdst = (int*)(F.ws + WS_SDST); float* sw = (float*)(F.ws + WS_SW);
    const bf16* XB = (const bf16*)(F.ws + WS_XB); bf16* XS = (bf16*)(F.ws + WS_XS);
    int e = -1, rank = 0, t = 0, kk = 0; float wgt = 0.f;
    if (F.tid < 256) { const int tl = F.tid >> 1; kk = F.tid & 1; t = F.vcu * 128 + tl; e = sel[(size_t)t * 4 + kk]; wgt = __builtin_bit_cast(float, sel[(size_t)t * 4 + 2 + kk]);
#pragma unroll
        for (int ee = 0; ee < 8; ++ee) { const unsigned long long mk = __ballot(e == ee); if (e == ee) rank = __popcll(mk & ((1ull << F.lane) - 1ull)); if (F.lane == 0) wcnt[F.wave * 8 + ee] = __popcll(mk); } }
    __syncthreads();
    if (F.tid < 256) { int pre = 0; for (int w = 0; w < F.wave; ++w) pre += wcnt[w * 8 + e];
        const int pos = mt[8 + e] + mt[16 + e] + pre + rank;
        sdst[pos] = t * 2 + kk; sw[pos] = wgt; plist[F.tid] = pos; plist[256 + F.tid] = t; }
    __syncthreads();
    for (int q = F.wave * 32; q < F.wave * 32 + 32; ++q) { const int pos = plist[q], tt = plist[256 + q];
        const GAS v4u* s = (const GAS v4u*)(XB + (size_t)tt * D) + F.lane; GAS v4u* d = (GAS v4u*)(XS + (size_t)pos * D) + F.lane;
        const v4u a = s[0], b = s[64]; d[0] = a; d[64] = b; }
    if (F.vcu < 8) { const int ee = F.vcu, lo = mt[8 + ee] + mt[ee], hi = mt[8 + ee] + (((mt[ee] + 255) >> 8) << 8);
        for (int r = lo + F.wave; r < hi; r += NWAVES) { GAS v4u* d = (GAS v4u*)(XS + (size_t)r * D) + F.lane; d[0] = (v4u){0u, 0u, 0u, 0u}; d[64] = (v4u){0u, 0u, 0u, 0u}; if (F.lane == 0) { sdst[r] = -1; sw[r] = 0.f; } } }
}

__device__ __forceinline__ void final_phase(Frame& F, const float* R0, const float* gam, const float* bet, float* out) {
    const int gw = F.vcu * NWAVES + F.wave, NGW = F.G * NWAVES;
    const bf16* Y = (const bf16*)(F.ws + WS_Y);
    f32x4 gv[4], bv[4];
#pragma unroll
    for (int j = 0; j < 4; ++j) { gv[j] = *((const GAS f32x4*)gam + F.lane + 64 * j); bv[j] = *((const GAS f32x4*)bet + F.lane + 64 * j); }
    for (int m = gw; m < T; m += NGW) {
        const GAS f32x4* xr = (const GAS f32x4*)(R0 + (size_t)m * D) + F.lane;
        const GAS v2u* y0 = (const GAS v2u*)(Y + (size_t)m * 2 * D) + F.lane; const GAS v2u* y1 = y0 + 256;
        f32x4 v[4]; float s = 0.f;
#pragma unroll
        for (int j = 0; j < 4; ++j) { const v2u a = y0[64 * j], b = y1[64 * j]; v[j] = xr[64 * j] * ALPHA;
            v[j].x += bf2f(a.x & 0xffffu) + bf2f(b.x & 0xffffu); v[j].y += bf2f(a.x >> 16) + bf2f(b.x >> 16); v[j].z += bf2f(a.y & 0xffffu) + bf2f(b.y & 0xffffu); v[j].w += bf2f(a.y >> 16) + bf2f(b.y >> 16);
            s += (v[j].x + v[j].y) + (v[j].z + v[j].w); }
        const float mean = wave_sum(s) * (1.f / D); float s2 = 0.f;
#pragma unroll
        for (int j = 0; j < 4; ++j) { v[j] = v[j] - mean; s2 += (v[j].x * v[j].x + v[j].y * v[j].y) + (v[j].z * v[j].z + v[j].w * v[j].w); }
        const float rstd = 1.f / sqrtf(wave_sum(s2) * (1.f / D) + LN_EPS);
        GAS f32x4* of = (GAS f32x4*)(out + (size_t)m * D) + F.lane;
#pragma unroll
        for (int j = 0; j < 4; ++j) of[64 * j] = v[j] * rstd * gv[j] + bv[j];
    }
}

namespace ep {
using pg8::f32x4; using pg8::Unit; using pg8::u32x4; using pg8::u32x2; using pg8::cvt_pk_bf16;
constexpr int HALF = 128;

struct DenseOrder { int nM, nN, G, c; size_t astep, bstep;
    __device__ __forceinline__ bool next(int i, Unit& u) const { const long L = (long)i * G + c; if (L >= (long)nM * nN) return false;
        pg8::order_tile((int)L, nM, nN, u.pm, u.pn); u.aoff = (size_t)u.pm * astep; u.boff = (size_t)u.pn * bstep; return true; } };
struct PoolOrder { int G, c;
    __device__ __forceinline__ bool next(int i, Unit& u) const { const long L = (long)i * G + c; if (L >= (T / 256) * 4) return false;
        pg8::order_tile((int)L, T / 256, 4, u.pm, u.pn); u.aoff = (size_t)u.pm * 256 * D * 2 + (size_t)u.pn * 512; u.boff = (size_t)u.pn * 256 * 256 * 2; return true; } };
struct CmpOrder { int G, c;
    __device__ __forceinline__ bool next(int i, Unit& u) const { const long L = (long)i * G + c; if (L >= 256) return false;
        const int kv = (int)L >> 7, bg = ((int)L >> 2) & 31, kq = (int)L & 3; u.pm = bg; u.pn = kv * 4 + kq;
        u.aoff = ((size_t)kv * KV6_STRIDE + (size_t)bg * SEQ * 64 + (size_t)kq * 512) * 2; u.boff = (size_t)kv * 256 * 2048 * 2 + (size_t)kq * 8 * 32768; return true; } };
template <int NN> struct MoeOrder { int nM, G, c, tile0; const LAS int* tile_e; size_t a_tile, b_exp, b_tile; bool a_local;
    __device__ __forceinline__ bool next(int i, Unit& u) const { const int L = i * G + c; if (L >= nM * NN) return false;
        const int pml = L / NN; u.pn = L % NN; u.pm = tile0 + pml; const int e = __builtin_amdgcn_readfirstlane(tile_e[u.pm]);
        u.aoff = (size_t)(a_local ? pml : u.pm) * a_tile; u.boff = (size_t)e * b_exp + (size_t)u.pn * b_tile; return true; } };

struct EpiPool { static constexpr bool PERM = false; const float* x; const float* scale; float* out;
    __device__ __forceinline__ void operator()(const f32x4 (&acc)[2][2][4][2], const Unit& u, int wr, int wc, int fr, int fq) const {
        const int col0 = u.pn * 256 + wc * 32 + 4 * fq;
#pragma unroll
        for (int bj = 0; bj < 2; ++bj)
#pragma unroll
            for (int n = 0; n < 2; ++n) { const f32x4 sc = *(const f32x4*)(scale + col0 + bj * HALF + n * 16);
#pragma unroll
                for (int ai = 0; ai < 2; ++ai) {
#pragma unroll
                    for (int m = 0; m < 4; ++m) { const size_t off = (size_t)(u.pm * 256 + ai * HALF + wr * 64 + m * 16 + fr) * D + col0 + bj * HALF + n * 16;
                        const f32x4 xv = *(const f32x4*)(x + off); *(f32x4*)(out + off) = xv * ALPHA + acc[ai][bj][m][n] * sc; }
                    asm volatile("" ::: "memory"); } }
    } };
struct EpiResid { static constexpr bool PERM = false; float* R;
    __device__ __forceinline__ void operator()(const f32x4 (&acc)[2][2][4][2], const Unit& u, int wr, int wc, int fr, int fq) const {
        const int col0 = u.pn * 256 + wc * 32 + 4 * fq;
#pragma unroll
        for (int ai = 0; ai < 2; ++ai)
#pragma unroll
            for (int m = 0; m < 4; ++m) { const size_t off = (size_t)(u.pm * 256 + ai * HALF + wr * 64 + m * 16 + fr) * D + col0;
#pragma unroll
                for (int bj = 0; bj < 2; ++bj)
#pragma unroll
                    for (int n = 0; n < 2; ++n) { float* p = R + off + bj * HALF + n * 16; const f32x4 xv = *(const f32x4*)p; *(f32x4*)p = xv * ALPHA + acc[ai][bj][m][n]; }
                if (m & 1) asm volatile("" ::: "memory"); }
    } };
struct EpiSwiGLU { static constexpr bool PERM = true; bf16* O; int ldc; int pm0;
    __device__ __forceinline__ void operator()(const f32x4 (&acc)[2][2][4][2], const Unit& u, int wr, int wc, int fr, int fq) const {
        const int col0 = u.pn * 128 + wc * 32 + 8 * fq;
#pragma unroll
        for (int ai = 0; ai < 2; ++ai)
#pragma unroll
            for (int m = 0; m < 4; ++m) { bf16* rowp = O + (size_t)((u.pm - pm0) * 256 + ai * HALF + wr * 64 + m * 16 + fr) * ldc + col0;
                const f32x4 g0 = acc[ai][0][m][0], g1 = acc[ai][0][m][1], u0 = acc[ai][1][m][0], u1 = acc[ai][1][m][1];
                u32x4 w; w.x = cvt_pk_bf16(silu_f(g0[0]) * u0[0], silu_f(g0[1]) * u0[1]); w.y = cvt_pk_bf16(silu_f(g0[2]) * u0[2], silu_f(g0[3]) * u0[3]);
                w.z = cvt_pk_bf16(silu_f(g1[0]) * u1[0], silu_f(g1[1]) * u1[1]); w.w = cvt_pk_bf16(silu_f(g1[2]) * u1[2], silu_f(g1[3]) * u1[3]);
                *(u32x4*)rowp = w; }
    } };
struct EpiMoeDown { static constexpr bool PERM = true; bf16* Y; const int* sdst; const float* sw;
    __device__ __forceinline__ void operator()(const f32x4 (&acc)[2][2][4][2], const Unit& u, int wr, int wc, int fr, int fq) const {
        const int col0 = u.pn * 256 + wc * 32 + 8 * fq;
#pragma unroll
        for (int ai = 0; ai < 2; ++ai)
#pragma unroll
            for (int m = 0; m < 4; ++m) { const int sr = u.pm * 256 + ai * HALF + wr * 64 + m * 16 + fr; const int d = sdst[sr]; const float w = sw[sr];
                if (d >= 0) { bf16* rowp = Y + (size_t)d * D + col0;
#pragma unroll
                    for (int bj = 0; bj < 2; ++bj) { const f32x4 v0 = acc[ai][bj][m][0] * w, v1 = acc[ai][bj][m][1] * w;
                        u32x4 o; o.x = cvt_pk_bf16(v0[0], v0[1]); o.y = cvt_pk_bf16(v0[2], v0[3]); o.z = cvt_pk_bf16(v1[0], v1[1]); o.w = cvt_pk_bf16(v1[2], v1[3]);
                        *(u32x4*)(rowp + bj * HALF) = o; } } }
    } };
struct EpiCPart { static constexpr bool PERM = false; float* part;
    __device__ __forceinline__ void operator()(const f32x4 (&acc)[2][2][4][2], const Unit& u, int wr, int wc, int fr, int fq) const {
        const int col0 = wc * 32 + 4 * fq;
#pragma unroll
        for (int ai = 0; ai < 2; ++ai)
#pragma unroll
            for (int m = 0; m < 4; ++m) { float* rowp = part + ((size_t)u.pn * 8192 + u.pm * 256 + ai * HALF + wr * 64 + m * 16 + fr) * 128 + col0;
#pragma unroll
                for (int n = 0; n < 2; ++n) *(f32x4*)(rowp + n * 16) = acc[ai][0][m][n]; }
    } };
struct EpiInProj { static constexpr bool PERM = false; bf16* Q; bf16* KV6; float* gates; const float* rc; const float* rs;
    __device__ __forceinline__ void operator()(const f32x4 (&acc)[2][2][4][2], const Unit& u, int wr, int wc, int fr, int fq) const {
        const int pn = u.pn, i0 = 16 * (wc & 1) + 4 * fq;
        const bool rope = (pn < 4) || pn == 6 || pn == 8;
#pragma unroll
        for (int ai = 0; ai < 2; ++ai)
#pragma unroll
            for (int m = 0; m < 4; ++m) { const int row = u.pm * 256 + ai * HALF + wr * 64 + m * 16 + fr, pos = row & (SEQ - 1), bb = row >> 12;
                f32x4 cs = (f32x4){1.f, 1.f, 1.f, 1.f}, sn = (f32x4){0.f, 0.f, 0.f, 0.f};
                if (rope) { cs = *(const f32x4*)(rc + pos * 32 + i0); sn = *(const f32x4*)(rs + pos * 32 + i0); }
#pragma unroll
                for (int bj = 0; bj < 2; ++bj) { const int head = 2 * bj + (wc >> 1); const f32x4 x1 = acc[ai][bj][m][0], x2 = acc[ai][bj][m][1];
                    if (pn == 10) { if (head == 0) { float* gp = gates + (size_t)row * 48 + i0;
                            f32x4 s1; for (int j = 0; j < 4; ++j) s1[j] = 1.0f / (1.0f + __expf(-x1[j])); *(f32x4*)gp = s1;
                            if (i0 < 16) { f32x4 s2; for (int j = 0; j < 4; ++j) s2[j] = 1.0f / (1.0f + __expf(-x2[j])); *(f32x4*)(gp + 32) = s2; } } }
                    else { f32x4 o1 = x1 * cs - x2 * sn, o2 = x1 * sn + x2 * cs; bf16* dst;
                        if (pn < 4) { o1 = o1 * QSCALE; o2 = o2 * QSCALE; dst = Q + (size_t)row * D + (4 * pn + head) * 64 + i0; }
                        else if (pn < 6) dst = KV6 + (size_t)(pn - 4) * KV6_STRIDE + ((size_t)(bb * 4 + head) * SEQ + pos) * 64 + i0;
                        else { const int r = pos & 63;
                            const int sw = (pn & 1) ? ((r >> 4) * 512 + (r & 15) * 32 + i0) : ((i0 >> 3) * 512 + r * 8 + (i0 & 7));
                            dst = KV6 + (size_t)(pn - 4) * KV6_STRIDE + ((size_t)(bb * 4 + head) * SEQ + (pos & ~63)) * 64 + sw; }
                        u32x2 a, b; a.x = cvt_pk_bf16(o1[0], o1[1]); a.y = cvt_pk_bf16(o1[2], o1[3]); b.x = cvt_pk_bf16(o2[0], o2[1]); b.y = cvt_pk_bf16(o2[2], o2[3]);
                        *(u32x2*)dst = a; *(u32x2*)(dst + (pn >= 6 && pn < 10 ? 2048 : 32)) = b; } } }
    } };
}

__device__ __forceinline__ void compress_finish_phase(Frame& F) {
    LAS float* w2s = (LAS float*)(F.lds + RING_OFF);
    for (int idx = F.tid; idx < 2 * 8192; idx += 512) w2s[idx] = F.inp(idx < 8192 ? I_W2K : I_W2V)[idx & 8191];
    __syncthreads();
    const float* part = (const float*)(F.ws + WS_CPART); const float* cb = (const float*)(F.ws + WS_MISC);
    const float* rc = (const float*)(F.ws + WS_ROPE); const float* rs = rc + SEQ * 32;
    bf16* kvc = (bf16*)(F.ws + WS_KVC);
    const int gw = F.vcu * NWAVES + F.wave, NGW = F.G * NWAVES;
    for (int row = gw; row < 2 * 32 * 256; row += NGW) {
        const int kv = row >> 13, r = row & 8191, n = r & 255;
        const int r6 = n & 63; bf16* dst = kvc + (size_t)(row & ~63) * 64 + (kv == 0 ? (F.lane >> 3) * 512 + r6 * 8 + (F.lane & 7) : ((F.lane >> 5) * 4 + (r6 >> 4)) * 512 + (r6 & 15) * 32 + (F.lane & 31));
        if (n == 255) { *dst = 0; continue; }
        float h0 = cb[kv * 128 + F.lane], h1 = cb[kv * 128 + 64 + F.lane];
#pragma unroll
        for (int q = 0; q < 4; ++q) { const float* p = part + ((size_t)(kv * 4 + q) * 8192 + r) * 128; h0 += p[F.lane]; h1 += p[64 + F.lane]; }
        h0 = silu_f(h0); h1 = silu_f(h1);
        const LAS float* w2 = w2s + kv * 8192 + F.lane; float o = 0.f;
#pragma unroll
        for (int c = 0; c < 64; ++c) o += __builtin_bit_cast(float, __builtin_amdgcn_readlane(__builtin_bit_cast(int, h0), c)) * w2[c * 64];
#pragma unroll
        for (int c = 0; c < 64; ++c) o += __builtin_bit_cast(float, __builtin_amdgcn_readlane(__builtin_bit_cast(int, h1), c)) * w2[(64 + c) * 64];
        if (kv == 0) { const int pos = 16 * n + 31, i = F.lane & 31; const float other = __shfl_xor(o, 32), cs = rc[pos * 32 + i], sn = rs[pos * 32 + i];
            o = (F.lane < 32) ? o * cs - other * sn : other * sn + o * cs; }
        *dst = (bf16)f2bf(o);
    }
    __syncthreads();
}

namespace att {
using f32x16 = __attribute__((ext_vector_type(16))) float;
using s16x4 = __attribute__((ext_vector_type(4))) short;
constexpr int SLOTB = 8192;
constexpr int NSLOT = 4, LDS_K = 0, LDS_V = NSLOT * SLOTB, LDS_WS = 2 * NSLOT * SLOTB, LDS_OST = LDS_WS + NWAVES * 256, OSTR = 64  , LDS_IMP = LDS_OST + NWAVES * 32 * OSTR * 4, LDS_SM = LDS_IMP + NWAVES * 2048, LDS_END = LDS_SM + NWAVES * 64;
static_assert(LDS_END <= RING_BYTES, "attention LDS");
__device__ __forceinline__ int crow(int r, int hi) { return (r & 3) + 8 * (r >> 2) + 4 * hi; }
__device__ __forceinline__ float max3f(float a, float b, float c) { float r; asm("v_max3_f32 %0, %1, %2, %3" : "=v"(r) : "v"(a), "v"(b), "v"(c)); return r; }
__device__ __forceinline__ unsigned cvtpk(float lo, float hi) { unsigned r; asm("v_cvt_pk_bf16_f32 %0, %1, %2" : "=v"(r) : "v"(lo), "v"(hi)); return r; }
typedef short v4i16_t __attribute__((ext_vector_type(4)));
#define ATT_WAIT_BAR(N) asm volatile("s_waitcnt vmcnt(" #N ") lgkmcnt(0)\n\ts_barrier" ::: "memory")
#define ATT_LGKM_BAR() asm volatile("s_waitcnt lgkmcnt(0)\n\ts_barrier" ::: "memory")

__device__ __forceinline__ void qkt(f32x16& p0, f32x16& p1, const LAS unsigned char* Kslot, const bf16x8* qr, int r32, int hi) {
    const LAS unsigned char* kb = Kslot + hi * 1024 + r32 * 16;
    p0 = f32x16{}; p1 = f32x16{};
#pragma unroll
    for (int d0 = 0; d0 < 4; ++d0) {
        const bf16x8 b0 = *(const LAS bf16x8*)(kb + d0 * 2048), b1 = *(const LAS bf16x8*)(kb + d0 * 2048 + 512);
        p0 = __builtin_amdgcn_mfma_f32_32x32x16_bf16(b0, qr[d0], p0, 0, 0, 0); p1 = __builtin_amdgcn_mfma_f32_32x32x16_bf16(b1, qr[d0], p1, 0, 0, 0); }
}
__device__ __forceinline__ float rowmax(const f32x16& p0, const f32x16& p1) {
    float a = max3f(p0[0], p0[1], p1[0]), b = max3f(p0[2], p0[3], p1[1]); a = max3f(a, p1[2], p1[3]);
#pragma unroll
    for (int r = 4; r < 16; r += 4) { a = max3f(a, p0[r], p0[r + 1]); b = max3f(b, p0[r + 2], p0[r + 3]); a = max3f(a, p1[r], p1[r + 1]); b = max3f(b, p1[r + 2], p1[r + 3]); }
    const float m = fmaxf(a, b);
    auto rr = __builtin_amdgcn_permlane32_swap(__float_as_uint(m), __float_as_uint(m), false, false);
    return fmaxf(__uint_as_float(rr[0]), __uint_as_float(rr[1]));
}
__device__ __forceinline__ float halfswap_add(float v) { auto rr = __builtin_amdgcn_permlane32_swap(__float_as_uint(v), __float_as_uint(v), false, false); return __uint_as_float(rr[0]) + __uint_as_float(rr[1]); }
__device__ __forceinline__ void pv(f32x16* o, int vb, bf16x8 pa0, bf16x8 pa1, bf16x8 pa2, bf16x8 pa3) {
#pragma unroll
    for (int d0 = 0; d0 < 2; ++d0) { s16x4 lo[4], hi[4];
#pragma unroll
        for (int ks = 0; ks < 4; ++ks) {
            asm volatile("ds_read_b64_tr_b16 %0,%1 offset:%c2" : "=&v"(lo[ks]) : "v"(vb), "i"(d0 * 4096 + ks * 1024) : "memory");
            asm volatile("ds_read_b64_tr_b16 %0,%1 offset:%c2" : "=&v"(hi[ks]) : "v"(vb), "i"(d0 * 4096 + ks * 1024 + 512) : "memory"); }
        asm volatile("s_waitcnt lgkmcnt(0)" ::: "memory"); __builtin_amdgcn_sched_barrier(0);
#define ATT_PK(k) (bf16x8){lo[k][0], lo[k][1], lo[k][2], lo[k][3], hi[k][0], hi[k][1], hi[k][2], hi[k][3]}
        o[d0] = __builtin_amdgcn_mfma_f32_32x32x16_bf16(pa0, ATT_PK(0), o[d0], 0, 0, 0);
        o[d0] = __builtin_amdgcn_mfma_f32_32x32x16_bf16(pa1, ATT_PK(1), o[d0], 0, 0, 0);
        o[d0] = __builtin_amdgcn_mfma_f32_32x32x16_bf16(pa2, ATT_PK(2), o[d0], 0, 0, 0);
        o[d0] = __builtin_amdgcn_mfma_f32_32x32x16_bf16(pa3, ATT_PK(3), o[d0], 0, 0, 0);
#undef ATT_PK
    }
}
__device__ __forceinline__ void mask_gt(f32x16& p0, f32x16& p1, int thr, int hi) {
    asm volatile("" : "+v"(thr), "+v"(hi));
#pragma unroll
    for (int r = 0; r < 16; ++r) { const int kv = crow(r, hi); if (kv > thr) p0[r] = -INFINITY; if (kv + 32 > thr) p1[r] = -INFINITY; } }
__device__ __forceinline__ void mask_le(f32x16& p0, f32x16& p1, int thr, int hi) {
    asm volatile("" : "+v"(thr), "+v"(hi));
#pragma unroll
    for (int r = 0; r < 16; ++r) { const int kv = crow(r, hi); if (kv <= thr) p0[r] = -INFINITY; if (kv + 32 <= thr) p1[r] = -INFINITY; } }
__device__ __forceinline__ void mask_all(f32x16& p0, f32x16& p1) {
#pragma unroll
    for (int r = 0; r < 16; ++r) { p0[r] = -INFINITY; p1[r] = -INFINITY; } }

struct Ctx { LAS unsigned char* shm; int wid, lane, r32, hi; LAS float* wsf; int vb0; unsigned koff, voff; };

__device__ __forceinline__ const char* uni_ptr(const void* p) { const unsigned long long v = (unsigned long long)p;
    return (const char*)(((unsigned long long)(unsigned)__builtin_amdgcn_readfirstlane((unsigned)(v >> 32)) << 32) | (unsigned)__builtin_amdgcn_readfirstlane((unsigned)v)); }
__device__ __forceinline__ void dma_k(const Ctx& c, const bf16* Kt, int slot) {
    __builtin_amdgcn_global_load_lds((const unsigned*)(uni_ptr(Kt) + c.koff), (LAS unsigned*)(c.shm + LDS_K + slot * SLOTB + c.wid * 1024), 16, 0, 0); }
__device__ __forceinline__ void dma_v(const Ctx& c, const bf16* Vt, int slot) {
    __builtin_amdgcn_global_load_lds((const unsigned*)(uni_ptr(Vt) + c.voff), (LAS unsigned*)(c.shm + LDS_V + slot * SLOTB + c.wid * 1024), 16, 0, 0); }

__device__ __forceinline__ void p_times_v(const Ctx& c, f32x16* o, const f32x16& p0, const f32x16& p1, int slot) {
    v4u pw0 = (v4u){cvtpk(p0[0], p0[1]), cvtpk(p0[2], p0[3]), cvtpk(p0[4], p0[5]), cvtpk(p0[6], p0[7])};
    v4u pw1 = (v4u){cvtpk(p0[8], p0[9]), cvtpk(p0[10], p0[11]), cvtpk(p0[12], p0[13]), cvtpk(p0[14], p0[15])};
    v4u pw2 = (v4u){cvtpk(p1[0], p1[1]), cvtpk(p1[2], p1[3]), cvtpk(p1[4], p1[5]), cvtpk(p1[6], p1[7])};
    v4u pw3 = (v4u){cvtpk(p1[8], p1[9]), cvtpk(p1[10], p1[11]), cvtpk(p1[12], p1[13]), cvtpk(p1[14], p1[15])};
    pv(o, c.vb0 + slot * SLOTB, __builtin_bit_cast(bf16x8, pw0), __builtin_bit_cast(bf16x8, pw1), __builtin_bit_cast(bf16x8, pw2), __builtin_bit_cast(bf16x8, pw3));
}
__device__ __forceinline__ void online_step(const Ctx& c, f32x16& p0, f32x16& p1, float& m, float& l, f32x16* o, int slot) {
    const float rm = rowmax(p0, p1);
    const float mn = fmaxf(fmaxf(m, rm), -1.0e30f);
    const float f = __builtin_amdgcn_exp2f(m - mn);
    float s = 0.f;
#pragma unroll
    for (int r = 0; r < 16; ++r) { p0[r] = __builtin_amdgcn_exp2f(p0[r] - mn); p1[r] = __builtin_amdgcn_exp2f(p1[r] - mn); s += p0[r] + p1[r]; }
    l = l * f + s; m = mn;
    if (__any(f != 1.0f)) { if (c.hi == 0) c.wsf[c.r32] = f; LDS_WAIT();
#pragma unroll
        for (int r = 0; r < 16; ++r) { const float fr = c.wsf[crow(r, c.hi)]; o[0][r] *= fr; o[1][r] *= fr; }
        LDS_WAIT(); }
    p_times_v(c, o, p0, p1, slot);
}
__device__ __forceinline__ void fold_out(const Ctx& c, LAS float* outacc, const f32x16* o, float fac) {
    if (c.hi == 0) c.wsf[32 + c.r32] = fac; LDS_WAIT();
    LAS float* pa = outacc + c.hi * (4 * OSTR + 32) + c.r32; LAS float* pb = outacc + c.hi * (4 * OSTR) + (1 - c.hi) * 32 + c.r32; const LAS float* fp = c.wsf + 32 + 4 * c.hi;
#pragma unroll
    for (int r = 0; r < 16; ++r) { const int ro = (r & 3) + 8 * (r >> 2); const float fr = fp[ro]; pa[ro * OSTR] += o[0][r] * fr; pb[ro * OSTR] += o[1][r] * fr; }
    LDS_WAIT();
}

typedef __attribute__((address_space(3))) const char* lds_cptr;
__device__ __forceinline__ void glds16(const void* gsrc, unsigned lds_dst) { unsigned keep;
    asm volatile("s_mov_b32 %0, m0\n\ts_mov_b32 m0, %2\n\ts_nop 0\n\tglobal_load_lds_dwordx4 %1, off\n\ts_mov_b32 m0, %0" : "=&s"(keep) : "v"(gsrc), "s"(lds_dst) : "memory"); }
__device__ __forceinline__ void kload8(bf16x8* kf, lds_cptr kp) {
    kf[0] = *(const LAS bf16x8*)(kp);        kf[1] = *(const LAS bf16x8*)(kp + 512);  kf[2] = *(const LAS bf16x8*)(kp + 2048); kf[3] = *(const LAS bf16x8*)(kp + 2560);
    kf[4] = *(const LAS bf16x8*)(kp + 4096); kf[5] = *(const LAS bf16x8*)(kp + 4608); kf[6] = *(const LAS bf16x8*)(kp + 6144); kf[7] = *(const LAS bf16x8*)(kp + 6656); }
__device__ __forceinline__ void kload2(bf16x8* kf, lds_cptr kp, int j) { kf[2 * j] = *(const LAS bf16x8*)(kp + j * 2048); kf[2 * j + 1] = *(const LAS bf16x8*)(kp + j * 2048 + 512); }
__device__ __forceinline__ s16x4 vtr(lds_cptr p) { return __builtin_bit_cast(s16x4, __builtin_amdgcn_ds_read_tr16_b64_v4i16((LAS v4i16_t*)p)); }
template <int THRL>
__device__ __forceinline__ void fast_seg(const Ctx& c, const bf16x8 (&qr)[4], int kind, int qb, int tok, unsigned long long mymask, const bf16* Kb, const bf16* Vb, int NTreal, float gate, LAS float* out) {
    const int NT = NTreal < 3 ? 4 : ((NTreal + 1) & ~1);
    const unsigned lds0 = (unsigned)(uintptr_t)c.shm;
    const unsigned kdst = lds0 + LDS_K + c.wid * 1024, vdst = lds0 + LDS_V + c.wid * 1024;
    const lds_cptr shm3 = (lds_cptr)c.shm; const lds_cptr kp0 = shm3 + LDS_K + c.hi * 1024 + c.r32 * 16;
    const lds_cptr vp0 = shm3 + LDS_V + ((c.lane >> 4) & 1) * 32 + (c.lane & 3) * 8 + (4 * c.hi + ((c.lane & 15) >> 2)) * 64;
    const int hi = c.hi, r32 = c.r32;
#define FS_BLK(t) ((t) < NTreal ? (kind == 0 ? (t) : qb - (t)) : (kind == 0 ? 0 : qb))
#define FS_DMA_K(t, slot) glds16(uni_ptr(Kb + (size_t)FS_BLK(t) * 4096) + c.koff, (unsigned)__builtin_amdgcn_readfirstlane(kdst + (slot)))
#define FS_DMA_V(t, slot) glds16(uni_ptr(Vb + (size_t)FS_BLK(t) * 4096) + c.koff, (unsigned)__builtin_amdgcn_readfirstlane(vdst + (slot)))
#define FS_WAIT_BAR(N) asm volatile("s_waitcnt vmcnt(" #N ") lgkmcnt(0)\n\ts_barrier" ::: "memory")
#define FS_SBAR() __builtin_amdgcn_sched_barrier(0)
#define FS_MASK(P0, P1, t) do { const int t_ = (t); \
        if (t_ >= NTreal) mask_all(P0, P1); \
        else if (kind == 0) { const bool sel_ = (mymask >> t_) & 1ull; if (__any(!sel_)) { if (!sel_) mask_all(P0, P1); } if (t_ == qb) mask_gt(P0, P1, tok, hi); } \
        else { if (t_ == 0) mask_gt(P0, P1, tok, hi); if (t_ == 8) mask_le(P0, P1, tok, hi); } } while (0)
    bf16x8 kfa, kfb, kfc, kfd;
    FS_DMA_K(0, 0); FS_DMA_V(0, 0); FS_DMA_K(1, SLOTB); FS_DMA_K(2, 2 * SLOTB);
    float mhat = 0.f, l_reg = 0.f; f32x16 o[2]; o[0] = f32x16{}; o[1] = f32x16{};
    bool resc = false;
    f32x16 pA0, pA1, pB0, pB1;
    int sl_prev = 0, sl_cur = 0, sl_next = SLOTB;
#define FS_ROT() do { sl_prev = sl_cur; sl_cur = sl_next; sl_next = (sl_next == 2 * SLOTB) ? 0 : sl_next + SLOTB; } while (0)
#define FS_RESC() do { if (resc) { asm volatile("s_waitcnt lgkmcnt(0)" ::: "memory"); \
        _Pragma("unroll") for (int d_ = 0; d_ < 2; ++d_) _Pragma("unroll") for (int r = 0; r < 16; ++r) o[d_][r] *= c.wsf[crow(r, hi)]; } } while (0)
    FS_WAIT_BAR(3);
    qkt(pA0, pA1, c.shm + LDS_K, qr, r32, hi);
    FS_MASK(pA0, pA1, 0);
    { float a = __builtin_fmaxf(__builtin_fmaxf(pA0[0], pA0[1]), pA1[0]);
#pragma unroll
      for (int r = 0; r < 16; ++r) a = __builtin_fmaxf(__builtin_fmaxf(a, pA0[r]), pA1[r]);
      { auto rr = __builtin_amdgcn_permlane32_swap(__float_as_uint(a), __float_as_uint(a), false, false); a = __builtin_fmaxf(__uint_as_float(rr[0]), __uint_as_float(rr[1])); }
      mhat = a;
#pragma unroll
      for (int r = 0; r < 16; ++r) { pA0[r] = __builtin_amdgcn_exp2f(pA0[r] - mhat); pA1[r] = __builtin_amdgcn_exp2f(pA1[r] - mhat); } }
    FS_WAIT_BAR(0);
    FS_DMA_K(3, 3 * SLOTB); FS_DMA_V(1, SLOTB);
    FS_ROT();
    kfa = *(const LAS bf16x8*)(kp0 + SLOTB); kfb = *(const LAS bf16x8*)(kp0 + SLOTB + 512);
    s16x4 vlo[8], vhi[8]; v4u pw0, pw1, pw2, pw3;
#define FS_PKW(P, B) cvtpk(P[B], P[(B) + 1])
#define FS_PAF(k) __builtin_bit_cast(bf16x8, pw##k)
#define FS_VFR(i) (bf16x8){vlo[i][0], vlo[i][1], vlo[i][2], vlo[i][3], vhi[i][0], vhi[i][1], vhi[i][2], vhi[i][3]}
#define FS_PIN(x) asm volatile("" : "+v"(x))
#define FS_MX3(a, b, c_) __builtin_fmaxf(__builtin_fmaxf((a), (b)), (c_))
#define FS_GAPA(MF, A0, A1, A2, A3, W0, W1, PW) do { MF; sacc += A0; sacc += A1; sacc += A2; sacc += A3; FS_PIN(sacc); W0; W1; FS_PIN(PW); FS_SBAR(); } while (0)
#define FS_EX(v) __builtin_amdgcn_exp2f((v) - mhat)
#define FS_GAPB(MF, X, B) do { MF; X[B] = FS_EX(X[B]); X[(B) + 1] = FS_EX(X[(B) + 1]); X[(B) + 2] = FS_EX(X[(B) + 2]); X[(B) + 3] = FS_EX(X[(B) + 3]); FS_PIN(X); FS_SBAR(); } while (0)
#define FS_VRD(i) do { vlo[i] = vtr(vp_ + (((i) >> 2) * 4096 + ((i) & 3) * 1024)); vhi[i] = vtr(vp_ + (((i) >> 2) * 4096 + ((i) & 3) * 1024 + 512)); } while (0)
#define FS_KL(off) (*(const LAS bf16x8*)(kq_ + (off)))
#define FS_Z f32x16{}
#define FS_STEP(C0, C1, P0, P1, t, GK, GV, GL) do { FS_SBAR(); \
    const lds_cptr vp_ = vp0 + sl_prev; const lds_cptr kq_ = kp0 + ((t) & 3) * SLOTB; \
    FS_VRD(0); kfc = FS_KL(2048); FS_SBAR(); float sacc = (P0[0] + P0[1]); \
    FS_GAPA(C0 = __builtin_amdgcn_mfma_f32_32x32x16_bf16(kfa, qr[0], FS_Z, 0, 0, 0), P0[2], P0[3], P0[4], P0[5],     pw0[0] = FS_PKW(P0, 0), pw0[1] = FS_PKW(P0, 2), pw0); \
    FS_VRD(4); kfd = FS_KL(2560); FS_SBAR(); FS_GAPA(C1 = __builtin_amdgcn_mfma_f32_32x32x16_bf16(kfb, qr[0], FS_Z, 0, 0, 0), P0[6], P0[7], P0[8], P0[9],     pw0[2] = FS_PKW(P0, 4), pw0[3] = FS_PKW(P0, 6), pw0); \
    FS_VRD(1); kfa = FS_KL(4096); FS_SBAR(); FS_GAPA(C0 = __builtin_amdgcn_mfma_f32_32x32x16_bf16(kfc, qr[1], C0, 0, 0, 0),   P0[10], P0[11], P0[12], P0[13], pw1[0] = FS_PKW(P0, 8), pw1[1] = FS_PKW(P0, 10), pw1); \
    FS_VRD(5); kfb = FS_KL(4608); FS_SBAR(); FS_GAPA(C1 = __builtin_amdgcn_mfma_f32_32x32x16_bf16(kfd, qr[1], C1, 0, 0, 0),   P0[14], P0[15], P1[0], P1[1],   pw1[2] = FS_PKW(P0, 12), pw1[3] = FS_PKW(P0, 14), pw1); \
    FS_VRD(2); kfc = FS_KL(6144); FS_SBAR(); FS_GAPA(C0 = __builtin_amdgcn_mfma_f32_32x32x16_bf16(kfa, qr[2], C0, 0, 0, 0),   P1[2], P1[3], P1[4], P1[5],     pw2[0] = FS_PKW(P1, 0), pw2[1] = FS_PKW(P1, 2), pw2); \
    FS_VRD(6); kfd = FS_KL(6656); FS_SBAR(); FS_GAPA(C1 = __builtin_amdgcn_mfma_f32_32x32x16_bf16(kfb, qr[2], C1, 0, 0, 0),   P1[6], P1[7], P1[8], P1[9],     pw2[2] = FS_PKW(P1, 4), pw2[3] = FS_PKW(P1, 6), pw2); \
    FS_VRD(3); FS_SBAR(); FS_GAPA(C0 = __builtin_amdgcn_mfma_f32_32x32x16_bf16(kfc, qr[3], C0, 0, 0, 0),   P1[10], P1[11], P1[12], P1[13], pw3[0] = FS_PKW(P1, 8), pw3[1] = FS_PKW(P1, 10), pw3); \
    FS_VRD(7); FS_SBAR(); FS_GAPA(C1 = __builtin_amdgcn_mfma_f32_32x32x16_bf16(kfd, qr[3], C1, 0, 0, 0),   P1[14], P1[15], 0.f, 0.f,       pw3[2] = FS_PKW(P1, 12), pw3[3] = FS_PKW(P1, 14), pw3); \
    l_reg += sacc; \
    if (GK) { FS_DMA_K((t) + 3, (((t) + 3) & 3) * SLOTB); } if (GV) { FS_DMA_V((t) + 1, sl_next); } \
    FS_MASK(C0, C1, t); \
    { float a = FS_MX3(C0[0], C0[1], C1[0]), b = FS_MX3(C0[2], C0[3], C1[1]); a = FS_MX3(a, C1[2], C1[3]); \
      _Pragma("unroll") for (int r = 4; r < 16; r += 4) { a = FS_MX3(a, C0[r], C0[r + 1]); b = FS_MX3(b, C0[r + 2], C0[r + 3]); a = FS_MX3(a, C1[r], C1[r + 1]); b = FS_MX3(b, C1[r + 2], C1[r + 3]); } \
      float rm = __builtin_fmaxf(a, b); { auto rr = __builtin_amdgcn_permlane32_swap(__float_as_uint(rm), __float_as_uint(rm), false, false); rm = __builtin_fmaxf(__uint_as_float(rr[0]), __uint_as_float(rr[1])); } \
      rm -= mhat; resc = false; \
      if (__builtin_expect(__any(rm > (float)THRL), 0)) { const float dl = __builtin_fmaxf(rm, 0.f); mhat += dl; \
        const float f = __builtin_amdgcn_exp2f(-dl); l_reg *= f; if (hi == 0) c.wsf[r32] = f; resc = true; } } \
    FS_SBAR(); \
    FS_GAPB(o[0] = __builtin_amdgcn_mfma_f32_32x32x16_bf16(FS_PAF(0), FS_VFR(0), o[0], 0, 0, 0), C0, 0); \
    FS_GAPB(o[1] = __builtin_amdgcn_mfma_f32_32x32x16_bf16(FS_PAF(0), FS_VFR(4), o[1], 0, 0, 0), C0, 4); \
    FS_GAPB(o[0] = __builtin_amdgcn_mfma_f32_32x32x16_bf16(FS_PAF(1), FS_VFR(1), o[0], 0, 0, 0), C0, 8); \
    FS_GAPB(o[1] = __builtin_amdgcn_mfma_f32_32x32x16_bf16(FS_PAF(1), FS_VFR(5), o[1], 0, 0, 0), C0, 12); \
    FS_GAPB(o[0] = __builtin_amdgcn_mfma_f32_32x32x16_bf16(FS_PAF(2), FS_VFR(2), o[0], 0, 0, 0), C1, 0); \
    FS_GAPB(o[1] = __builtin_amdgcn_mfma_f32_32x32x16_bf16(FS_PAF(2), FS_VFR(6), o[1], 0, 0, 0), C1, 4); \
    if (GL) { const lds_cptr kn_ = kp0 + (((t) + 1) & 3) * SLOTB; kfa = *(const LAS bf16x8*)(kn_); kfb = *(const LAS bf16x8*)(kn_ + 512); FS_SBAR(); } \
    FS_GAPB(o[0] = __builtin_amdgcn_mfma_f32_32x32x16_bf16(FS_PAF(3), FS_VFR(3), o[0], 0, 0, 0), C1, 8); \
    FS_GAPB(o[1] = __builtin_amdgcn_mfma_f32_32x32x16_bf16(FS_PAF(3), FS_VFR(7), o[1], 0, 0, 0), C1, 12); \
    } while (0)
    int t = 1;
    for (; t + 5 < NT; t += 2) {
        FS_STEP(pB0, pB1, pA0, pA1, t, true, true, true);     FS_WAIT_BAR(2); FS_RESC(); FS_ROT();
        FS_STEP(pA0, pA1, pB0, pB1, t + 1, true, true, true); FS_WAIT_BAR(2); FS_RESC(); FS_ROT();
    }
#define FS_ENDW(tt) do { if ((tt) + 3 < NT) { FS_WAIT_BAR(2); } else if ((tt) + 2 < NT) { FS_WAIT_BAR(1); } else { FS_WAIT_BAR(0); } } while (0)
    for (; t + 1 < NT; t += 2) {
        FS_STEP(pB0, pB1, pA0, pA1, t, (t + 3 < NT), (t + 1 < NT), (t + 1 < NT));         FS_ENDW(t);     FS_RESC(); FS_ROT();
        FS_STEP(pA0, pA1, pB0, pB1, t + 1, (t + 4 < NT), (t + 2 < NT), (t + 2 < NT));     FS_ENDW(t + 1); FS_RESC(); FS_ROT();
    }
    FS_STEP(pB0, pB1, pA0, pA1, NT - 1, false, false, false); FS_RESC();
    { float sacc = pB0[0] + pB0[1];
#pragma unroll
      for (int r = 2; r < 16; ++r) sacc += pB0[r];
#pragma unroll
      for (int r = 0; r < 16; ++r) sacc += pB1[r];
      l_reg += sacc;
      pw0 = (v4u){FS_PKW(pB0, 0), FS_PKW(pB0, 2), FS_PKW(pB0, 4), FS_PKW(pB0, 6)}; pw1 = (v4u){FS_PKW(pB0, 8), FS_PKW(pB0, 10), FS_PKW(pB0, 12), FS_PKW(pB0, 14)};
      pw2 = (v4u){FS_PKW(pB1, 0), FS_PKW(pB1, 2), FS_PKW(pB1, 4), FS_PKW(pB1, 6)}; pw3 = (v4u){FS_PKW(pB1, 8), FS_PKW(pB1, 10), FS_PKW(pB1, 12), FS_PKW(pB1, 14)};
      FS_SBAR(); pv(o, c.vb0 + sl_cur, FS_PAF(0), FS_PAF(1), FS_PAF(2), FS_PAF(3)); }
    const float lt = halfswap_add(l_reg);
    fold_out(c, out, o, lt > 0.f ? gate / lt : 0.f);
    asm volatile("s_waitcnt lgkmcnt(0)\n\ts_barrier" ::: "memory");
#undef FS_BLK
#undef FS_DMA_K
#undef FS_DMA_V
#undef FS_WAIT_BAR
#undef FS_SBAR
#undef FS_MASK
#undef FS_ROT
#undef FS_RESC
#undef FS_PKW
#undef FS_PAF
#undef FS_VFR
#undef FS_PIN
#undef FS_MX3
#undef FS_GAPA
#undef FS_EX
#undef FS_GAPB
#undef FS_VRD
#undef FS_KL
#undef FS_Z
#undef FS_STEP
#undef FS_ENDW
}

__device__ __forceinline__ void attn_unit(Frame& F, int b, int g, int qb) {
    Ctx c; c.shm = F.lds + RING_OFF; c.wid = F.wave; c.lane = F.lane; c.r32 = F.lane & 31; c.hi = F.lane >> 5;
    c.wsf = (LAS float*)(c.shm + LDS_WS) + c.wid * 64;
    c.vb0 = (int)(uintptr_t)(c.shm + LDS_V) + ((c.lane >> 4) & 1) * 32 + (c.lane & 3) * 8 + (4 * c.hi + ((c.lane & 15) >> 2)) * 64;
    c.koff = (unsigned)(c.wid * 1024 + c.lane * 16); c.voff = c.koff;
    const int tt = c.r32 & 7, hh = c.r32 >> 3, tok = 8 * c.wid + tt, t0 = 64 * qb, t = t0 + tok;
    const size_t grow = (size_t)b * SEQ + t;
    const bf16* Qp = (const bf16*)(F.ws + WS_Q) + grow * D + (4 * g + hh) * 64 + c.hi * 8;
    const bf16* KV6 = (const bf16*)(F.ws + WS_KV6) + (size_t)(b * 4 + g) * SEQ * 64;
    const bf16* KC = (const bf16*)(F.ws + WS_KVC) + (size_t)(b * 4 + g) * 256 * 64;
    VM_WAIT();
    bf16x8 qr[4];
#pragma unroll
    for (int d0 = 0; d0 < 4; ++d0) qr[d0] = *(const bf16x8*)(Qp + d0 * 16);
    const float* gp = (const float*)(F.ws + WS_GATES) + grow * 48 + (4 * g + hh) * 3;
    LAS float* out = (LAS float*)(c.shm + LDS_OST) + c.wid * 32 * OSTR;
#pragma unroll
    for (int k = 0; k < 32; ++k) out[k * OSTR + c.lane] = 0.f;
    LAS float* imp = (LAS float*)(c.shm + LDS_IMP) + c.wid * 512;
    LAS unsigned long long* smk = (LAS unsigned long long*)(c.shm + LDS_SM) + c.wid * 8;
    const bool need_sel = qb > 15;
    if (need_sel) {
#pragma unroll
        for (int k = 0; k < 8; ++k) imp[k * 64 + c.lane] = 0.f; }
    const int nmax = (t - 31) >> 4;
    const int nmax_min = (t0 - 31) >> 4;
    const int nct = ((4 * qb + 2) >> 6) + 1;
    const int e0 = nct, e1 = 2 * nct;
    for (int j = 0; j < nct; ++j) { dma_k(c, KC + (size_t)j * 4096, j); dma_v(c, KC + (size_t)32 * 256 * 64 + (size_t)j * 4096, j); }
    float m = -INFINITY, l = 0.f; f32x16 o[2]; o[0] = f32x16{}; o[1] = f32x16{};
    ATT_WAIT_BAR(0);
    f32x16 p0, p1;
    qkt(p0, p1, c.shm + LDS_K, qr, c.r32, c.hi);
    for (int i = 0; i < e1; ++i) {
        const bool pass2 = i >= e0; const int j = pass2 ? i - e0 : i; const int jn = (i + 1 >= e0) ? i + 1 - e0 : i + 1;
        if (64 * j + 63 > nmax_min) mask_gt(p0, p1, nmax - 64 * j, c.hi);
        float mn = m, f = 1.0f;
        if (!pass2) { const float rm = rowmax(p0, p1); mn = fmaxf(fmaxf(m, rm), -1.0e30f); f = __builtin_amdgcn_exp2f(m - mn); m = mn; }
        f32x16 n0 = f32x16{}, n1 = f32x16{}; float s = 0.f; v4u pw0, pw1, pw2, pw3;
        const bool do_imp = pass2 && need_sel;
        LAS float* impr = imp + tt * 64 + 16 * j + c.hi;
        { const LAS unsigned char* kb = c.shm + LDS_K + (jn & 3) * SLOTB + c.hi * 1024 + c.r32 * 16;
#define ATT_GRP(d0_, P_, B_, PW_) do { const bf16x8 b0_ = *(const LAS bf16x8*)(kb + (d0_) * 2048), b1_ = *(const LAS bf16x8*)(kb + (d0_) * 2048 + 512); \
            n0 = __builtin_amdgcn_mfma_f32_32x32x16_bf16(b0_, qr[d0_], n0, 0, 0, 0); n1 = __builtin_amdgcn_mfma_f32_32x32x16_bf16(b1_, qr[d0_], n1, 0, 0, 0); \
            float e_[8]; _Pragma("unroll") for (int r_ = 0; r_ < 8; ++r_) { e_[r_] = __builtin_amdgcn_exp2f(P_[(B_) + r_] - mn); s += e_[r_]; } \
            PW_ = (v4u){cvtpk(e_[0], e_[1]), cvtpk(e_[2], e_[3]), cvtpk(e_[4], e_[5]), cvtpk(e_[6], e_[7])}; \
            if (do_imp) { float qa = (e_[0] + e_[1]) + (e_[2] + e_[3]), qb_ = (e_[4] + e_[5]) + (e_[6] + e_[7]), la = e_[3], lb = e_[7]; \
                qa += __shfl_xor(qa, 8); qa += __shfl_xor(qa, 16); qb_ += __shfl_xor(qb_, 8); qb_ += __shfl_xor(qb_, 16); la += __shfl_xor(la, 8); la += __shfl_xor(la, 16); lb += __shfl_xor(lb, 8); lb += __shfl_xor(lb, 16); \
                if (hh == 0) { const int jo = 4 * ((d0_) & 1) + 8 * ((d0_) >> 1); impr[jo] += qa; impr[jo + 2] += qb_; LDS_WAIT(); \
                    if (16 * j + c.hi + jo + 1 < 64) impr[jo + 1] += la; if (16 * j + c.hi + jo + 3 < 64) impr[jo + 3] += lb; LDS_WAIT(); } } \
            __builtin_amdgcn_sched_barrier(0); } while (0)
          ATT_GRP(0, p0, 0, pw0); ATT_GRP(1, p0, 8, pw1); ATT_GRP(2, p1, 0, pw2); ATT_GRP(3, p1, 8, pw3);
#undef ATT_GRP
        }
        l = l * f + s;
        if (!pass2) {
            if (i + 1 == e0) { const float lt = halfswap_add(l); m = lt > 0.f ? m + __builtin_amdgcn_logf(lt) : 0.f; l = 0.f; }
        } else
            pv(o, c.vb0 + j * SLOTB, __builtin_bit_cast(bf16x8, pw0), __builtin_bit_cast(bf16x8, pw1), __builtin_bit_cast(bf16x8, pw2), __builtin_bit_cast(bf16x8, pw3));
        p0 = n0; p1 = n1;
    }
    fold_out(c, out, o, gp[0]);
    unsigned long long mymask;
    if (need_sel) {
        const unsigned long long lt_mask = (1ull << c.lane) - 1ull;
        for (int k = 0; k < 8; ++k) {
            const int jl = c.lane; const bool valid = jl <= qb; const bool forced = (jl == 0) || (jl == qb) || (jl == qb - 1);
            const float sc = valid ? imp[k * 64 + jl] + (forced ? 1000.0f : 0.0f) : -1.0f;
            const unsigned u = __float_as_uint(sc); const unsigned key = (u & 0x80000000u) ? ~u : (u | 0x80000000u);
            unsigned T = 0u;
#pragma unroll 4
            for (int bit = 31; bit >= 0; --bit) { const unsigned cand = T | (1u << bit); if (__popcll(__ballot(key >= cand)) >= 16) T = cand; }
            const unsigned long long gt = __ballot(key > T), eq = __ballot(key == T); const int need = 16 - __popcll(gt);
            const bool sel = (key > T) || (key == T && __popcll(eq & lt_mask) < need);
            const unsigned long long mk = __ballot(sel && valid);
            if (c.lane == 0) smk[k] = mk;
        }
        LDS_WAIT();
        mymask = smk[tt];
    } else mymask = (2ull << qb) - 1ull;
    asm volatile("s_waitcnt lgkmcnt(0)\n\ts_barrier" ::: "memory");
    for (int kind = 0; kind < 2; ++kind) {
        const bf16* Kb = KV6 + (kind == 0 ? 2 : 4) * KV6_STRIDE; const bf16* Vb = Kb + KV6_STRIDE;
        fast_seg<8>(c, qr, kind, qb, tok, mymask, Kb, Vb, kind == 0 ? qb + 1 : (qb < 8 ? qb : 8) + 1, gp[1 + kind], out);
    }
    {
        LDS_WAIT();
        bf16* AO = (bf16*)(F.ws + WS_AO);
#pragma unroll
        for (int i = 0; i < 4; ++i) { const int row = i * 8 + (c.lane >> 3), ch = c.lane & 7; const LAS f32x4* sp = (const LAS f32x4*)(out + (c.lane >> 3) * OSTR + ((ch * 8) ^ (((c.lane >> 3) & 4) << 3)) + i * 8 * OSTR); const f32x4 a = sp[0], bq = sp[1];
            const v4u v = (v4u){cvtpk(a[0], a[1]), cvtpk(a[2], a[3]), cvtpk(bq[0], bq[1]), cvtpk(bq[2], bq[3])};
            *(v4u*)(AO + ((size_t)b * SEQ + t0 + 8 * c.wid + (row & 7)) * D + (4 * g + (row >> 3)) * 64 + ch * 8) = v; }
        LDS_WAIT();
    }
    asm volatile("s_waitcnt lgkmcnt(0)\n\ts_barrier" ::: "memory");
}
__device__ __forceinline__ void attn_phase(Frame& F) {
    const int bg = F.vcu >> 3, s = F.vcu & 7;
    const int gw = F.vcu * NWAVES + F.wave, NGW = F.G * NWAVES;
    LAS unsigned* scr = (LAS unsigned*)(F.lds + RING_OFF + F.wave * W_SCR);
    static_assert(NWAVES * W_SCR <= LDS_IMP, "MoE weight items use the K/V ring / out-tile region between attention units");
    for (int i = 0; i < 8; ++i) { const int base = (i >> 1) * 16; const int qb = (i & 1) ? base + 15 - s : base + s;
        attn_unit(F, bg >> 2, bg & 3, qb);
        { const int it = W_MOE0 + gw + NGW * i;
            if (it < W_NITEMS) { const WItem w = witem_decode(F, it); f32x4 la[32]; witem_load(w, F.lane, la); witem_store(w, F.lane, la, scr); } }
        asm volatile("s_waitcnt vmcnt(0) lgkmcnt(0)\n\ts_barrier" ::: "memory");
    }
}
#undef ATT_WAIT_BAR
#undef ATT_LGKM_BAR
}

#ifndef MK_PER_PHASE
#define MK_PER_PHASE 0
#endif
constexpr int N_PHASES = 24;
struct Args { const float* in[18]; float* out; unsigned char* ws; int ph_lo, ph_hi, li, pad; };

__global__ void __launch_bounds__(NWAVES * 64, 2) fwd_kernel(Args args) {
    extern __shared__ __attribute__((aligned(16))) unsigned char lds[];
    Frame F;
    F.lds = (LAS unsigned char*)lds;
    F.MISC = (volatile LAS unsigned*)(F.lds + MISC_OFF);
    refresh(F);
    F.G = gridDim.x; { const int bx = blockIdx.x; F.vcu = (F.G % 8 == 0) ? (bx % 8) * (F.G / 8) + bx / 8 : bx; }
    F.ws = args.ws; F.ctl = (gu32*)(args.ws + WS_CTL); F.out = args.out;
    for (int u = F.tid; u < (LDS_BYTES - LDSCTL_OFF) / 4; u += NWAVES * 64) ((LAS unsigned*)(F.lds + LDSCTL_OFF))[u] = 0u;
    __syncthreads();
    if (F.tid < 18) ((LAS unsigned long long*)(F.lds + PTR_OFF))[F.tid] = (unsigned long long)args.in[F.tid];
    __syncthreads();
    XcdBarrier bar = xcd_barrier_post((unsigned*)(F.ctl + CW_BAR) + args.li * XCD_BAR_WORDS, F.MISC + 8);
#define GRID_BAR() xcd_barrier(bar)
    const int lo = args.ph_lo, hi = args.ph_hi;
#ifndef PH_MASK
#define PH_MASK 0xFFFFFFu
#endif
#define IN(k) (((PH_MASK >> ((k) > 13 ? 13 + (((k) - 13) & 1) : (k))) & 1u) && lo <= (k) && (k) < hi)
#define BOTH(k) (IN(k) && IN((k) + 1))
#ifndef REP_MASK
#define REP_MASK 0u
#endif
#define REPS(k) (1 + (int)((REP_MASK >> ((k) > 13 ? 13 + (((k) - 13) & 1) : (k))) & 1u))
    unsigned char* ws = args.ws;
    float* R0 = (float*)(ws + WS_R0); bf16* XB = (bf16*)(ws + WS_XB);
    const int cblk = (int)blockIdx.x;

    if (IN(0)) for (int rep_ = 0; rep_ < REPS(0); ++rep_) { refresh(F); p0_prologue(F); if (BOTH(0)) GRID_BAR(); }
    if (IN(1)) for (int rep_ = 0; rep_ < REPS(1); ++rep_) { refresh(F);
        pg8::Gemm g{(const bf16*)(ws + WS_APOOL), (const bf16*)(ws + W_POOL), D, 256}; ep::PoolOrder S{F.G, cblk};
        ep::EpiPool E{F.inp(I_X), F.inp(I_POOLS), R0};
        pg8::gemm_phase<ep::EpiPool, ep::PoolOrder, true, false>(F.lds + RING_OFF, g, S, E);
        if (BOTH(1)) GRID_BAR(); }
    if (IN(2)) for (int rep_ = 0; rep_ < REPS(2); ++rep_) { refresh(F); ln_phase(F, R0, F.inp(I_LNG) + 0 * D, F.inp(I_LNB) + 0 * D, R0, XB); if (BOTH(2)) GRID_BAR(); }
    if (IN(3)) for (int rep_ = 0; rep_ < REPS(3); ++rep_) { refresh(F);
        pg8::Gemm g{XB, (const bf16*)(ws + W_FGU), D, D}; ep::DenseOrder S{T / 256, 2 * DFF / 256, F.G, cblk, (size_t)256 * D * 2, (size_t)256 * D * 2};
        ep::EpiSwiGLU E{(bf16*)(ws + WS_H1), DFF, 0};
        pg8::gemm_phase(F.lds + RING_OFF, g, S, E);
        if (BOTH(3)) GRID_BAR(); }
    if (IN(4)) for (int rep_ = 0; rep_ < REPS(4); ++rep_) { refresh(F);
        pg8::Gemm g{(const bf16*)(ws + WS_H1), (const bf16*)(ws + W_FDN), DFF, DFF}; ep::DenseOrder S{T / 256, D / 256, F.G, cblk, (size_t)256 * DFF * 2, (size_t)256 * DFF * 2};
        ep::EpiResid E{R0};
        pg8::gemm_phase(F.lds + RING_OFF, g, S, E);
        if (BOTH(4)) GRID_BAR(); }
    if (IN(5)) for (int rep_ = 0; rep_ < REPS(5); ++rep_) { refresh(F); ln_phase(F, R0, F.inp(I_LNG) + 1 * D, F.inp(I_LNB) + 1 * D, R0, XB); if (BOTH(5)) GRID_BAR(); }
    if (IN(6)) for (int rep_ = 0; rep_ < REPS(6); ++rep_) { refresh(F);
        pg8::Gemm g{XB, (const bf16*)(ws + W_IN), D, D}; ep::DenseOrder S{T / 256, INP_PAD / 256, F.G, cblk, (size_t)256 * D * 2, (size_t)256 * D * 2};
        ep::EpiInProj E{(bf16*)(ws + WS_Q), (bf16*)(ws + WS_KV6), (float*)(ws + WS_GATES), (const float*)(ws + WS_ROPE), (const float*)(ws + WS_ROPE) + SEQ * 32};
        pg8::gemm_phase(F.lds + RING_OFF, g, S, E);
        if (BOTH(6)) GRID_BAR(); }
    if (IN(7)) for (int rep_ = 0; rep_ < REPS(7); ++rep_) { refresh(F);
        pg8::Gemm g{(const bf16*)(ws + WS_KV6), (const bf16*)(ws + W_C1), 1024, 512}; ep::CmpOrder S{F.G, cblk};
        ep::EpiCPart E{(float*)(ws + WS_CPART)};
        pg8::gemm_phase(F.lds + RING_OFF, g, S, E);
        if (BOTH(7)) GRID_BAR(); }
    if (IN(8)) for (int rep_ = 0; rep_ < REPS(8); ++rep_) { refresh(F); compress_finish_phase(F); if (BOTH(8)) GRID_BAR(); }
    if (IN(9)) for (int rep_ = 0; rep_ < REPS(9); ++rep_) { refresh(F); att::attn_phase(F); if (BOTH(9)) GRID_BAR(); }
    if (IN(10)) for (int rep_ = 0; rep_ < REPS(10); ++rep_) { refresh(F);
        pg8::Gemm g{(const bf16*)(ws + WS_AO), (const bf16*)(ws + W_OUT), D, D}; ep::DenseOrder S{T / 256, D / 256, F.G, cblk, (size_t)256 * D * 2, (size_t)256 * D * 2};
        ep::EpiResid E{R0};
        pg8::gemm_phase(F.lds + RING_OFF, g, S, E);
        if (BOTH(10)) GRID_BAR(); }
    if (IN(11)) for (int rep_ = 0; rep_ < REPS(11); ++rep_) { refresh(F); ln_router_phase(F, R0, F.inp(I_LNG) + 2 * D, F.inp(I_LNB) + 2 * D, XB); if (BOTH(11)) GRID_BAR(); }
    if (IN(12)) for (int rep_ = 0; rep_ < REPS(12); ++rep_) { refresh(F); moe_dispatch_phase(F); if (BOTH(12)) GRID_BAR(); }
    for (int ch = 0; ch < MOE_NCH; ++ch) {
        const int p1 = 13 + 2 * ch, p2 = p1 + 1;
        const LAS int* mt = (const LAS int*)(F.lds + MOET_OFF);
        if (IN(p1)) for (int rep_ = 0; rep_ < REPS(p1); ++rep_) { refresh(F);
            if (lo == p1) moe_tables(F);
            const int NT = mt[24], tile0 = MOE_CH * ch, nM = (NT - tile0) < MOE_CH ? (NT - tile0) : MOE_CH;
            if (nM > 0) {
                pg8::Gemm g{(const bf16*)(ws + WS_XS), (const bf16*)(ws + W_MGU), D, D};
                ep::MoeOrder<2 * DFE / 256> S{nM, F.G, cblk, tile0, mt + 32, (size_t)256 * D * 2, (size_t)2 * DFE * D * 2, (size_t)256 * D * 2, false};
                ep::EpiSwiGLU E{(bf16*)(ws + WS_H2), DFE, tile0};
                pg8::gemm_phase(F.lds + RING_OFF, g, S, E);
                if (BOTH(p1)) GRID_BAR(); } }
        if (IN(p2)) for (int rep_ = 0; rep_ < REPS(p2); ++rep_) { refresh(F);
            if (lo == p2) moe_tables(F);
            const int NT = mt[24], tile0 = MOE_CH * ch, nM = (NT - tile0) < MOE_CH ? (NT - tile0) : MOE_CH;
            if (nM > 0) {
                pg8::Gemm g{(const bf16*)(ws + WS_H2), (const bf16*)(ws + W_MDN), DFE, DFE};
                ep::MoeOrder<D / 256> S{nM, F.G, cblk, tile0, mt + 32, (size_t)256 * DFE * 2, (size_t)D * DFE * 2, (size_t)256 * DFE * 2, true};
                ep::EpiMoeDown E{(bf16*)(ws + WS_Y), (const int*)(ws + WS_SDST), (const float*)(ws + WS_SW)};
                pg8::gemm_phase(F.lds + RING_OFF, g, S, E);
                if (BOTH(p2)) GRID_BAR(); } }
    }
    if (IN(23)) for (int rep_ = 0; rep_ < REPS(23); ++rep_) { refresh(F); final_phase(F, R0, F.inp(I_LNG) + 3 * D, F.inp(I_LNB) + 3 * D, F.out); }
#undef IN
#undef BOTH
#undef GRID_BAR
}

extern "C" void kernel_launch(void* const* d_in, const int* in_sizes, int n_in, void* d_out, int out_size, void* d_ws, size_t ws_size, hipStream_t stream) {
    static int grid = 0;
    if (grid == 0) {
        if (n_in != 18 || in_sizes[0] != T * D || out_size != T * D || ws_size < WS_END) { fprintf(stderr, "kernel_launch: shape/workspace mismatch (n_in %d, ws %zu)\n", n_in, ws_size); grid = -1; return; }
        int dev = 0, cus = 0, per_cu = 0;
        if (hipGetDevice(&dev) != hipSuccess || hipDeviceGetAttribute(&cus, hipDeviceAttributeMultiprocessorCount, dev) != hipSuccess) { grid = -1; return; }
        if (hipFuncSetAttribute((const void*)fwd_kernel, hipFuncAttributeMaxDynamicSharedMemorySize, LDS_BYTES) != hipSuccess) { fprintf(stderr, "kernel_launch: hipFuncSetAttribute failed\n"); grid = -1; return; }
        if (hipOccupancyMaxActiveBlocksPerMultiprocessor(&per_cu, (const void*)fwd_kernel, NWAVES * 64, LDS_BYTES) != hipSuccess || per_cu < 1) { fprintf(stderr, "kernel_launch: occupancy query says %d blocks per CU\n", per_cu); }
        (void)hipGetLastError();
        if (cus != 256) { fprintf(stderr, "kernel_launch: built for 256 CUs, device has %d\n", cus); grid = -1; return; }
        grid = 256;
    }
    if (grid < 0) return;
    if (hipMemsetAsync((char*)d_ws + WS_CTL, 0, CTL_ZERO_BYTES, stream) != hipSuccess) return;
    Args a{};
    for (int i = 0; i < 18; ++i) a.in[i] = (const float*)d_in[i];
    a.out = (float*)d_out; a.ws = (unsigned char*)d_ws;
#if MK_PER_PHASE
    for (int p = 0; p < N_PHASES; ++p) { a.ph_lo = p; a.ph_hi = p + 1; a.li = p; hipLaunchKernelGGL(fwd_kernel, dim3(grid), dim3(NWAVES * 64), LDS_BYTES, stream, a); }
#else
    a.ph_lo = 0; a.ph_hi = N_PHASES; a.li = 0;
    hipLaunchKernelGGL(fwd_kernel, dim3(grid), dim3(NWAVES * 64), LDS_BYTES, stream, a);
#endif
}
```

```cpp
#include <hip/hip_runtime.h>
#include <cstdio>
#include <cstdint>

namespace pg8 {
#define PG8_LAS __attribute__((address_space(3)))
typedef unsigned short bf16_t;
typedef short bf16x8 __attribute__((ext_vector_type(8)));
typedef float f32x4 __attribute__((ext_vector_type(4)));
typedef float f32x2 __attribute__((ext_vector_type(2)));
typedef unsigned u32x4 __attribute__((ext_vector_type(4)));
typedef unsigned u32x2 __attribute__((ext_vector_type(2)));
constexpr int BM = 256, BK = 64, HALF = 128, HTB = HALF * BK * 2  , STAGE_BYTES = 8 * HTB, NXCD = 8, WGM = 8;

__host__ __device__ __forceinline__ int lds_byte(int r, int c) { const int st = (r >> 4) * 2 + (c >> 5), rr = r & 15, cc = c & 31, ob = rr * 64 + cc * 2; return st * 1024 + (ob ^ (((ob >> 9) & 1) << 5)); }
__host__ __device__ __forceinline__ void stage_rc(int b, int& R, int& C) { const int st = b / 1024, sb = b % 1024, swz = sb ^ (((sb >> 9) & 1) << 5); R = (st >> 1) * 16 + swz / 64; C = (st & 1) * 32 + (swz % 64) / 2; }
__host__ __device__ __forceinline__ int perm32(int rho) { const int n = rho >> 4, i = rho & 15; return 8 * (i >> 2) + 4 * n + (i & 3); }

struct Unit { int pm, pn; size_t aoff, boff; };
struct Gemm { const bf16_t* A; const bf16_t* Bt; int lda, K; };

__device__ __forceinline__ void order_tile(int L, int nM, int nN, int& pm, int& pn) {
    const int nwg = nM * nN; int wgid = L;
    { const int q = nwg / NXCD, r = nwg % NXCD, xcd = wgid % NXCD, off = wgid / NXCD; wgid = (xcd < r ? xcd * (q + 1) : r * (q + 1) + (xcd - r) * q) + off; }
    const int nig = WGM * nN, gid = wgid / nig, fm = gid * WGM, gsz = (nM - fm) < WGM ? (nM - fm) : WGM;
    pm = fm + ((wgid % nig) % gsz); pn = (wgid % nig) / gsz;
}

__device__ __forceinline__ unsigned cvt_pk_bf16(float lo, float hi) { unsigned r; asm volatile("v_cvt_pk_bf16_f32 %0, %1, %2" : "=v"(r) : "v"(lo), "v"(hi)); return r; }

template <class Epi, class Sched, bool ALIGN_EPI = true, bool SP2 = true>
__device__ __forceinline__ void gemm_phase(PG8_LAS unsigned char* lds, const Gemm g, const Sched& S, const Epi& E) {
    int tid = threadIdx.x; asm volatile("" : "+v"(tid));
    const int wid = __builtin_amdgcn_readfirstlane(tid >> 6), lane = tid & 63, wr = wid >> 2, wc = wid & 3, fr = lane & 15, fq = lane >> 4;
    const int K = g.K, nt = K / BK;
    unsigned voffA[2], voffB[2];
#pragma unroll
    for (int i = 0; i < 2; ++i) { int R, C; stage_rc(tid * 16 + i * 8192, R, C); const int Rb = Epi::PERM ? ((R & ~31) + perm32(R & 31)) : R;
        voffA[i] = (unsigned)(R * g.lda + C) * 2u; voffB[i] = (unsigned)(tid * 16 + i * 8192); (void)Rb; }
    const size_t kstep = (size_t)(BK * 2), kstepB = 32768;
    const size_t hstepA = (size_t)HALF * g.lda * 2, hstepB = 16384;
    const unsigned ldsw = (unsigned)wid * 1024u;
    const int aoff = lds_byte(wr * 64 + fr, fq * 8), boff = lds_byte(wc * 32 + fr, fq * 8);
#define PG8_SA(b, h) (((b) * 2 + (h)) * HTB)
#define PG8_SB(b, h) ((4 + (b) * 2 + (h)) * HTB)
#define PG8_STAGE(bufoff, gbase, voff) do { _Pragma("unroll") for (int _i = 0; _i < 2; ++_i) \
        __builtin_amdgcn_global_load_lds((const unsigned*)((const char*)(gbase) + (voff)[_i]), (PG8_LAS unsigned*)(lds + (bufoff) + ldsw + _i * 8192), 16, 0, 0); } while (0)
#define PG8_LDA(dst, b, h) do { _Pragma("unroll") for (int m = 0; m < 4; ++m) _Pragma("unroll") for (int k = 0; k < 2; ++k) dst[m][k] = *(const PG8_LAS bf16x8*)(lds + PG8_SA(b, h) + aoff + m * 2048 + k * 1024); } while (0)
#define PG8_LDB(dst, b, h) do { _Pragma("unroll") for (int n = 0; n < 2; ++n) _Pragma("unroll") for (int k = 0; k < 2; ++k) dst[n][k] = *(const PG8_LAS bf16x8*)(lds + PG8_SB(b, h) + boff + n * 2048 + k * 1024); } while (0)
#define PG8_MMA(ai, bj, At, Bt) do { __builtin_amdgcn_s_setprio(1); _Pragma("unroll") for (int m = 0; m < 4; ++m) _Pragma("unroll") for (int n = 0; n < 2; ++n) _Pragma("unroll") for (int k = 0; k < 2; ++k) \
        acc[ai][bj][m][n] = __builtin_amdgcn_mfma_f32_16x16x32_bf16(Bt[n][k], At[m][k], acc[ai][bj][m][n], 0, 0, 0); __builtin_amdgcn_s_setprio(0); } while (0)
#define PG8_WAIT_V(n) asm volatile("s_waitcnt vmcnt(" #n ")" ::: "memory")
#define PG8_WAIT_L(n) asm volatile("s_waitcnt lgkmcnt(" #n ")" ::: "memory")
#define PG8_BAR __builtin_amdgcn_s_barrier()
#define PG8_SCHED __builtin_amdgcn_sched_barrier(0)
    Unit cur, nxt; int ui = 0;
    if (!S.next(0, cur)) return;
    f32x4 acc[2][2][4][2];
#pragma unroll
    for (int a = 0; a < 2; ++a)
#pragma unroll
        for (int b = 0; b < 2; ++b)
#pragma unroll
            for (int m = 0; m < 4; ++m)
#pragma unroll
                for (int n = 0; n < 2; ++n) acc[a][b][m][n] = (f32x4){0.f, 0.f, 0.f, 0.f};
    bf16x8 At[4][2], B0[2][2], B1[2][2];
    const char* cA = (const char*)g.A + cur.aoff; const char* cB = (const char*)g.Bt + cur.boff;
    if constexpr (SP2) {
        PG8_STAGE(PG8_SB(0, 0), cB, voffB); PG8_STAGE(PG8_SB(0, 1), cB + hstepB, voffB); PG8_STAGE(PG8_SA(0, 0), cA, voffA); PG8_STAGE(PG8_SA(0, 1), cA + hstepA, voffA);
        if (wr == 1) PG8_BAR;
        PG8_WAIT_V(2); PG8_BAR;
        PG8_STAGE(PG8_SB(1, 0), cB + kstepB, voffB); PG8_STAGE(PG8_SA(1, 0), cA + kstep, voffA); PG8_STAGE(PG8_SB(1, 1), cB + hstepB + kstepB, voffB);
        PG8_WAIT_V(6); PG8_BAR;
    } else {
        PG8_STAGE(PG8_SB(0, 0), cB, voffB); PG8_STAGE(PG8_SA(0, 0), cA, voffA); PG8_STAGE(PG8_SB(0, 1), cB + hstepB, voffB); PG8_STAGE(PG8_SA(0, 1), cA + hstepA, voffA);
        if (wr == 1) PG8_BAR;
        PG8_WAIT_V(4); PG8_BAR;
        PG8_STAGE(PG8_SB(1, 0), cB + kstepB, voffB); PG8_STAGE(PG8_SA(1, 0), cA + kstep, voffA); PG8_STAGE(PG8_SB(1, 1), cB + hstepB + kstepB, voffB);
        PG8_WAIT_V(6); PG8_BAR;
    }
    for (;;) {
        const bool has_next = S.next(ui + 1, nxt);
        const char* nA = has_next ? (const char*)g.A + nxt.aoff : cA; const char* nB = has_next ? (const char*)g.Bt + nxt.boff : cB;
        for (int t = 0; t < nt; t += 2) {
            const bool last = (t == nt - 2);
            const char* a1 = cA + (size_t)(t + 1) * kstep;
            const char* a2 = last ? nA : cA + (size_t)(t + 2) * kstep; const char* b2 = last ? nB : cB + (size_t)(t + 2) * kstepB;
            const char* a3 = a2 + kstep; const char* b3 = b2 + kstepB;
            if constexpr (SP2) {
            PG8_LDB(B0, 0, 0); PG8_LDB(B1, 0, 1); PG8_SCHED; PG8_LDA(At, 0, 0); PG8_STAGE(PG8_SA(1, 1), a1 + hstepA, voffA);
            PG8_WAIT_V(8); PG8_WAIT_L(0); PG8_BAR; PG8_MMA(0, 0, At, B0); PG8_MMA(0, 1, At, B1); PG8_BAR; PG8_SCHED;
            PG8_LDA(At, 0, 1); PG8_STAGE(PG8_SB(0, 0), b2, voffB); PG8_STAGE(PG8_SB(0, 1), b2 + hstepB, voffB); PG8_STAGE(PG8_SA(0, 0), a2, voffA);
            PG8_WAIT_V(8); PG8_WAIT_L(0); PG8_BAR; PG8_MMA(1, 0, At, B0); PG8_MMA(1, 1, At, B1); PG8_BAR; PG8_SCHED;
            PG8_LDB(B0, 1, 0); PG8_LDB(B1, 1, 1); PG8_SCHED; PG8_LDA(At, 1, 0); PG8_STAGE(PG8_SA(0, 1), a2 + hstepA, voffA);
            PG8_WAIT_V(8); PG8_WAIT_L(0); PG8_BAR; PG8_MMA(0, 0, At, B0); PG8_MMA(0, 1, At, B1); PG8_BAR; PG8_SCHED;
            PG8_LDA(At, 1, 1); PG8_STAGE(PG8_SB(1, 0), b3, voffB); PG8_STAGE(PG8_SB(1, 1), b3 + hstepB, voffB); PG8_STAGE(PG8_SA(1, 0), a3, voffA);
            PG8_WAIT_V(8); PG8_WAIT_L(0); PG8_BAR; PG8_MMA(1, 0, At, B0); PG8_MMA(1, 1, At, B1); PG8_BAR; PG8_SCHED;
            } else {
            PG8_LDB(B0, 0, 0); PG8_SCHED; PG8_LDA(At, 0, 0); PG8_STAGE(PG8_SA(1, 1), a1 + hstepA, voffA);
            PG8_WAIT_L(8); PG8_BAR; PG8_WAIT_L(0); PG8_MMA(0, 0, At, B0); PG8_BAR; PG8_SCHED;
            PG8_LDB(B1, 0, 1); PG8_STAGE(PG8_SB(0, 0), b2, voffB);
            PG8_BAR; PG8_WAIT_L(0); PG8_MMA(0, 1, At, B1); PG8_BAR;
            PG8_LDA(At, 0, 1); PG8_STAGE(PG8_SA(0, 0), a2, voffA);
            PG8_BAR; PG8_WAIT_L(0); PG8_MMA(1, 0, At, B0); PG8_BAR; PG8_SCHED;
            PG8_STAGE(PG8_SB(0, 1), b2 + hstepB, voffB);
            PG8_WAIT_V(6); PG8_BAR; PG8_MMA(1, 1, At, B1); PG8_BAR;
            PG8_LDB(B0, 1, 0); PG8_SCHED; PG8_LDA(At, 1, 0); PG8_STAGE(PG8_SA(0, 1), a2 + hstepA, voffA);
            PG8_WAIT_L(8); PG8_BAR; PG8_WAIT_L(0); PG8_MMA(0, 0, At, B0); PG8_BAR; PG8_SCHED;
            PG8_LDB(B1, 1, 1); PG8_STAGE(PG8_SB(1, 0), b3, voffB);
            PG8_BAR; PG8_WAIT_L(0); PG8_MMA(0, 1, At, B1); PG8_BAR;
            PG8_LDA(At, 1, 1); PG8_STAGE(PG8_SA(1, 0), a3, voffA);
            PG8_BAR; PG8_WAIT_L(0); PG8_MMA(1, 0, At, B0); PG8_BAR; PG8_SCHED;
            PG8_STAGE(PG8_SB(1, 1), b3 + hstepB, voffB);
            PG8_WAIT_V(6); PG8_BAR; PG8_MMA(1, 1, At, B1); PG8_BAR;
            }
        }
        if constexpr (ALIGN_EPI) { if (wr == 0) PG8_BAR; }
        E(acc, cur, wr, wc, fr, fq);
        if (!has_next) break;
#pragma unroll
        for (int a = 0; a < 2; ++a)
#pragma unroll
            for (int b = 0; b < 2; ++b)
#pragma unroll
                for (int m = 0; m < 4; ++m)
#pragma unroll
                    for (int n = 0; n < 2; ++n) acc[a][b][m][n] = (f32x4){0.f, 0.f, 0.f, 0.f};
        cur = nxt; cA = nA; cB = nB; ++ui;
        if constexpr (ALIGN_EPI) { if (wr == 1) PG8_BAR; }
    }
    PG8_WAIT_V(0);
    if constexpr (!ALIGN_EPI) { if (wr == 0) PG8_BAR; }
    PG8_BAR;
#undef PG8_SA
#undef PG8_SB
#undef PG8_STAGE
#undef PG8_LDA
#undef PG8_LDB
#undef PG8_MMA
#undef PG8_WAIT_V
#undef PG8_WAIT_L
#undef PG8_BAR
#undef PG8_SCHED
}
}

constexpr int NWAVES = 8;
constexpr int BATCH = 8, SEQ = 4096, D = 1024, T = BATCH * SEQ;
constexpr int DFF = 2816, NE = 8, DFE = 3584, INP = 2608, INP_PAD = 2816;
constexpr int NH = 16, NG = 4, HD = 64;
constexpr float LN_EPS = 1e-5f;
constexpr float ALPHA = 1.4142135623730951f;
constexpr float QSCALE = 0.125f * 1.4426950408889634f;
constexpr int MOE_CH = 64;
constexpr int MOE_MAXT = 264;
constexpr int MOE_NCH = 5;

constexpr size_t MiB = 1u << 20;
constexpr size_t WS_CTL = 0, CTL_ZERO_BYTES = 1 * MiB;
constexpr size_t WS_ROPE = 1 * MiB;
constexpr size_t WS_MISC = 2 * MiB;
constexpr size_t WS_SEL = 3 * MiB;
constexpr size_t WS_SDST = 4 * MiB;
constexpr size_t WS_SW = 5 * MiB;
constexpr size_t WS_KVC = 6 * MiB;
constexpr size_t WS_CPART = 8 * MiB;
constexpr size_t WS_GATES = 40 * MiB;
constexpr size_t W_POOL = 48 * MiB, W_FGU = 49 * MiB, W_FDN = 60 * MiB, W_IN = 66 * MiB, W_C1 = 72 * MiB, W_OUT = 74 * MiB, W_MGU = 76 * MiB, W_MDN = 188 * MiB;
constexpr size_t WS_R0 = 256 * MiB;
constexpr size_t WS_XB = 384 * MiB;
constexpr size_t WS_BIG = 448 * MiB;
constexpr size_t WS_APOOL = WS_BIG, WS_H1 = 512 * MiB;
constexpr size_t WS_Q = WS_BIG, WS_KV6 = 512 * MiB, WS_AO = 616 * MiB;
constexpr size_t WS_XS = WS_BIG, WS_H2 = 580 * MiB, WS_Y = 692 * MiB;
constexpr size_t WS_END = 820 * MiB;
constexpr size_t KV6_STRIDE = (size_t)T * 256;
static_assert(W_MGU + (size_t)NE * 2 * DFE * D * 2 <= W_MDN && W_MDN + (size_t)NE * D * DFE * 2 <= WS_R0, "weights map");
static_assert(WS_H1 + (size_t)T * DFF * 2 <= WS_END && WS_XS + (size_t)MOE_MAXT * 256 * D * 2 <= WS_H2 && WS_H2 + (size_t)MOE_CH * 256 * DFE * 2 <= WS_Y && WS_Y + (size_t)T * 2 * D * 2 <= WS_END, "big map");
constexpr int CW_TMO = 0, CW_BAR = 4096;
constexpr int N_BAR_REGIONS = 28;

constexpr int RING_OFF = 0, RING_BYTES = 155648;
constexpr int LDSCTL_OFF = RING_BYTES, MISC_OFF = LDSCTL_OFF + 320;
constexpr int PTR_OFF = RING_BYTES + 512;
constexpr int MOET_OFF = RING_BYTES + 1024;
constexpr int LDS_BYTES = 163840;

#define GAS __attribute__((address_space(1)))
#define LAS __attribute__((address_space(3)))
typedef unsigned short bf16;
typedef unsigned v4u __attribute__((ext_vector_type(4)));
typedef unsigned v2u __attribute__((ext_vector_type(2)));
typedef float f32x4 __attribute__((ext_vector_type(4)));
typedef float f32x2 __attribute__((ext_vector_type(2)));
typedef short bf16x8 __attribute__((ext_vector_type(8)));
typedef GAS unsigned gu32;
#define RLX_AGENT __ATOMIC_RELAXED, __HIP_MEMORY_SCOPE_AGENT
#define LDS_WAIT() asm volatile("s_waitcnt lgkmcnt(0)" ::: "memory")
#define VM_WAIT() asm volatile("s_waitcnt vmcnt(0)" ::: "memory")
__device__ __forceinline__ unsigned f2bf(float f) { unsigned u = __builtin_bit_cast(unsigned, f); return (u + 0x7fffu + ((u >> 16) & 1u)) >> 16; }
__device__ __forceinline__ unsigned pk2(float lo, float hi) { return f2bf(lo) | (f2bf(hi) << 16); }
__device__ __forceinline__ float bf2f(unsigned h) { return __builtin_bit_cast(float, h << 16); }

#define XB_TMO      128
#define XB_XCNT(j)  (256  + 64 * (j))
#define XB_XSUB(j)  (1280 + 64 * (j))
#define XB_XGEN(j)  (2304 + 64 * (j))
#define XB_TOP      3328
#define XB_TOPGEN   3392
#define XCD_BAR_WORDS 3456
#define XB_SPIN_CAP (1u << 18)
__device__ __forceinline__ unsigned xb_ld(unsigned* p)              { return __hip_atomic_load(p, __ATOMIC_RELAXED, __HIP_MEMORY_SCOPE_AGENT); }
__device__ __forceinline__ unsigned xb_add(unsigned* p, unsigned v) { return __hip_atomic_fetch_add(p, v, __ATOMIC_RELAXED, __HIP_MEMORY_SCOPE_AGENT); }
__device__ __forceinline__ unsigned xb_xcc_id() { return (unsigned)__builtin_amdgcn_s_getreg((3 << 11) | 20) & 0xFu; }
#define XB_SPIN(cond, bar) do { unsigned _sp = 0; while (cond) { __builtin_amdgcn_s_sleep(1); \
    if ((++_sp & 255u) == 0u) { if (xb_ld(&(bar)[XB_TMO])) break; if (_sp > XB_SPIN_CAP) { atomicAdd(&(bar)[XB_TMO], 1u); break; } } } } while (0)
struct XcdBarrier { unsigned* bar; unsigned x; volatile LAS unsigned* st; };
__device__ __forceinline__ XcdBarrier xcd_barrier_post(unsigned* bar, volatile LAS unsigned* st) {
    XcdBarrier b; b.bar = bar; b.x = xb_xcc_id(); b.st = st;
    if (threadIdx.x == 0) (void)xb_add(&bar[XB_XCNT(b.x)], 1u);
    return b;
}
__device__ __forceinline__ void xcd_barrier_complete(unsigned* bar, unsigned x, unsigned& nloc, unsigned& nx) {
    const unsigned G = gridDim.x * gridDim.y * gridDim.z;
    unsigned sum, cnt, mine, sp = 0u;
    for (;;) {
        sum = 0u; cnt = 0u; mine = 0u;
#pragma unroll
        for (unsigned j = 0; j < 16; ++j) { const unsigned c = xb_ld(&bar[XB_XCNT(j)]); sum += c; cnt += (c > 0u) ? 1u : 0u; mine = (j == x) ? c : mine; }
        if (sum == G) break;
        __builtin_amdgcn_s_sleep(1);
        if ((++sp & 255u) == 0u) { if (xb_ld(&bar[XB_TMO])) break; if (sp > XB_SPIN_CAP) { atomicAdd(&bar[XB_TMO], 1u); break; } }
    }
    nloc = mine > 0u ? mine : 1u; nx = cnt > 0u ? cnt : 1u;
}
__device__ __forceinline__ void xcd_barrier(const XcdBarrier& b) {
    asm volatile("s_waitcnt vmcnt(0)" ::: "memory");
    __syncthreads();
    if (threadIdx.x == 0) {
        unsigned* bar = b.bar;
        __builtin_amdgcn_s_waitcnt(0);
        unsigned nloc = b.st[0], nx = b.st[1];
        if (nloc == 0u) { xcd_barrier_complete(bar, b.x, nloc, nx); b.st[0] = nloc; b.st[1] = nx; }
        const unsigned old = xb_add(&bar[XB_XSUB(b.x)], 1u);
        const unsigned gen = old / nloc;
        if (old + 1u == (gen + 1u) * nloc) {
            __builtin_amdgcn_fence(__ATOMIC_RELEASE, "agent");
            asm volatile("s_waitcnt vmcnt(0)" ::: "memory");
            const unsigned og = xb_add(&bar[XB_TOP], 1u);
            const unsigned tg = og / nx;
            if (og + 1u == (tg + 1u) * nx) xb_add(&bar[XB_TOPGEN], 1u);
            else XB_SPIN(xb_ld(&bar[XB_TOPGEN]) == tg, bar);
            __builtin_amdgcn_fence(__ATOMIC_ACQUIRE, "agent");
            xb_add(&bar[XB_XGEN(b.x)], 1u);
            asm volatile("s_waitcnt vmcnt(0)" ::: "memory");
        } else {
            XB_SPIN(xb_ld(&bar[XB_XGEN(b.x)]) == gen, bar);
            __builtin_amdgcn_fence(__ATOMIC_ACQUIRE, "agent");
            asm volatile("s_waitcnt vmcnt(0)" ::: "memory");
        }
    }
    __syncthreads();
}

struct Frame {
    LAS unsigned char* lds;
    volatile LAS unsigned* MISC;
    gu32* ctl;
    unsigned char* ws;
    int tid, lane, wave;
    int vcu, G;
    float* out;
    __device__ __forceinline__ const float* inp(int i) const {
        const unsigned long long v = ((const LAS unsigned long long*)(lds + PTR_OFF))[i];
        const unsigned lo = __builtin_amdgcn_readfirstlane((unsigned)v), hi = __builtin_amdgcn_readfirstlane((unsigned)(v >> 32));
        return (const float*)(((unsigned long long)hi << 32) | lo); }
};
enum { I_X = 0, I_LNG, I_LNB, I_POOLW, I_POOLS, I_WIN, I_PEK, I_W1K, I_W2K, I_PEV, I_W1V, I_W2V, I_WOUT, I_FGU, I_FDN, I_ROUTER, I_MGU, I_MDN };

__device__ __forceinline__ void refresh(Frame& F) { int t = threadIdx.x; asm volatile("" : "+v"(t)); F.tid = t; F.lane = t & 63; F.wave = __builtin_amdgcn_readfirstlane(t >> 6); }
__device__ __forceinline__ float wave_sum(float v) {
#pragma unroll
    for (int o = 1; o < 64; o <<= 1) v += __shfl_xor(v, o);
    return v;
}
__device__ __forceinline__ float silu_f(float x) { return x * __builtin_amdgcn_rcpf(1.0f + __builtin_amdgcn_exp2f(-1.4426950408889634f * x)); }

__device__ __forceinline__ int wrow_map(int mode, int n, int Npad) {
    if (mode == 0) return n;
    if (mode == 1) { const int half = Npad >> 1; return n < half ? ((n >> 7) << 8) + (n & 127) : (((n - half) >> 7) << 8) + 128 + ((n - half) & 127); }
    const int tile = n >> 8, o = n & 255, head = o >> 6, hf = (o >> 5) & 1, i = o & 31;
    return (tile << 8) + 128 * (head >> 1) + 32 * (2 * (head & 1) + (i >> 4)) + 16 * hf + (i & 15);
}
struct WItem { const float* W; bf16* WT; int K, Nreal, Npad, mode, perm, k0, n0; };
constexpr int W_NITEMS_POOL = 4 * 4 * 2, W_NI_FG = (D / 64) * (2 * DFF / 128), W_NI_FD = (DFF / 64) * (D / 128), W_NI_IN = (D / 64) * (INP_PAD / 128), W_NI_C1 = (2048 / 64) * (256 / 128), W_NI_WO = (D / 64) * (D / 128);
constexpr int W_NI_MG = (D / 64) * (2 * DFE / 128), W_NI_MD = (DFE / 64) * (D / 128);
constexpr int W_NITEMS = W_NITEMS_POOL + W_NI_FG + W_NI_FD + W_NI_IN + 2 * W_NI_C1 + W_NI_WO + NE * W_NI_MG + NE * W_NI_MD;
constexpr int W_MOE0 = W_NITEMS - NE * (W_NI_MG + W_NI_MD);
__device__ __forceinline__ WItem witem_decode(const Frame& F, int it) {
    WItem w; int r = it; int sub;
    unsigned char* ws = F.ws;
    if (r < W_NITEMS_POOL) { const int g = r / 8; sub = r % 8; w = WItem{F.inp(I_POOLW) + (size_t)g * 65536, (bf16*)(ws + W_POOL) + (size_t)g * 65536, 256, 256, 256, 0, 0, 0, 0}; }
    else if ((r -= W_NITEMS_POOL) < W_NI_FG) { sub = r; w = WItem{F.inp(I_FGU), (bf16*)(ws + W_FGU), D, 2 * DFF, 2 * DFF, 1, 1, 0, 0}; }
    else if ((r -= W_NI_FG) < W_NI_FD) { sub = r; w = WItem{F.inp(I_FDN), (bf16*)(ws + W_FDN), DFF, D, D, 0, 0, 0, 0}; }
    else if ((r -= W_NI_FD) < W_NI_IN) { sub = r; w = WItem{F.inp(I_WIN), (bf16*)(ws + W_IN), D, INP, INP_PAD, 2, 0, 0, 0}; }
    else if ((r -= W_NI_IN) < 2 * W_NI_C1) { const int kv = r / W_NI_C1; sub = r % W_NI_C1; w = WItem{F.inp(kv ? I_W1V : I_W1K), (bf16*)(ws + W_C1) + (size_t)kv * 256 * 2048, 2048, 128, 256, 0, 0, 0, 0}; }
    else if ((r -= 2 * W_NI_C1) < W_NI_WO) { sub = r; w = WItem{F.inp(I_WOUT), (bf16*)(ws + W_OUT), D, D, D, 0, 0, 0, 0}; }
    else if ((r -= W_NI_WO) < NE * W_NI_MG) { const int e = r / W_NI_MG; sub = r % W_NI_MG; w = WItem{F.inp(I_MGU) + (size_t)e * D * 2 * DFE, (bf16*)(ws + W_MGU) + (size_t)e * 2 * DFE * D, D, 2 * DFE, 2 * DFE, 1, 1, 0, 0}; }
    else { r -= NE * W_NI_MG; const int e = r / W_NI_MD; sub = r % W_NI_MD; w = WItem{F.inp(I_MDN) + (size_t)e * DFE * D, (bf16*)(ws + W_MDN) + (size_t)e * D * DFE, DFE, D, D, 0, 1, 0, 0}; }
    const int nblk = w.Npad / 128; w.k0 = 64 * (sub / nblk); w.n0 = 128 * (sub % nblk);
    return w;
}
constexpr int W_SCR = 32 * 130 * 4;
__device__ __forceinline__ void witem_load(const WItem& w, int lane, f32x4 (&ld)[32]) {
    const int nn = w.n0 + 4 * (lane & 31); const bool ok = nn < w.Nreal;
    const float* base = w.W + (size_t)(w.k0 + 2 * (lane >> 5)) * w.Nreal + nn;
#pragma unroll
    for (int j = 0; j < 32; ++j) { const int kk = 4 * (j >> 1) + (j & 1); ld[j] = ok ? *(const GAS f32x4*)(base + (size_t)kk * w.Nreal) : (f32x4){0.f, 0.f, 0.f, 0.f}; }
}
__device__ __forceinline__ void witem_store(const WItem& w, int lane, const f32x4 (&ld)[32], LAS unsigned* scr) {
#pragma unroll
    for (int m = 0; m < 16; ++m) { const f32x4 a = ld[2 * m], b = ld[2 * m + 1]; LAS unsigned* d = scr + (2 * m + (lane >> 5)) * 130 + 4 * (lane & 31);
        *(LAS v2u*)d = (v2u){pg8::cvt_pk_bf16(a[0], b[0]), pg8::cvt_pk_bf16(a[1], b[1])}; *(LAS v2u*)(d + 2) = (v2u){pg8::cvt_pk_bf16(a[2], b[2]), pg8::cvt_pk_bf16(a[3], b[3])}; }
    LDS_WAIT(); asm volatile("" ::: "memory");
    const int c = lane & 7; const size_t kblk = (size_t)(w.k0 >> 6) * 32768; const size_t panel = (size_t)w.K * 512;
#pragma unroll
    for (int j = 0; j < 16; ++j) { const int n = (lane >> 3) + 8 * j; const LAS unsigned* s = scr + (4 * c) * 130 + n;
        const v4u o = (v4u){s[0], s[130], s[260], s[390]};
        const int p = wrow_map(w.mode, w.n0 + n, w.Npad), r128 = p & 127, x = r128 & 31;
        const int R = w.perm ? ((r128 & ~31) + 16 * ((x >> 2) & 1) + 4 * (x >> 3) + (x & 3)) : r128;
        *(GAS v4u*)((unsigned char*)w.WT + (size_t)(p >> 8) * panel + kblk + ((p >> 7) & 1) * 16384 + pg8::lds_byte(R, 8 * c)) = o; }
    LDS_WAIT(); asm volatile("" ::: "memory");
}

template <int W> __device__ __forceinline__ void pool_unit_compute(Frame& F, const LAS f32x4* tile, bf16* AP, int t0, int s0, int halo, int g) {
#pragma unroll 2
    for (int k = 0; k < 8; ++k) { const int o = F.tid + k * 512, r = o >> 6, c4 = o & 63, s = s0 + r;
        const int cnt = (s + 1) < W ? (s + 1) : W; const LAS f32x4* col = tile + c4; const int top = halo + r;
        f32x4 sum = (f32x4){0.f, 0.f, 0.f, 0.f};
#pragma unroll
        for (int j = 0; j < W; ++j) { const int rr = (j < cnt) ? top - j : top; const f32x4 v = col[rr * 64]; if (j < cnt) sum += v; }
        const f32x4 cur = col[top * 64]; const float fc = (float)cnt;
        const f32x4 v = (f32x4){sum.x / fc, sum.y / fc, sum.z / fc, sum.w / fc} - cur;
        v2u pk; pk.x = pk2(v.x, v.y); pk.y = pk2(v.z, v.w);
        *(GAS v2u*)(AP + (size_t)(t0 + r) * D + g * 256 + c4 * 4) = pk; }
}
__device__ __forceinline__ void p0_pool_operand(Frame& F) {
    const float* x = F.inp(I_X); bf16* AP = (bf16*)(F.ws + WS_APOOL);
    LAS f32x4* tile = (LAS f32x4*)(F.lds + RING_OFF);
    for (int unit = F.vcu; unit < (T / 64) * 4; unit += F.G) {
        const int rb = unit >> 2, g = unit & 3, w = 2 << g, t0 = rb * 64, s0 = t0 & (SEQ - 1);
        const int halo = (w - 1) < s0 ? (w - 1) : s0; const int total = (64 + halo) * 64;
        f32x4 ld[10];
#pragma unroll
        for (int k = 0; k < 10; ++k) { const int idx = F.tid + k * 512; const int row = idx >> 6, c4 = idx & 63;
            ld[k] = (idx < total) ? *(const GAS f32x4*)(x + (size_t)(t0 - halo + row) * D + g * 256 + c4 * 4) : (f32x4){0.f, 0.f, 0.f, 0.f}; }
        __syncthreads();
#pragma unroll
        for (int k = 0; k < 10; ++k) { const int idx = F.tid + k * 512; if (idx < total) tile[idx] = ld[k]; }
        __syncthreads();
        if (g == 0) pool_unit_compute<2>(F, tile, AP, t0, s0, halo, g); else if (g == 1) pool_unit_compute<4>(F, tile, AP, t0, s0, halo, g);
        else if (g == 2) pool_unit_compute<8>(F, tile, AP, t0, s0, halo, g); else pool_unit_compute<16>(F, tile, AP, t0, s0, halo, g);
    }
    __syncthreads();
}

__device__ __forceinline__ void p0_prologue(Frame& F) {
    const int gw = F.vcu * NWAVES + F.wave, NGW = F.G * NWAVES;
    { float* rc = (float*)(F.ws + WS_ROPE); float* rs = rc + SEQ * 32;
      for (int idx = F.vcu * 512 + F.tid; idx < SEQ * 32; idx += F.G * 512) { const int pos = idx >> 5, i = idx & 31;
          const float fr = powf(10000.0f, -(float)i / 32.0f);
          const double ang = (double)((float)pos * fr);
          const double k = __builtin_rint(ang * 0.15915494309189535); const double r = ang - k * 6.283185307179586476925287, r2 = r * r;
          double sn = 1.0, cs = 1.0;
#pragma unroll
          for (int q = 12; q >= 1; --q) { sn = 1.0 - r2 * (1.0 / (double)((2 * q) * (2 * q + 1))) * sn; cs = 1.0 - r2 * (1.0 / (double)((2 * q - 1) * (2 * q))) * cs; }
          rc[idx] = (float)cs; rs[idx] = (float)(r * sn); } }
    if (F.vcu < 256) { const int kv = F.vcu >> 7, cc = F.vcu & 127; const float* pe = F.inp(kv == 0 ? I_PEK : I_PEV); const float* w1 = F.inp(kv == 0 ? I_W1K : I_W1V);
        LAS float* red = (LAS float*)(F.lds + RING_OFF + 98304);
        float s = 0.f;
#pragma unroll
        for (int q = 0; q < 4; ++q) { const int r = F.tid + 512 * q; s += pe[r] * w1[(size_t)r * 128 + cc]; }
        s = wave_sum(s); if (F.lane == 0) red[F.wave] = s; __syncthreads();
        if (F.tid == 0) ((float*)(F.ws + WS_MISC))[kv * 128 + cc] = ((red[0] + red[1]) + (red[2] + red[3])) + ((red[4] + red[5]) + (red[6] + red[7]));
        __syncthreads(); }
    p0_pool_operand(F);
    LAS unsigned* scr = (LAS unsigned*)(F.lds + RING_OFF + F.wave * W_SCR);
    for (int it = gw; it < W_MOE0; it += NGW) { const WItem w = witem_decode(F, it); f32x4 la[32]; witem_load(w, F.lane, la); witem_store(w, F.lane, la, scr); }
}

__device__ __forceinline__ void ln_phase(Frame& F, const float* src, const float* gam, const float* bet, float* dstf, bf16* dstb) {
    const int gw = F.vcu * NWAVES + F.wave, NGW = F.G * NWAVES;
    f32x4 gv[4], bv[4];
#pragma unroll
    for (int j = 0; j < 4; ++j) { gv[j] = *((const GAS f32x4*)gam + F.lane + 64 * j); bv[j] = *((const GAS f32x4*)bet + F.lane + 64 * j); }
    for (int m = gw; m < T; m += NGW) {
        const GAS f32x4* xr = (const GAS f32x4*)(src + (size_t)m * D) + F.lane;
        f32x4 v[4]; float s = 0.f;
#pragma unroll
        for (int j = 0; j < 4; ++j) { v[j] = xr[64 * j]; s += (v[j].x + v[j].y) + (v[j].z + v[j].w); }
        const float mean = wave_sum(s) * (1.f / D); float s2 = 0.f;
#pragma unroll
        for (int j = 0; j < 4; ++j) { v[j] = v[j] - mean; s2 += (v[j].x * v[j].x + v[j].y * v[j].y) + (v[j].z * v[j].z + v[j].w * v[j].w); }
        const float rstd = 1.f / sqrtf(wave_sum(s2) * (1.f / D) + LN_EPS);
        GAS f32x4* of = (GAS f32x4*)(dstf + (size_t)m * D) + F.lane;
#pragma unroll
        for (int j = 0; j < 4; ++j) { v[j] = v[j] * rstd * gv[j] + bv[j]; of[64 * j] = v[j]; }
        if (dstb) { GAS v2u* ob = (GAS v2u*)(dstb + (size_t)m * D) + F.lane;
#pragma unroll
            for (int j = 0; j < 4; ++j) { v2u pk; pk.x = pk2(v[j].x, v[j].y); pk.y = pk2(v[j].z, v[j].w); ob[64 * j] = pk; } }
    }
}

__device__ __forceinline__ void ln_router_phase(Frame& F, float* R0, const float* gam, const float* bet, bf16* dstb) {
    LAS float* rt = (LAS float*)(F.lds + RING_OFF);
    LAS unsigned* cnt = (LAS unsigned*)(F.lds + RING_OFF + 32768);
    const float* router = F.inp(I_ROUTER);
    for (int idx = F.tid; idx < 8192; idx += 512) { const int c = idx >> 3, e = idx & 7; rt[e * 1024 + c] = router[idx]; }
    if (F.tid < 8) cnt[F.tid] = 0u;
    __syncthreads();
    f32x4 gv[4], bv[4];
#pragma unroll
    for (int j = 0; j < 4; ++j) { gv[j] = *((const GAS f32x4*)gam + F.lane + 64 * j); bv[j] = *((const GAS f32x4*)bet + F.lane + 64 * j); }
    int* sel = (int*)(F.ws + WS_SEL);
    for (int k = 0; k < 16; ++k) {
        const int m = F.vcu * 128 + F.wave * 16 + k;
        const GAS f32x4* xr = (const GAS f32x4*)(R0 + (size_t)m * D) + F.lane;
        f32x4 v[4]; float s = 0.f;
#pragma unroll
        for (int j = 0; j < 4; ++j) { v[j] = xr[64 * j]; s += (v[j].x + v[j].y) + (v[j].z + v[j].w); }
        const float mean = wave_sum(s) * (1.f / D); float s2 = 0.f;
#pragma unroll
        for (int j = 0; j < 4; ++j) { v[j] = v[j] - mean; s2 += (v[j].x * v[j].x + v[j].y * v[j].y) + (v[j].z * v[j].z + v[j].w * v[j].w); }
        const float rstd = 1.f / sqrtf(wave_sum(s2) * (1.f / D) + LN_EPS);
        GAS f32x4* of = (GAS f32x4*)(R0 + (size_t)m * D) + F.lane;
        GAS v2u* ob = (GAS v2u*)(dstb + (size_t)m * D) + F.lane;
#pragma unroll
        for (int j = 0; j < 4; ++j) { v[j] = v[j] * rstd * gv[j] + bv[j]; of[64 * j] = v[j]; v2u pk; pk.x = pk2(v[j].x, v[j].y); pk.y = pk2(v[j].z, v[j].w); ob[64 * j] = pk; }
        float lg[8];
#pragma unroll
        for (int e = 0; e < 8; ++e) { float a = 0.f;
#pragma unroll
            for (int j = 0; j < 4; ++j) { const f32x4 r4 = *((const LAS f32x4*)(rt + e * 1024) + F.lane + 64 * j); a += (v[j].x * r4.x + v[j].y * r4.y) + (v[j].z * r4.z + v[j].w * r4.w); }
            lg[e] = wave_sum(a); }
        int i0 = 0; float v0 = lg[0];
#pragma unroll
        for (int e = 1; e < 8; ++e) if (lg[e] > v0) { v0 = lg[e]; i0 = e; }
        int i1 = -1; float v1 = -3.0e38f;
#pragma unroll
        for (int e = 0; e < 8; ++e) if (e != i0 && lg[e] > v1) { v1 = lg[e]; i1 = e; }
        const float ex = __expf(v1 - v0), w0 = 1.0f / (1.0f + ex), w1 = ex * w0;
        if (F.lane == 0) { *(GAS v4u*)(sel + (size_t)m * 4) = (v4u){(unsigned)i0, (unsigned)i1, __builtin_bit_cast(unsigned, w0), __builtin_bit_cast(unsigned, w1)};
            __hip_atomic_fetch_add(cnt + i0, 1u, __ATOMIC_RELAXED, __HIP_MEMORY_SCOPE_WORKGROUP); __hip_atomic_fetch_add(cnt + i1, 1u, __ATOMIC_RELAXED, __HIP_MEMORY_SCOPE_WORKGROUP); }
    }
    __syncthreads();
    if (F.tid < 8) ((unsigned*)(F.ws + WS_MISC + 4096))[F.vcu * 8 + F.tid] = cnt[F.tid];
}

__device__ __forceinline__ void moe_tables(Frame& F) {
    LAS int* cw = (LAS int*)(F.lds + RING_OFF + 65536);
    LAS int* mt = (LAS int*)(F.lds + MOET_OFF);
    const int* cg = (const int*)(F.ws + WS_MISC + 4096);
    __syncthreads();
    for (int idx = F.tid; idx < 2048; idx += 512) cw[idx] = __hip_atomic_load(cg + idx, RLX_AGENT);
    __syncthreads();
    { const int e = F.wave; int a[4]; int s = 0;
#pragma unroll
      for (int k = 0; k < 4; ++k) { a[k] = cw[(4 * F.lane + k) * 8 + e]; s += a[k]; }
      int inc = s;
#pragma unroll
      for (int o = 1; o < 64; o <<= 1) { const int y = __shfl_up(inc, o); if (F.lane >= o) inc += y; }
      if (F.lane == 63) mt[e] = inc;
      if (F.lane == (F.vcu >> 2)) { const int q = F.vcu & 3; mt[16 + e] = inc - s + (q > 0 ? a[0] : 0) + (q > 1 ? a[1] : 0) + (q > 2 ? a[2] : 0); } }
    __syncthreads();
    if (F.tid == 0) { int row = 0, tile = 0;
        for (int e = 0; e < 8; ++e) { mt[8 + e] = row; const int nt = (mt[e] + 255) >> 8; for (int i = 0; i < nt; ++i) mt[32 + tile + i] = e; tile += nt; row += nt << 8; }
        mt[24] = tile; }
    __syncthreads();
}

__device__ __forceinline__ void moe_dispatch_phase(Frame& F) {
    moe_tables(F);
    LAS int* mt = (LAS int*)(F.lds + MOET_OFF);
    LAS int* wcnt = (LAS int*)(F.lds + RING_OFF);
    LAS int* plist = (LAS int*)(F.lds + RING_OFF + 1024);
    const int* sel = (const int*)(F.ws + WS_SEL);
    int* sdst = (int*)(F.ws + WS_SDST); float* sw = (float*)(F.ws + WS_SW);
    const bf16* XB = (const bf16*)(F.ws + WS_XB); bf16* XS = (bf16*)(F.ws + WS_XS);
    int e = -1, rank = 0, t = 0, kk = 0; float wgt = 0.f;
    if (F.tid < 256) { const int tl = F.tid >> 1; kk = F.tid & 1; t = F.vcu * 128 + tl; e = sel[(size_t)t * 4 + kk]; wgt = __builtin_bit_cast(float, sel[(size_t)t * 4 + 2 + kk]);
#pragma unroll
        for (int ee = 0; ee < 8; ++ee) { const unsigned long long mk = __ballot(e == ee); if (e == ee) rank = __popcll(mk & ((1ull << F.lane) - 1ull)); if (F.lane == 0) wcnt[F.wave * 8 + ee] = __popcll(mk); } }
    __syncthreads();
    if (F.tid < 256) { int pre = 0; for (int w = 0; w < F.wave; ++w) pre += wcnt[w * 8 + e];
        const int pos = mt[8 + e] + mt[16 + e] + pre + rank;
        sdst[pos] = t * 2 + kk; sw[pos] = wgt; plist[F.tid] = pos; plist[256 + F.tid] = t; }
    __syncthreads();
    for (int q = F.wave * 32; q < F.wave * 32 + 32; ++q) { const int pos = plist[q], tt = plist[256 + q];
        const GAS v4u* s = (const GAS v4u*)(XB + (size_t)tt * D) + F.lane; GAS v4u* d = (GAS v4u*)(XS + (size_t)pos * D) + F.lane;
        const v4u a = s[0], b = s[64]; d[0] = a; d[64] = b; }
    if (F.vcu < 8) { const int ee = F.vcu, lo = mt[8 + ee] + mt[ee], hi = mt[8 + ee] + (((mt[ee] + 255) >> 8) << 8);
        for (int r = lo + F.wave; r < hi; r += NWAVES) { GAS v4u* d = (GAS v4u*)(XS + (size_t)r * D) + F.lane; d[0] = (v4u){0u, 0u, 0u, 0u}; d[64] = (v4u){0u, 0u, 0u, 0u}; if (F.lane == 0) { sdst[r] = -1; sw[r] = 0.f; } } }
}

__device__ __forceinline__ void final_phase(Frame& F, const float* R0, const float* gam, const float* bet, float* out) {
    const int gw = F.vcu * NWAVES + F.wave, NGW = F.G * NWAVES;
    const bf16* Y = (const bf16*)(F.ws + WS_Y);
    f32x4 gv[4], bv[4];
#pragma unroll
    for (int j = 0; j < 4; ++j) { gv[j] = *((const GAS f32x4*)gam + F.lane + 64 * j); bv[j] = *((const GAS f32x4*)bet + F.lane + 64 * j); }
    for (int m = gw; m < T; m += NGW) {
        const GAS f32x4* xr = (const GAS f32x4*)(R0 + (size_t)m * D) + F.lane;
        const GAS v2u* y0 = (const GAS v2u*)(Y + (size_t)m * 2 * D) + F.lane; const GAS v2u* y1 = y0 + 256;
        f32x4 v[4]; float s = 0.f;
#pragma unroll
        for (int j = 0; j < 4; ++j) { const v2u a = y0[64 * j], b = y1[64 * j]; v[j] = xr[64 * j] * ALPHA;
            v[j].x += bf2f(a.x & 0xffffu) + bf2f(b.x & 0xffffu); v[j].y += bf2f(a.x >> 16) + bf2f(b.x >> 16); v[j].z += bf2f(a.y & 0xffffu) + bf2f(b.y & 0xffffu); v[j].w += bf2f(a.y >> 16) + bf2f(b.y >> 16);
            s += (v[j].x + v[j].y) + (v[j].z + v[j].w); }
        const float mean = wave_sum(s) * (1.f / D); float s2 = 0.f;
#pragma unroll
        for (int j = 0; j < 4; ++j) { v[j] = v[j] - mean; s2 += (v[j].x * v[j].x + v[j].y * v[j].y) + (v[j].z * v[j].z + v[j].w * v[j].w); }
        const float rstd = 1.f / sqrtf(wave_sum(s2) * (1.f / D) + LN_EPS);
        GAS f32x4* of = (GAS f32x4*)(out + (size_t)m * D) + F.lane;
#pragma unroll
        for (int j = 0; j < 4; ++j) of[64 * j] = v[j] * rstd * gv[j] + bv[j];
    }
}

__device__ __forceinline__ void moe_rem_combine(Frame& F, int tile0, int nM) {
    const int gw = F.vcu * NWAVES + F.wave, NGW = F.G * NWAVES;
    const float* part = (const float*)(F.ws + WS_XB); const int* sdst = (const int*)(F.ws + WS_SDST); const float* sw = (const float*)(F.ws + WS_SW); bf16* Y = (bf16*)(F.ws + WS_Y);
    for (int r = gw; r < nM * 256; r += NGW) { const int sr = tile0 * 256 + r; const int d = sdst[sr]; if (d < 0) continue; const float w = sw[sr];
        f32x4 a[4];
#pragma unroll
        for (int j = 0; j < 4; ++j) a[j] = (f32x4){0.f, 0.f, 0.f, 0.f};
#pragma unroll
        for (int ks = 0; ks < 7; ++ks) { const GAS f32x4* p = (const GAS f32x4*)(part + ((size_t)ks * 1792 + r) * D) + F.lane;
#pragma unroll
            for (int j = 0; j < 4; ++j) a[j] += p[64 * j]; }
        GAS v2u* o = (GAS v2u*)(Y + (size_t)d * D) + F.lane;
#pragma unroll
        for (int j = 0; j < 4; ++j) { v2u pk; pk.x = pk2(a[j].x * w, a[j].y * w); pk.y = pk2(a[j].z * w, a[j].w * w); o[64 * j] = pk; } }
}

namespace ep {
using pg8::f32x4; using pg8::Unit; using pg8::u32x4; using pg8::u32x2; using pg8::cvt_pk_bf16;
constexpr int HALF = 128;

struct DenseOrder { int nM, nN, G, c; size_t astep, bstep;
    __device__ __forceinline__ bool next(int i, Unit& u) const { const long L = (long)i * G + c; if (L >= (long)nM * nN) return false;
        pg8::order_tile((int)L, nM, nN, u.pm, u.pn); u.aoff = (size_t)u.pm * astep; u.boff = (size_t)u.pn * bstep; return true; } };
struct PoolOrder { int G, c;
    __device__ __forceinline__ bool next(int i, Unit& u) const { const long L = (long)i * G + c; if (L >= (T / 256) * 4) return false;
        pg8::order_tile((int)L, T / 256, 4, u.pm, u.pn); u.aoff = (size_t)u.pm * 256 * D * 2 + (size_t)u.pn * 512; u.boff = (size_t)u.pn * 256 * 256 * 2; return true; } };
struct CmpOrder { int G, c;
    __device__ __forceinline__ bool next(int i, Unit& u) const { const long L = (long)i * G + c; if (L >= 256) return false;
        const int kv = (int)L >> 7, bg = ((int)L >> 2) & 31, kq = (int)L & 3; u.pm = bg; u.pn = kv * 4 + kq;
        u.aoff = ((size_t)kv * KV6_STRIDE + (size_t)bg * SEQ * 64 + (size_t)kq * 512) * 2; u.boff = (size_t)kv * 256 * 2048 * 2 + (size_t)kq * 8 * 32768; return true; } };
template <int NN> struct MoeOrder { int nM, G, c, tile0; const LAS int* tile_e; size_t a_tile, b_exp, b_tile; bool a_local;
    __device__ __forceinline__ bool next(int i, Unit& u) const { const int L = i * G + c; if (L >= nM * NN) return false;
        const int pml = L / NN; u.pn = L % NN; u.pm = tile0 + pml; const int e = __builtin_amdgcn_readfirstlane(tile_e[u.pm]);
        u.aoff = (size_t)(a_local ? pml : u.pm) * a_tile; u.boff = (size_t)e * b_exp + (size_t)u.pn * b_tile; return true; } };

struct RemOrder { int nM, G, c, tile0; const LAS int* tile_e; size_t b_exp;
    __device__ __forceinline__ bool next(int i, Unit& u) const { const int L = i * G + c; if (L >= nM * 28) return false;
        const int pn4 = L & 3, r = (L >> 2) % nM, ks = (L >> 2) / nM; u.pm = r; u.pn = ks * 4 + pn4; const int e = __builtin_amdgcn_readfirstlane(tile_e[tile0 + r]);
        u.aoff = (size_t)r * 256 * DFE * 2 + (size_t)ks * 512 * 2; u.boff = (size_t)e * b_exp + (size_t)pn4 * 256 * DFE * 2 + (size_t)ks * 8 * 32768; return true; } };
struct EpiRemPart { static constexpr bool PERM = true; float* part;
    __device__ __forceinline__ void operator()(const f32x4 (&acc)[2][2][4][2], const Unit& u, int wr, int wc, int fr, int fq) const {
        const int ks = u.pn >> 2, col0 = (u.pn & 3) * 256 + wc * 32 + 8 * fq;
#pragma unroll
        for (int ai = 0; ai < 2; ++ai)
#pragma unroll
            for (int m = 0; m < 4; ++m) { float* rowp = part + ((size_t)ks * 1792 + u.pm * 256 + ai * HALF + wr * 64 + m * 16 + fr) * D + col0;
#pragma unroll
                for (int bj = 0; bj < 2; ++bj)
#pragma unroll
                    for (int n = 0; n < 2; ++n) *(f32x4*)(rowp + bj * HALF + n * 4) = acc[ai][bj][m][n]; }
    } };

struct EpiPool { static constexpr bool PERM = false; const float* x; const float* scale; float* out;
    __device__ __forceinline__ void operator()(const f32x4 (&acc)[2][2][4][2], const Unit& u, int wr, int wc, int fr, int fq) const {
        const int col0 = u.pn * 256 + wc * 32 + 4 * fq;
#pragma unroll
        for (int bj = 0; bj < 2; ++bj)
#pragma unroll
            for (int n = 0; n < 2; ++n) { const f32x4 sc = *(const f32x4*)(scale + col0 + bj * HALF + n * 16);
#pragma unroll
                for (int ai = 0; ai < 2; ++ai) {
#pragma unroll
                    for (int m = 0; m < 4; ++m) { const size_t off = (size_t)(u.pm * 256 + ai * HALF + wr * 64 + m * 16 + fr) * D + col0 + bj * HALF + n * 16;
                        const f32x4 xv = *(const f32x4*)(x + off); *(f32x4*)(out + off) = xv * ALPHA + acc[ai][bj][m][n] * sc; }
                    asm volatile("" ::: "memory"); } }
    } };
struct EpiResid { static constexpr bool PERM = false; float* R;
    __device__ __forceinline__ void operator()(const f32x4 (&acc)[2][2][4][2], const Unit& u, int wr, int wc, int fr, int fq) const {
        const int col0 = u.pn * 256 + wc * 32 + 4 * fq;
#pragma unroll
        for (int ai = 0; ai < 2; ++ai)
#pragma unroll
            for (int m = 0; m < 4; ++m) { const size_t off = (size_t)(u.pm * 256 + ai * HALF + wr * 64 + m * 16 + fr) * D + col0;
#pragma unroll
                for (int bj = 0; bj < 2; ++bj)
#pragma unroll
                    for (int n = 0; n < 2; ++n) { float* p = R + off + bj * HALF + n * 16; const f32x4 xv = *(const f32x4*)p; *(f32x4*)p = xv * ALPHA + acc[ai][bj][m][n]; }
                if (m & 1) asm volatile("" ::: "memory"); }
    } };
struct EpiSwiGLU { static constexpr bool PERM = true; bf16* O; int ldc; int pm0;
    __device__ __forceinline__ void operator()(const f32x4 (&acc)[2][2][4][2], const Unit& u, int wr, int wc, int fr, int fq) const {
        const int col0 = u.pn * 128 + wc * 32 + 8 * fq;
#pragma unroll
        for (int ai = 0; ai < 2; ++ai)
#pragma unroll
            for (int m = 0; m < 4; ++m) { bf16* rowp = O + (size_t)((u.pm - pm0) * 256 + ai * HALF + wr * 64 + m * 16 + fr) * ldc + col0;
                const f32x4 g0 = acc[ai][0][m][0], g1 = acc[ai][0][m][1], u0 = acc[ai][1][m][0], u1 = acc[ai][1][m][1];
                u32x4 w; w.x = cvt_pk_bf16(silu_f(g0[0]) * u0[0], silu_f(g0[1]) * u0[1]); w.y = cvt_pk_bf16(silu_f(g0[2]) * u0[2], silu_f(g0[3]) * u0[3]);
                w.z = cvt_pk_bf16(silu_f(g1[0]) * u1[0], silu_f(g1[1]) * u1[1]); w.w = cvt_pk_bf16(silu_f(g1[2]) * u1[2], silu_f(g1[3]) * u1[3]);
                *(u32x4*)rowp = w; }
    } };
struct EpiMoeDown { static constexpr bool PERM = true; bf16* Y; const int* sdst; const float* sw;
    __device__ __forceinline__ void operator()(const f32x4 (&acc)[2][2][4][2], const Unit& u, int wr, int wc, int fr, int fq) const {
        const int col0 = u.pn * 256 + wc * 32 + 8 * fq;
#pragma unroll
        for (int ai = 0; ai < 2; ++ai)
#pragma unroll
            for (int m = 0; m < 4; ++m) { const int sr = u.pm * 256 + ai * HALF + wr * 64 + m * 16 + fr; const int d = sdst[sr]; const float w = sw[sr];
                if (d >= 0) { bf16* rowp = Y + (size_t)d * D + col0;
#pragma unroll
                    for (int bj = 0; bj < 2; ++bj) { const f32x4 v0 = acc[ai][bj][m][0] * w, v1 = acc[ai][bj][m][1] * w;
                        u32x4 o; o.x = cvt_pk_bf16(v0[0], v0[1]); o.y = cvt_pk_bf16(v0[2], v0[3]); o.z = cvt_pk_bf16(v1[0], v1[1]); o.w = cvt_pk_bf16(v1[2], v1[3]);
                        *(u32x4*)(rowp + bj * HALF) = o; } } }
    } };
struct EpiCPart { static constexpr bool PERM = false; float* part;
    __device__ __forceinline__ void operator()(const f32x4 (&acc)[2][2][4][2], const Unit& u, int wr, int wc, int fr, int fq) const {
        const int col0 = wc * 32 + 4 * fq;
#pragma unroll
        for (int ai = 0; ai < 2; ++ai)
#pragma unroll
            for (int m = 0; m < 4; ++m) { float* rowp = part + ((size_t)u.pn * 8192 + u.pm * 256 + ai * HALF + wr * 64 + m * 16 + fr) * 128 + col0;
#pragma unroll
                for (int n = 0; n < 2; ++n) *(f32x4*)(rowp + n * 16) = acc[ai][0][m][n]; }
    } };
struct EpiInProj { static constexpr bool PERM = false; bf16* Q; bf16* KV6; float* gates; const float* rc; const float* rs;
    __device__ __forceinline__ void operator()(const f32x4 (&acc)[2][2][4][2], const Unit& u, int wr, int wc, int fr, int fq) const {
        const int pn = u.pn, i0 = 16 * (wc & 1) + 4 * fq;
        const bool rope = (pn < 4) || pn == 6 || pn == 8;
#pragma unroll
        for (int ai = 0; ai < 2; ++ai)
#pragma unroll
            for (int m = 0; m < 4; ++m) { const int row = u.pm * 256 + ai * HALF + wr * 64 + m * 16 + fr, pos = row & (SEQ - 1), bb = row >> 12;
                f32x4 cs = (f32x4){1.f, 1.f, 1.f, 1.f}, sn = (f32x4){0.f, 0.f, 0.f, 0.f};
                if (rope) { cs = *(const f32x4*)(rc + pos * 32 + i0); sn = *(const f32x4*)(rs + pos * 32 + i0); }
#pragma unroll
                for (int bj = 0; bj < 2; ++bj) { const int head = 2 * bj + (wc >> 1); const f32x4 x1 = acc[ai][bj][m][0], x2 = acc[ai][bj][m][1];
                    if (pn == 10) { if (head == 0) { float* gp = gates + (size_t)row * 48 + i0;
                            f32x4 s1; for (int j = 0; j < 4; ++j) s1[j] = 1.0f / (1.0f + __expf(-x1[j])); *(f32x4*)gp = s1;
                            if (i0 < 16) { f32x4 s2; for (int j = 0; j < 4; ++j) s2[j] = 1.0f / (1.0f + __expf(-x2[j])); *(f32x4*)(gp + 32) = s2; } } }
                    else { f32x4 o1 = x1 * cs - x2 * sn, o2 = x1 * sn + x2 * cs; bf16* dst;
                        if (pn < 4) { o1 = o1 * QSCALE; o2 = o2 * QSCALE; dst = Q + (size_t)row * D + (4 * pn + head) * 64 + i0; }
                        else if (pn < 6) dst = KV6 + (size_t)(pn - 4) * KV6_STRIDE + ((size_t)(bb * 4 + head) * SEQ + pos) * 64 + i0;
                        else { const int r = pos & 63;
                            const int sw = (pn & 1) ? ((r >> 4) * 512 + (r & 15) * 32 + i0) : ((i0 >> 3) * 512 + r * 8 + (i0 & 7));
                            dst = KV6 + (size_t)(pn - 4) * KV6_STRIDE + ((size_t)(bb * 4 + head) * SEQ + (pos & ~63)) * 64 + sw; }
                        u32x2 a, b; a.x = cvt_pk_bf16(o1[0], o1[1]); a.y = cvt_pk_bf16(o1[2], o1[3]); b.x = cvt_pk_bf16(o2[0], o2[1]); b.y = cvt_pk_bf16(o2[2], o2[3]);
                        *(u32x2*)dst = a; *(u32x2*)(dst + (pn >= 6 && pn < 10 ? 2048 : 32)) = b; } } }
    } };
}

__device__ __forceinline__ void compress_finish_phase(Frame& F) {
    LAS float* w2s = (LAS float*)(F.lds + RING_OFF);
    for (int idx = F.tid; idx < 2 * 8192; idx += 512) w2s[idx] = F.inp(idx < 8192 ? I_W2K : I_W2V)[idx & 8191];
    __syncthreads();
    const float* part = (const float*)(F.ws + WS_CPART); const float* cb = (const float*)(F.ws + WS_MISC);
    const float* rc = (const float*)(F.ws + WS_ROPE); const float* rs = rc + SEQ * 32;
    bf16* kvc = (bf16*)(F.ws + WS_KVC);
    const int gw = F.vcu * NWAVES + F.wave, NGW = F.G * NWAVES;
    for (int row = gw; row < 2 * 32 * 256; row += NGW) {
        const int kv = row >> 13, r = row & 8191, n = r & 255;
        const int r6 = n & 63; bf16* dst = kvc + (size_t)(row & ~63) * 64 + (kv == 0 ? (F.lane >> 3) * 512 + r6 * 8 + (F.lane & 7) : ((F.lane >> 5) * 4 + (r6 >> 4)) * 512 + (r6 & 15) * 32 + (F.lane & 31));
        if (n == 255) { *dst = 0; continue; }
        float h0 = cb[kv * 128 + F.lane], h1 = cb[kv * 128 + 64 + F.lane];
#pragma unroll
        for (int q = 0; q < 4; ++q) { const float* p = part + ((size_t)(kv * 4 + q) * 8192 + r) * 128; h0 += p[F.lane]; h1 += p[64 + F.lane]; }
        h0 = silu_f(h0); h1 = silu_f(h1);
        const LAS float* w2 = w2s + kv * 8192 + F.lane; float o = 0.f;
#pragma unroll
        for (int c = 0; c < 64; ++c) o += __builtin_bit_cast(float, __builtin_amdgcn_readlane(__builtin_bit_cast(int, h0), c)) * w2[c * 64];
#pragma unroll
        for (int c = 0; c < 64; ++c) o += __builtin_bit_cast(float, __builtin_amdgcn_readlane(__builtin_bit_cast(int, h1), c)) * w2[(64 + c) * 64];
        if (kv == 0) { const int pos = 16 * n + 31, i = F.lane & 31; const float other = __shfl_xor(o, 32), cs = rc[pos * 32 + i], sn = rs[pos * 32 + i];
            o = (F.lane < 32) ? o * cs - other * sn : other * sn + o * cs; }
        *dst = (bf16)f2bf(o);
    }
    __syncthreads();
}

namespace att {
using f32x16 = __attribute__((ext_vector_type(16))) float;
using s16x4 = __attribute__((ext_vector_type(4))) short;
constexpr int SLOTB = 8192;
constexpr int NSLOT = 4, LDS_K = 0, LDS_V = NSLOT * SLOTB, LDS_WS = 2 * NSLOT * SLOTB, LDS_OST = LDS_WS + NWAVES * 256, OSTR = 64  , LDS_IMP = LDS_OST + NWAVES * 32 * OSTR * 4, LDS_SM = LDS_IMP + NWAVES * 2048, LDS_END = LDS_SM + NWAVES * 64;
static_assert(LDS_END <= RING_BYTES, "attention LDS");
__device__ __forceinline__ int crow(int r, int hi) { return (r & 3) + 8 * (r >> 2) + 4 * hi; }
__device__ __forceinline__ float max3f(float a, float b, float c) { float r; asm("v_max3_f32 %0, %1, %2, %3" : "=v"(r) : "v"(a), "v"(b), "v"(c)); return r; }
__device__ __forceinline__ unsigned cvtpk(float lo, float hi) { unsigned r; asm("v_cvt_pk_bf16_f32 %0, %1, %2" : "=v"(r) : "v"(lo), "v"(hi)); return r; }
typedef short v4i16_t __attribute__((ext_vector_type(4)));
#define ATT_WAIT_BAR(N) asm volatile("s_waitcnt vmcnt(" #N ") lgkmcnt(0)\n\ts_barrier" ::: "memory")
#define ATT_LGKM_BAR() asm volatile("s_waitcnt lgkmcnt(0)\n\ts_barrier" ::: "memory")

__device__ __forceinline__ void qkt(f32x16& p0, f32x16& p1, const LAS unsigned char* Kslot, const bf16x8* qr, int r32, int hi) {
    const LAS unsigned char* kb = Kslot + hi * 1024 + r32 * 16;
    p0 = f32x16{}; p1 = f32x16{};
#pragma unroll
    for (int d0 = 0; d0 < 4; ++d0) {
        const bf16x8 b0 = *(const LAS bf16x8*)(kb + d0 * 2048), b1 = *(const LAS bf16x8*)(kb + d0 * 2048 + 512);
        p0 = __builtin_amdgcn_mfma_f32_32x32x16_bf16(b0, qr[d0], p0, 0, 0, 0); p1 = __builtin_amdgcn_mfma_f32_32x32x16_bf16(b1, qr[d0], p1, 0, 0, 0); }
}
__device__ __forceinline__ float rowmax(const f32x16& p0, const f32x16& p1) {
    float a = max3f(p0[0], p0[1], p1[0]), b = max3f(p0[2], p0[3], p1[1]); a = max3f(a, p1[2], p1[3]);
#pragma unroll
    for (int r = 4; r < 16; r += 4) { a = max3f(a, p0[r], p0[r + 1]); b = max3f(b, p0[r + 2], p0[r + 3]); a = max3f(a, p1[r], p1[r + 1]); b = max3f(b, p1[r + 2], p1[r + 3]); }
    const float m = fmaxf(a, b);
    auto rr = __builtin_amdgcn_permlane32_swap(__float_as_uint(m), __float_as_uint(m), false, false);
    return fmaxf(__uint_as_float(rr[0]), __uint_as_float(rr[1]));
}
__device__ __forceinline__ float halfswap_add(float v) { auto rr = __builtin_amdgcn_permlane32_swap(__float_as_uint(v), __float_as_uint(v), false, false); return __uint_as_float(rr[0]) + __uint_as_float(rr[1]); }
__device__ __forceinline__ void pv(f32x16* o, int vb, bf16x8 pa0, bf16x8 pa1, bf16x8 pa2, bf16x8 pa3) {
#pragma unroll
    for (int d0 = 0; d0 < 2; ++d0) { s16x4 lo[4], hi[4];
#pragma unroll
        for (int ks = 0; ks < 4; ++ks) {
            asm volatile("ds_read_b64_tr_b16 %0,%1 offset:%c2" : "=&v"(lo[ks]) : "v"(vb), "i"(d0 * 4096 + ks * 1024) : "memory");
            asm volatile("ds_read_b64_tr_b16 %0,%1 offset:%c2" : "=&v"(hi[ks]) : "v"(vb), "i"(d0 * 4096 + ks * 1024 + 512) : "memory"); }
        asm volatile("s_waitcnt lgkmcnt(0)" ::: "memory"); __builtin_amdgcn_sched_barrier(0);
#define ATT_PK(k) (bf16x8){lo[k][0], lo[k][1], lo[k][2], lo[k][3], hi[k][0], hi[k][1], hi[k][2], hi[k][3]}
        o[d0] = __builtin_amdgcn_mfma_f32_32x32x16_bf16(pa0, ATT_PK(0), o[d0], 0, 0, 0);
        o[d0] = __builtin_amdgcn_mfma_f32_32x32x16_bf16(pa1, ATT_PK(1), o[d0], 0, 0, 0);
        o[d0] = __builtin_amdgcn_mfma_f32_32x32x16_bf16(pa2, ATT_PK(2), o[d0], 0, 0, 0);
        o[d0] = __builtin_amdgcn_mfma_f32_32x32x16_bf16(pa3, ATT_PK(3), o[d0], 0, 0, 0);
#undef ATT_PK
    }
}
__device__ __forceinline__ void mask_gt(f32x16& p0, f32x16& p1, int thr, int hi) {
    asm volatile("" : "+v"(thr), "+v"(hi));
#pragma unroll
    for (int r = 0; r < 16; ++r) { const int kv = crow(r, hi); if (kv > thr) p0[r] = -INFINITY; if (kv + 32 > thr) p1[r] = -INFINITY; } }
__device__ __forceinline__ void mask_le(f32x16& p0, f32x16& p1, int thr, int hi) {
    asm volatile("" : "+v"(thr), "+v"(hi));
#pragma unroll
    for (int r = 0; r < 16; ++r) { const int kv = crow(r, hi); if (kv <= thr) p0[r] = -INFINITY; if (kv + 32 <= thr) p1[r] = -INFINITY; } }
__device__ __forceinline__ void mask_all(f32x16& p0, f32x16& p1) {
#pragma unroll
    for (int r = 0; r < 16; ++r) { p0[r] = -INFINITY; p1[r] = -INFINITY; } }

struct Ctx { LAS unsigned char* shm; int wid, lane, r32, hi; LAS float* wsf; int vb0; unsigned koff, voff; };

__device__ __forceinline__ const char* uni_ptr(const void* p) { const unsigned long long v = (unsigned long long)p;
    return (const char*)(((unsigned long long)(unsigned)__builtin_amdgcn_readfirstlane((unsigned)(v >> 32)) << 32) | (unsigned)__builtin_amdgcn_readfirstlane((unsigned)v)); }
__device__ __forceinline__ void dma_k(const Ctx& c, const bf16* Kt, int slot) {
    __builtin_amdgcn_global_load_lds((const unsigned*)(uni_ptr(Kt) + c.koff), (LAS unsigned*)(c.shm + LDS_K + slot * SLOTB + c.wid * 1024), 16, 0, 0); }
__device__ __forceinline__ void dma_v(const Ctx& c, const bf16* Vt, int slot) {
    __builtin_amdgcn_global_load_lds((const unsigned*)(uni_ptr(Vt) + c.voff), (LAS unsigned*)(c.shm + LDS_V + slot * SLOTB + c.wid * 1024), 16, 0, 0); }

__device__ __forceinline__ void p_times_v(const Ctx& c, f32x16* o, const f32x16& p0, const f32x16& p1, int slot) {
    v4u pw0 = (v4u){cvtpk(p0[0], p0[1]), cvtpk(p0[2], p0[3]), cvtpk(p0[4], p0[5]), cvtpk(p0[6], p0[7])};
    v4u pw1 = (v4u){cvtpk(p0[8], p0[9]), cvtpk(p0[10], p0[11]), cvtpk(p0[12], p0[13]), cvtpk(p0[14], p0[15])};
    v4u pw2 = (v4u){cvtpk(p1[0], p1[1]), cvtpk(p1[2], p1[3]), cvtpk(p1[4], p1[5]), cvtpk(p1[6], p1[7])};
    v4u pw3 = (v4u){cvtpk(p1[8], p1[9]), cvtpk(p1[10], p1[11]), cvtpk(p1[12], p1[13]), cvtpk(p1[14], p1[15])};
    pv(o, c.vb0 + slot * SLOTB, __builtin_bit_cast(bf16x8, pw0), __builtin_bit_cast(bf16x8, pw1), __builtin_bit_cast(bf16x8, pw2), __builtin_bit_cast(bf16x8, pw3));
}
__device__ __forceinline__ void online_step(const Ctx& c, f32x16& p0, f32x16& p1, float& m, float& l, f32x16* o, int slot) {
    const float rm = rowmax(p0, p1);
    const float mn = fmaxf(fmaxf(m, rm), -1.0e30f);
    const float f = __builtin_amdgcn_exp2f(m - mn);
    float s = 0.f;
#pragma unroll
    for (int r = 0; r < 16; ++r) { p0[r] = __builtin_amdgcn_exp2f(p0[r] - mn); p1[r] = __builtin_amdgcn_exp2f(p1[r] - mn); s += p0[r] + p1[r]; }
    l = l * f + s; m = mn;
    if (__any(f != 1.0f)) { if (c.hi == 0) c.wsf[c.r32] = f; LDS_WAIT();
#pragma unroll
        for (int r = 0; r < 16; ++r) { const float fr = c.wsf[crow(r, c.hi)]; o[0][r] *= fr; o[1][r] *= fr; }
        LDS_WAIT(); }
    p_times_v(c, o, p0, p1, slot);
}
__device__ __forceinline__ void fold_out(const Ctx& c, LAS float* outacc, const f32x16* o, float fac) {
    if (c.hi == 0) c.wsf[32 + c.r32] = fac; LDS_WAIT();
    LAS float* pa = outacc + c.hi * (4 * OSTR + 32) + c.r32; LAS float* pb = outacc + c.hi * (4 * OSTR) + (1 - c.hi) * 32 + c.r32; const LAS float* fp = c.wsf + 32 + 4 * c.hi;
#pragma unroll
    for (int r = 0; r < 16; ++r) { const int ro = (r & 3) + 8 * (r >> 2); const float fr = fp[ro]; pa[ro * OSTR] += o[0][r] * fr; pb[ro * OSTR] += o[1][r] * fr; }
    LDS_WAIT();
}

typedef __attribute__((address_space(3))) const char* lds_cptr;
__device__ __forceinline__ void glds16(const void* gsrc, unsigned lds_dst) { unsigned keep;
    asm volatile("s_mov_b32 %0, m0\n\ts_mov_b32 m0, %2\n\ts_nop 0\n\tglobal_load_lds_dwordx4 %1, off\n\ts_mov_b32 m0, %0" : "=&s"(keep) : "v"(gsrc), "s"(lds_dst) : "memory"); }
__device__ __forceinline__ void kload8(bf16x8* kf, lds_cptr kp) {
    kf[0] = *(const LAS bf16x8*)(kp);        kf[1] = *(const LAS bf16x8*)(kp + 512);  kf[2] = *(const LAS bf16x8*)(kp + 2048); kf[3] = *(const LAS bf16x8*)(kp + 2560);
    kf[4] = *(const LAS bf16x8*)(kp + 4096); kf[5] = *(const LAS bf16x8*)(kp + 4608); kf[6] = *(const LAS bf16x8*)(kp + 6144); kf[7] = *(const LAS bf16x8*)(kp + 6656); }
__device__ __forceinline__ void kload2(bf16x8* kf, lds_cptr kp, int j) { kf[2 * j] = *(const LAS bf16x8*)(kp + j * 2048); kf[2 * j + 1] = *(const LAS bf16x8*)(kp + j * 2048 + 512); }
__device__ __forceinline__ s16x4 vtr(lds_cptr p) { return __builtin_bit_cast(s16x4, __builtin_amdgcn_ds_read_tr16_b64_v4i16((LAS v4i16_t*)p)); }
template <int THRL>
__device__ __forceinline__ void fast_seg(const Ctx& c, const bf16x8 (&qr)[4], int kind, int qb, int tok, unsigned long long mymask, const bf16* Kb, const bf16* Vb, int NTreal, float gate, LAS float* out) {
    const int NT = NTreal < 3 ? 4 : ((NTreal + 1) & ~1);
    const unsigned lds0 = (unsigned)(uintptr_t)c.shm;
    const unsigned kdst = lds0 + LDS_K + c.wid * 1024, vdst = lds0 + LDS_V + c.wid * 1024;
    const lds_cptr shm3 = (lds_cptr)c.shm; const lds_cptr kp0 = shm3 + LDS_K + c.hi * 1024 + c.r32 * 16;
    const lds_cptr vp0 = shm3 + LDS_V + ((c.lane >> 4) & 1) * 32 + (c.lane & 3) * 8 + (4 * c.hi + ((c.lane & 15) >> 2)) * 64;
    const int hi = c.hi, r32 = c.r32;
#define FS_BLK(t) ((t) < NTreal ? (kind == 0 ? (t) : qb - (t)) : (kind == 0 ? 0 : qb))
#define FS_DMA_K(t, slot) glds16(uni_ptr(Kb + (size_t)FS_BLK(t) * 4096) + c.koff, (unsigned)__builtin_amdgcn_readfirstlane(kdst + (slot)))
#define FS_DMA_V(t, slot) glds16(uni_ptr(Vb + (size_t)FS_BLK(t) * 4096) + c.koff, (unsigned)__builtin_amdgcn_readfirstlane(vdst + (slot)))
#define FS_WAIT_BAR(N) asm volatile("s_waitcnt vmcnt(" #N ") lgkmcnt(0)\n\ts_barrier" ::: "memory")
#define FS_SBAR() __builtin_amdgcn_sched_barrier(0)
#define FS_MASK(P0, P1, t) do { const int t_ = (t); \
        if (t_ >= NTreal) mask_all(P0, P1); \
        else if (kind == 0) { const bool sel_ = (mymask >> t_) & 1ull; if (__any(!sel_)) { if (!sel_) mask_all(P0, P1); } if (t_ == qb) mask_gt(P0, P1, tok, hi); } \
        else { if (t_ == 0) mask_gt(P0, P1, tok, hi); if (t_ == 8) mask_le(P0, P1, tok, hi); } } while (0)
    bf16x8 kfa, kfb, kfc, kfd, kfe, kff;
    FS_DMA_K(0, 0); FS_DMA_V(0, 0); FS_DMA_K(1, SLOTB); FS_DMA_K(2, 2 * SLOTB);
    float mhat = 0.f, l_reg = 0.f; f32x16 o[2]; o[0] = f32x16{}; o[1] = f32x16{};
    bool resc = false;
    f32x16 pA0, pA1, pB0, pB1;
    int sl_prev = 0, sl_cur = 0, sl_next = SLOTB;
#define FS_ROT() do { sl_prev = sl_cur; sl_cur = sl_next; sl_next = (sl_next == 2 * SLOTB) ? 0 : sl_next + SLOTB; } while (0)
#define FS_RESC() do { if (resc) { asm volatile("s_waitcnt lgkmcnt(0)" ::: "memory"); \
        _Pragma("unroll") for (int d_ = 0; d_ < 2; ++d_) _Pragma("unroll") for (int r = 0; r < 16; ++r) o[d_][r] *= c.wsf[crow(r, hi)]; } } while (0)
    FS_WAIT_BAR(3);
    qkt(pA0, pA1, c.shm + LDS_K, qr, r32, hi);
    FS_MASK(pA0, pA1, 0);
    { float a = __builtin_fmaxf(__builtin_fmaxf(pA0[0], pA0[1]), pA1[0]);
#pragma unroll
      for (int r = 0; r < 16; ++r) a = __builtin_fmaxf(__builtin_fmaxf(a, pA0[r]), pA1[r]);
      { auto rr = __builtin_amdgcn_permlane32_swap(__float_as_uint(a), __float_as_uint(a), false, false); a = __builtin_fmaxf(__uint_as_float(rr[0]), __uint_as_float(rr[1])); }
      mhat = a;
#pragma unroll
      for (int r = 0; r < 16; ++r) { pA0[r] = __builtin_amdgcn_exp2f(pA0[r] - mhat); pA1[r] = __builtin_amdgcn_exp2f(pA1[r] - mhat); } }
    FS_WAIT_BAR(0);
    FS_DMA_K(3, 3 * SLOTB); FS_DMA_V(1, SLOTB);
    FS_ROT();
    kfa = *(const LAS bf16x8*)(kp0 + SLOTB); kfb = *(const LAS bf16x8*)(kp0 + SLOTB + 512); kfc = *(const LAS bf16x8*)(kp0 + SLOTB + 2048); kfd = *(const LAS bf16x8*)(kp0 + SLOTB + 2560);
    s16x4 vlo[8], vhi[8]; v4u pw0, pw1, pw2, pw3;
#define FS_PKW(P, B) cvtpk(P[B], P[(B) + 1])
#define FS_PAF(k) __builtin_bit_cast(bf16x8, pw##k)
#define FS_VFR(i) (bf16x8){vlo[i][0], vlo[i][1], vlo[i][2], vlo[i][3], vhi[i][0], vhi[i][1], vhi[i][2], vhi[i][3]}
#define FS_PIN(x) asm volatile("" : "+v"(x))
#define FS_MX3(a, b, c_) __builtin_fmaxf(__builtin_fmaxf((a), (b)), (c_))
#define FS_GAPA(MF, A0, A1, A2, A3, W0, W1, PW) do { MF; sacc += A0; sacc += A1; sacc += A2; sacc += A3; FS_PIN(sacc); W0; W1; FS_PIN(PW); FS_SBAR(); } while (0)
#define FS_EX(v) __builtin_amdgcn_exp2f((v) - mhat)
#define FS_GAPB(MF, X, B) do { MF; X[B] = FS_EX(X[B]); X[(B) + 1] = FS_EX(X[(B) + 1]); X[(B) + 2] = FS_EX(X[(B) + 2]); X[(B) + 3] = FS_EX(X[(B) + 3]); FS_PIN(X); FS_SBAR(); } while (0)
#define FS_VRD(i) do { vlo[i] = vtr(vp_ + (((i) >> 2) * 4096 + ((i) & 3) * 1024)); vhi[i] = vtr(vp_ + (((i) >> 2) * 4096 + ((i) & 3) * 1024 + 512)); } while (0)
#define FS_KL(off) (*(const LAS bf16x8*)(kq_ + (off)))
#define FS_Z f32x16{}
#define FS_STEP(C0, C1, P0, P1, t, GK, GV, GL) do { FS_SBAR(); \
    const lds_cptr vp_ = vp0 + sl_prev; const lds_cptr kq_ = kp0 + ((t) & 3) * SLOTB; \
    FS_VRD(0); kfe = FS_KL(4096); FS_SBAR(); float sacc = (P0[0] + P0[1]); \
    FS_GAPA(C0 = __builtin_amdgcn_mfma_f32_32x32x16_bf16(kfa, qr[0], FS_Z, 0, 0, 0), P0[2], P0[3], P0[4], P0[5],     pw0[0] = FS_PKW(P0, 0), pw0[1] = FS_PKW(P0, 2), pw0); \
    FS_VRD(4); kff = FS_KL(4608); FS_SBAR(); FS_GAPA(C1 = __builtin_amdgcn_mfma_f32_32x32x16_bf16(kfb, qr[0], FS_Z, 0, 0, 0), P0[6], P0[7], P0[8], P0[9],     pw0[2] = FS_PKW(P0, 4), pw0[3] = FS_PKW(P0, 6), pw0); \
    FS_VRD(1); kfa = FS_KL(6144); FS_SBAR(); FS_GAPA(C0 = __builtin_amdgcn_mfma_f32_32x32x16_bf16(kfc, qr[1], C0, 0, 0, 0),   P0[10], P0[11], P0[12], P0[13], pw1[0] = FS_PKW(P0, 8), pw1[1] = FS_PKW(P0, 10), pw1); \
    FS_VRD(5); kfb = FS_KL(6656); FS_SBAR(); FS_GAPA(C1 = __builtin_amdgcn_mfma_f32_32x32x16_bf16(kfd, qr[1], C1, 0, 0, 0),   P0[14], P0[15], P1[0], P1[1],   pw1[2] = FS_PKW(P0, 12), pw1[3] = FS_PKW(P0, 14), pw1); \
    FS_VRD(2); FS_SBAR(); FS_GAPA(C0 = __builtin_amdgcn_mfma_f32_32x32x16_bf16(kfe, qr[2], C0, 0, 0, 0),   P1[2], P1[3], P1[4], P1[5],     pw2[0] = FS_PKW(P1, 0), pw2[1] = FS_PKW(P1, 2), pw2); \
    FS_VRD(6); FS_SBAR(); FS_GAPA(C1 = __builtin_amdgcn_mfma_f32_32x32x16_bf16(kff, qr[2], C1, 0, 0, 0),   P1[6], P1[7], P1[8], P1[9],     pw2[2] = FS_PKW(P1, 4), pw2[3] = FS_PKW(P1, 6), pw2); \
    FS_VRD(3); FS_SBAR(); FS_GAPA(C0 = __builtin_amdgcn_mfma_f32_32x32x16_bf16(kfa, qr[3], C0, 0, 0, 0),   P1[10], P1[11], P1[12], P1[13], pw3[0] = FS_PKW(P1, 8), pw3[1] = FS_PKW(P1, 10), pw3); \
    FS_VRD(7); FS_SBAR(); FS_GAPA(C1 = __builtin_amdgcn_mfma_f32_32x32x16_bf16(kfb, qr[3], C1, 0, 0, 0),   P1[14], P1[15], 0.f, 0.f,       pw3[2] = FS_PKW(P1, 12), pw3[3] = FS_PKW(P1, 14), pw3); \
    l_reg += sacc; \
    if (GK) { FS_DMA_K((t) + 3, (((t) + 3) & 3) * SLOTB); } if (GV) { FS_DMA_V((t) + 1, sl_next); } \
    FS_MASK(C0, C1, t); \
    { float a = FS_MX3(C0[0], C0[1], C1[0]), b = FS_MX3(C0[2], C0[3], C1[1]); a = FS_MX3(a, C1[2], C1[3]); \
      _Pragma("unroll") for (int r = 4; r < 16; r += 4) { a = FS_MX3(a, C0[r], C0[r + 1]); b = FS_MX3(b, C0[r + 2], C0[r + 3]); a = FS_MX3(a, C1[r], C1[r + 1]); b = FS_MX3(b, C1[r + 2], C1[r + 3]); } \
      float rm = __builtin_fmaxf(a, b); { auto rr = __builtin_amdgcn_permlane32_swap(__float_as_uint(rm), __float_as_uint(rm), false, false); rm = __builtin_fmaxf(__uint_as_float(rr[0]), __uint_as_float(rr[1])); } \
      rm -= mhat; resc = false; \
      if (__builtin_expect(__any(rm > (float)THRL), 0)) { const float dl = __builtin_fmaxf(rm, 0.f); mhat += dl; \
        const float f = __builtin_amdgcn_exp2f(-dl); l_reg *= f; if (hi == 0) c.wsf[r32] = f; resc = true; } } \
    FS_SBAR(); \
    FS_GAPB(o[0] = __builtin_amdgcn_mfma_f32_32x32x16_bf16(FS_PAF(0), FS_VFR(0), o[0], 0, 0, 0), C0, 0); \
    FS_GAPB(o[1] = __builtin_amdgcn_mfma_f32_32x32x16_bf16(FS_PAF(0), FS_VFR(4), o[1], 0, 0, 0), C0, 4); \
    FS_GAPB(o[0] = __builtin_amdgcn_mfma_f32_32x32x16_bf16(FS_PAF(1), FS_VFR(1), o[0], 0, 0, 0), C0, 8); \
    FS_GAPB(o[1] = __builtin_amdgcn_mfma_f32_32x32x16_bf16(FS_PAF(1), FS_VFR(5), o[1], 0, 0, 0), C0, 12); \
    FS_GAPB(o[0] = __builtin_amdgcn_mfma_f32_32x32x16_bf16(FS_PAF(2), FS_VFR(2), o[0], 0, 0, 0), C1, 0); \
    FS_GAPB(o[1] = __builtin_amdgcn_mfma_f32_32x32x16_bf16(FS_PAF(2), FS_VFR(6), o[1], 0, 0, 0), C1, 4); \
    if (GL) { const lds_cptr kn_ = kp0 + (((t) + 1) & 3) * SLOTB; kfa = *(const LAS bf16x8*)(kn_); kfb = *(const LAS bf16x8*)(kn_ + 512); kfc = *(const LAS bf16x8*)(kn_ + 2048); kfd = *(const LAS bf16x8*)(kn_ + 2560); FS_SBAR(); } \
    FS_GAPB(o[0] = __builtin_amdgcn_mfma_f32_32x32x16_bf16(FS_PAF(3), FS_VFR(3), o[0], 0, 0, 0), C1, 8); \
    FS_GAPB(o[1] = __builtin_amdgcn_mfma_f32_32x32x16_bf16(FS_PAF(3), FS_VFR(7), o[1], 0, 0, 0), C1, 12); \
    } while (0)
    int t = 1;
    for (; t + 5 < NT; t += 2) {
        FS_STEP(pB0, pB1, pA0, pA1, t, true, true, true);     FS_WAIT_BAR(2); FS_RESC(); FS_ROT();
        FS_STEP(pA0, pA1, pB0, pB1, t + 1, true, true, true); FS_WAIT_BAR(2); FS_RESC(); FS_ROT();
    }
#define FS_ENDW(tt) do { if ((tt) + 3 < NT) { FS_WAIT_BAR(2); } else if ((tt) + 2 < NT) { FS_WAIT_BAR(1); } else { FS_WAIT_BAR(0); } } while (0)
    for (; t + 1 < NT; t += 2) {
        FS_STEP(pB0, pB1, pA0, pA1, t, (t + 3 < NT), (t + 1 < NT), (t + 1 < NT));         FS_ENDW(t);     FS_RESC(); FS_ROT();
        FS_STEP(pA0, pA1, pB0, pB1, t + 1, (t + 4 < NT), (t + 2 < NT), (t + 2 < NT));     FS_ENDW(t + 1); FS_RESC(); FS_ROT();
    }
    FS_STEP(pB0, pB1, pA0, pA1, NT - 1, false, false, false); FS_RESC();
    { float sacc = pB0[0] + pB0[1];
#pragma unroll
      for (int r = 2; r < 16; ++r) sacc += pB0[r];
#pragma unroll
      for (int r = 0; r < 16; ++r) sacc += pB1[r];
      l_reg += sacc;
      pw0 = (v4u){FS_PKW(pB0, 0), FS_PKW(pB0, 2), FS_PKW(pB0, 4), FS_PKW(pB0, 6)}; pw1 = (v4u){FS_PKW(pB0, 8), FS_PKW(pB0, 10), FS_PKW(pB0, 12), FS_PKW(pB0, 14)};
      pw2 = (v4u){FS_PKW(pB1, 0), FS_PKW(pB1, 2), FS_PKW(pB1, 4), FS_PKW(pB1, 6)}; pw3 = (v4u){FS_PKW(pB1, 8), FS_PKW(pB1, 10), FS_PKW(pB1, 12), FS_PKW(pB1, 14)};
      FS_SBAR(); pv(o, c.vb0 + sl_cur, FS_PAF(0), FS_PAF(1), FS_PAF(2), FS_PAF(3)); }
    const float lt = halfswap_add(l_reg);
    fold_out(c, out, o, lt > 0.f ? gate / lt : 0.f);
    asm volatile("s_waitcnt lgkmcnt(0)\n\ts_barrier" ::: "memory");
#undef FS_BLK
#undef FS_DMA_K
#undef FS_DMA_V
#undef FS_WAIT_BAR
#undef FS_SBAR
#undef FS_MASK
#undef FS_ROT
#undef FS_RESC
#undef FS_PKW
#undef FS_PAF
#undef FS_VFR
#undef FS_PIN
#undef FS_MX3
#undef FS_GAPA
#undef FS_EX
#undef FS_GAPB
#undef FS_VRD
#undef FS_KL
#undef FS_Z
#undef FS_STEP
#undef FS_ENDW
}

__device__ __forceinline__ void attn_unit(Frame& F, int b, int g, int qb) {
    Ctx c; c.shm = F.lds + RING_OFF; c.wid = F.wave; c.lane = F.lane; c.r32 = F.lane & 31; c.hi = F.lane >> 5;
    c.wsf = (LAS float*)(c.shm + LDS_WS) + c.wid * 64;
    c.vb0 = (int)(uintptr_t)(c.shm + LDS_V) + ((c.lane >> 4) & 1) * 32 + (c.lane & 3) * 8 + (4 * c.hi + ((c.lane & 15) >> 2)) * 64;
    c.koff = (unsigned)(c.wid * 1024 + c.lane * 16); c.voff = c.koff;
    const int tt = c.r32 & 7, hh = c.r32 >> 3, tok = 8 * c.wid + tt, t0 = 64 * qb, t = t0 + tok;
    const size_t grow = (size_t)b * SEQ + t;
    const bf16* Qp = (const bf16*)(F.ws + WS_Q) + grow * D + (4 * g + hh) * 64 + c.hi * 8;
    const bf16* KV6 = (const bf16*)(F.ws + WS_KV6) + (size_t)(b * 4 + g) * SEQ * 64;
    const bf16* KC = (const bf16*)(F.ws + WS_KVC) + (size_t)(b * 4 + g) * 256 * 64;
    VM_WAIT();
    bf16x8 qr[4];
#pragma unroll
    for (int d0 = 0; d0 < 4; ++d0) qr[d0] = *(const bf16x8*)(Qp + d0 * 16);
    const float* gp = (const float*)(F.ws + WS_GATES) + grow * 48 + (4 * g + hh) * 3;
    LAS float* out = (LAS float*)(c.shm + LDS_OST) + c.wid * 32 * OSTR;
#pragma unroll
    for (int k = 0; k < 32; ++k) out[k * OSTR + c.lane] = 0.f;
    LAS float* imp = (LAS float*)(c.shm + LDS_IMP) + c.wid * 512;
    LAS unsigned long long* smk = (LAS unsigned long long*)(c.shm + LDS_SM) + c.wid * 8;
    const bool need_sel = qb > 15;
    if (need_sel) {
#pragma unroll
        for (int k = 0; k < 8; ++k) imp[k * 64 + c.lane] = 0.f; }
    const int nmax = (t - 31) >> 4;
    const int nmax_min = (t0 - 31) >> 4;
    const int nct = ((4 * qb + 2) >> 6) + 1;
    const int e0 = nct, e1 = 2 * nct;
    for (int j = 0; j < nct; ++j) { dma_k(c, KC + (size_t)j * 4096, j); dma_v(c, KC + (size_t)32 * 256 * 64 + (size_t)j * 4096, j); }
    float m = -INFINITY, l = 0.f; f32x16 o[2]; o[0] = f32x16{}; o[1] = f32x16{};
    ATT_WAIT_BAR(0);
    f32x16 p0, p1;
    qkt(p0, p1, c.shm + LDS_K, qr, c.r32, c.hi);
    for (int i = 0; i < e1; ++i) {
        const bool pass2 = i >= e0; const int j = pass2 ? i - e0 : i; const int jn = (i + 1 >= e0) ? i + 1 - e0 : i + 1;
        if (64 * j + 63 > nmax_min) mask_gt(p0, p1, nmax - 64 * j, c.hi);
        float mn = m, f = 1.0f;
        if (!pass2) { const float rm = rowmax(p0, p1); mn = fmaxf(fmaxf(m, rm), -1.0e30f); f = __builtin_amdgcn_exp2f(m - mn); m = mn; }
        f32x16 n0 = f32x16{}, n1 = f32x16{}; float s = 0.f; v4u pw0, pw1, pw2, pw3;
        const bool do_imp = pass2 && need_sel;
        LAS float* impr = imp + tt * 64 + 16 * j + c.hi;
        { const LAS unsigned char* kb = c.shm + LDS_K + (jn & 3) * SLOTB + c.hi * 1024 + c.r32 * 16;
#define ATT_GRP(d0_, P_, B_, PW_) do { const bf16x8 b0_ = *(const LAS bf16x8*)(kb + (d0_) * 2048), b1_ = *(const LAS bf16x8*)(kb + (d0_) * 2048 + 512); \
            n0 = __builtin_amdgcn_mfma_f32_32x32x16_bf16(b0_, qr[d0_], n0, 0, 0, 0); n1 = __builtin_amdgcn_mfma_f32_32x32x16_bf16(b1_, qr[d0_], n1, 0, 0, 0); \
            float e_[8]; _Pragma("unroll") for (int r_ = 0; r_ < 8; ++r_) { e_[r_] = __builtin_amdgcn_exp2f(P_[(B_) + r_] - mn); s += e_[r_]; } \
            PW_ = (v4u){cvtpk(e_[0], e_[1]), cvtpk(e_[2], e_[3]), cvtpk(e_[4], e_[5]), cvtpk(e_[6], e_[7])}; \
            if (do_imp) { float qa = (e_[0] + e_[1]) + (e_[2] + e_[3]), qb_ = (e_[4] + e_[5]) + (e_[6] + e_[7]), la = e_[3], lb = e_[7]; \
                qa += __shfl_xor(qa, 8); qa += __shfl_xor(qa, 16); qb_ += __shfl_xor(qb_, 8); qb_ += __shfl_xor(qb_, 16); la += __shfl_xor(la, 8); la += __shfl_xor(la, 16); lb += __shfl_xor(lb, 8); lb += __shfl_xor(lb, 16); \
                if (hh == 0) { const int jo = 4 * ((d0_) & 1) + 8 * ((d0_) >> 1); impr[jo] += qa; impr[jo + 2] += qb_; LDS_WAIT(); \
                    if (16 * j + c.hi + jo + 1 < 64) impr[jo + 1] += la; if (16 * j + c.hi + jo + 3 < 64) impr[jo + 3] += lb; LDS_WAIT(); } } \
            __builtin_amdgcn_sched_barrier(0); } while (0)
          ATT_GRP(0, p0, 0, pw0); ATT_GRP(1, p0, 8, pw1); ATT_GRP(2, p1, 0, pw2); ATT_GRP(3, p1, 8, pw3);
#undef ATT_GRP
        }
        l = l * f + s;
        if (!pass2) {
            if (i + 1 == e0) { const float lt = halfswap_add(l); m = lt > 0.f ? m + __builtin_amdgcn_logf(lt) : 0.f; l = 0.f; }
        } else
            pv(o, c.vb0 + j * SLOTB, __builtin_bit_cast(bf16x8, pw0), __builtin_bit_cast(bf16x8, pw1), __builtin_bit_cast(bf16x8, pw2), __builtin_bit_cast(bf16x8, pw3));
        p0 = n0; p1 = n1;
    }
    fold_out(c, out, o, gp[0]);
    unsigned long long mymask;
    if (need_sel) {
        const unsigned long long lt_mask = (1ull << c.lane) - 1ull;
        for (int k = 0; k < 8; ++k) {
            const int jl = c.lane; const bool valid = jl <= qb; const bool forced = (jl == 0) || (jl == qb) || (jl == qb - 1);
            const float sc = valid ? imp[k * 64 + jl] + (forced ? 1000.0f : 0.0f) : -1.0f;
            const unsigned u = __float_as_uint(sc); const unsigned key = (u & 0x80000000u) ? ~u : (u | 0x80000000u);
            unsigned T = 0u;
#pragma unroll 4
            for (int bit = 31; bit >= 0; --bit) { const unsigned cand = T | (1u << bit); if (__popcll(__ballot(key >= cand)) >= 16) T = cand; }
            const unsigned long long gt = __ballot(key > T), eq = __ballot(key == T); const int need = 16 - __popcll(gt);
            const bool sel = (key > T) || (key == T && __popcll(eq & lt_mask) < need);
            const unsigned long long mk = __ballot(sel && valid);
            if (c.lane == 0) smk[k] = mk;
        }
        LDS_WAIT();
        mymask = smk[tt];
    } else mymask = (2ull << qb) - 1ull;
    asm volatile("s_waitcnt lgkmcnt(0)\n\ts_barrier" ::: "memory");
    for (int kind = 0; kind < 2; ++kind) {
        const bf16* Kb = KV6 + (kind == 0 ? 2 : 4) * KV6_STRIDE; const bf16* Vb = Kb + KV6_STRIDE;
        fast_seg<8>(c, qr, kind, qb, tok, mymask, Kb, Vb, kind == 0 ? qb + 1 : (qb < 8 ? qb : 8) + 1, gp[1 + kind], out);
    }
    {
        LDS_WAIT();
        bf16* AO = (bf16*)(F.ws + WS_AO);
#pragma unroll
        for (int i = 0; i < 4; ++i) { const int row = i * 8 + (c.lane >> 3), ch = c.lane & 7; const LAS f32x4* sp = (const LAS f32x4*)(out + (c.lane >> 3) * OSTR + ((ch * 8) ^ (((c.lane >> 3) & 4) << 3)) + i * 8 * OSTR); const f32x4 a = sp[0], bq = sp[1];
            const v4u v = (v4u){cvtpk(a[0], a[1]), cvtpk(a[2], a[3]), cvtpk(bq[0], bq[1]), cvtpk(bq[2], bq[3])};
            *(v4u*)(AO + ((size_t)b * SEQ + t0 + 8 * c.wid + (row & 7)) * D + (4 * g + (row >> 3)) * 64 + ch * 8) = v; }
        LDS_WAIT();
    }
    asm volatile("s_waitcnt lgkmcnt(0)\n\ts_barrier" ::: "memory");
}
__device__ __forceinline__ void attn_phase(Frame& F) {
    const int bg = F.vcu >> 3, s = F.vcu & 7;
    const int gw = F.vcu * NWAVES + F.wave, NGW = F.G * NWAVES;
    LAS unsigned* scr = (LAS unsigned*)(F.lds + RING_OFF + F.wave * W_SCR);
    static_assert(NWAVES * W_SCR <= LDS_IMP, "MoE weight items use the K/V ring / out-tile region between attention units");
    for (int i = 0; i < 8; ++i) { const int base = (i >> 1) * 16; const int qb = (i & 1) ? base + 15 - s : base + s;
        attn_unit(F, bg >> 2, bg & 3, qb);
        { const int it = W_MOE0 + gw + NGW * i;
            if (it < W_NITEMS) { const WItem w = witem_decode(F, it); f32x4 la[32]; witem_load(w, F.lane, la); witem_store(w, F.lane, la, scr); } }
        asm volatile("s_waitcnt vmcnt(0) lgkmcnt(0)\n\ts_barrier" ::: "memory");
    }
}
#undef ATT_WAIT_BAR
#undef ATT_LGKM_BAR
}

#ifndef MK_PER_PHASE
#define MK_PER_PHASE 0
#endif
constexpr int N_PHASES = 24;
struct Args { const float* in[18]; float* out; unsigned char* ws; int ph_lo, ph_hi, li, pad; };

__global__ void __launch_bounds__(NWAVES * 64, 2) fwd_kernel(Args args) {
    extern __shared__ __attribute__((aligned(16))) unsigned char lds[];
    Frame F;
    F.lds = (LAS unsigned char*)lds;
    F.MISC = (volatile LAS unsigned*)(F.lds + MISC_OFF);
    refresh(F);
    F.G = gridDim.x; { const int bx = blockIdx.x; F.vcu = (F.G % 8 == 0) ? (bx % 8) * (F.G / 8) + bx / 8 : bx; }
    F.ws = args.ws; F.ctl = (gu32*)(args.ws + WS_CTL); F.out = args.out;
    for (int u = F.tid; u < (LDS_BYTES - LDSCTL_OFF) / 4; u += NWAVES * 64) ((LAS unsigned*)(F.lds + LDSCTL_OFF))[u] = 0u;
    __syncthreads();
    if (F.tid < 18) ((LAS unsigned long long*)(F.lds + PTR_OFF))[F.tid] = (unsigned long long)args.in[F.tid];
    __syncthreads();
    XcdBarrier bar = xcd_barrier_post((unsigned*)(F.ctl + CW_BAR) + args.li * XCD_BAR_WORDS, F.MISC + 8);
#define GRID_BAR() xcd_barrier(bar)
    const int lo = args.ph_lo, hi = args.ph_hi;
#ifndef PH_MASK
#define PH_MASK 0xFFFFFFu
#endif
#define IN(k) (((PH_MASK >> ((k) > 13 ? 13 + (((k) - 13) & 1) : (k))) & 1u) && lo <= (k) && (k) < hi)
#define BOTH(k) (IN(k) && IN((k) + 1))
#ifndef REP_MASK
#define REP_MASK 0u
#endif
#define REPS(k) (1 + (int)((REP_MASK >> ((k) > 13 ? 13 + (((k) - 13) & 1) : (k))) & 1u))
    unsigned char* ws = args.ws;
    float* R0 = (float*)(ws + WS_R0); bf16* XB = (bf16*)(ws + WS_XB);
    const int cblk = (int)blockIdx.x;

    if (IN(0)) for (int rep_ = 0; rep_ < REPS(0); ++rep_) { refresh(F); p0_prologue(F); if (BOTH(0)) GRID_BAR(); }
    if (IN(1)) for (int rep_ = 0; rep_ < REPS(1); ++rep_) { refresh(F);
        pg8::Gemm g{(const bf16*)(ws + WS_APOOL), (const bf16*)(ws + W_POOL), D, 256}; ep::PoolOrder S{F.G, cblk};
        ep::EpiPool E{F.inp(I_X), F.inp(I_POOLS), R0};
        pg8::gemm_phase<ep::EpiPool, ep::PoolOrder, true, false>(F.lds + RING_OFF, g, S, E);
        if (BOTH(1)) GRID_BAR(); }
    if (IN(2)) for (int rep_ = 0; rep_ < REPS(2); ++rep_) { refresh(F); ln_phase(F, R0, F.inp(I_LNG) + 0 * D, F.inp(I_LNB) + 0 * D, R0, XB); if (BOTH(2)) GRID_BAR(); }
    if (IN(3)) for (int rep_ = 0; rep_ < REPS(3); ++rep_) { refresh(F);
        pg8::Gemm g{XB, (const bf16*)(ws + W_FGU), D, D}; ep::DenseOrder S{T / 256, 2 * DFF / 256, F.G, cblk, (size_t)256 * D * 2, (size_t)256 * D * 2};
        ep::EpiSwiGLU E{(bf16*)(ws + WS_H1), DFF, 0};
        pg8::gemm_phase(F.lds + RING_OFF, g, S, E);
        if (BOTH(3)) GRID_BAR(); }
    if (IN(4)) for (int rep_ = 0; rep_ < REPS(4); ++rep_) { refresh(F);
        pg8::Gemm g{(const bf16*)(ws + WS_H1), (const bf16*)(ws + W_FDN), DFF, DFF}; ep::DenseOrder S{T / 256, D / 256, F.G, cblk, (size_t)256 * DFF * 2, (size_t)256 * DFF * 2};
        ep::EpiResid E{R0};
        pg8::gemm_phase(F.lds + RING_OFF, g, S, E);
        if (BOTH(4)) GRID_BAR(); }
    if (IN(5)) for (int rep_ = 0; rep_ < REPS(5); ++rep_) { refresh(F); ln_phase(F, R0, F.inp(I_LNG) + 1 * D, F.inp(I_LNB) + 1 * D, R0, XB); if (BOTH(5)) GRID_BAR(); }
    if (IN(6)) for (int rep_ = 0; rep_ < REPS(6); ++rep_) { refresh(F);
        pg8::Gemm g{XB, (const bf16*)(ws + W_IN), D, D}; ep::DenseOrder S{T / 256, INP_PAD / 256, F.G, cblk, (size_t)256 * D * 2, (size_t)256 * D * 2};
        ep::EpiInProj E{(bf16*)(ws + WS_Q), (bf16*)(ws + WS_KV6), (float*)(ws + WS_GATES), (const float*)(ws + WS_ROPE), (const float*)(ws + WS_ROPE) + SEQ * 32};
        pg8::gemm_phase(F.lds + RING_OFF, g, S, E);
        if (BOTH(6)) GRID_BAR(); }
    if (IN(7)) for (int rep_ = 0; rep_ < REPS(7); ++rep_) { refresh(F);
        pg8::Gemm g{(const bf16*)(ws + WS_KV6), (const bf16*)(ws + W_C1), 1024, 512}; ep::CmpOrder S{F.G, cblk};
        ep::EpiCPart E{(float*)(ws + WS_CPART)};
        pg8::gemm_phase(F.lds + RING_OFF, g, S, E);
        if (BOTH(7)) GRID_BAR(); }
    if (IN(8)) for (int rep_ = 0; rep_ < REPS(8); ++rep_) { refresh(F); compress_finish_phase(F); if (BOTH(8)) GRID_BAR(); }
    if (IN(9)) for (int rep_ = 0; rep_ < REPS(9); ++rep_) { refresh(F); att::attn_phase(F); if (BOTH(9)) GRID_BAR(); }
    if (IN(10)) for (int rep_ = 0; rep_ < REPS(10); ++rep_) { refresh(F);
        pg8::Gemm g{(const bf16*)(ws + WS_AO), (const bf16*)(ws + W_OUT), D, D}; ep::DenseOrder S{T / 256, D / 256, F.G, cblk, (size_t)256 * D * 2, (size_t)256 * D * 2};
        ep::EpiResid E{R0};
        pg8::gemm_phase(F.lds + RING_OFF, g, S, E);
        if (BOTH(10)) GRID_BAR(); }
    if (IN(11)) for (int rep_ = 0; rep_ < REPS(11); ++rep_) { refresh(F); ln_router_phase(F, R0, F.inp(I_LNG) + 2 * D, F.inp(I_LNB) + 2 * D, XB); if (BOTH(11)) GRID_BAR(); }
    if (IN(12)) for (int rep_ = 0; rep_ < REPS(12); ++rep_) { refresh(F); moe_dispatch_phase(F); if (BOTH(12)) GRID_BAR(); }
    for (int ch = 0; ch < MOE_NCH; ++ch) {
        const int p1 = 13 + 2 * ch, p2 = p1 + 1;
        const LAS int* mt = (const LAS int*)(F.lds + MOET_OFF);
        if (IN(p1)) for (int rep_ = 0; rep_ < REPS(p1); ++rep_) { refresh(F);
            if (lo == p1) moe_tables(F);
            const int NT = mt[24], tile0 = MOE_CH * ch, nM = (NT - tile0) < MOE_CH ? (NT - tile0) : MOE_CH;
            if (nM > 0) {
                pg8::Gemm g{(const bf16*)(ws + WS_XS), (const bf16*)(ws + W_MGU), D, D};
                ep::MoeOrder<2 * DFE / 256> S{nM, F.G, cblk, tile0, mt + 32, (size_t)256 * D * 2, (size_t)2 * DFE * D * 2, (size_t)256 * D * 2, false};
                ep::EpiSwiGLU E{(bf16*)(ws + WS_H2), DFE, tile0};
                pg8::gemm_phase(F.lds + RING_OFF, g, S, E);
                if (BOTH(p1)) GRID_BAR(); } }
        if (IN(p2)) for (int rep_ = 0; rep_ < REPS(p2); ++rep_) { refresh(F);
            if (lo == p2) moe_tables(F);
            const int NT = mt[24], tile0 = MOE_CH * ch, nM = (NT - tile0) < MOE_CH ? (NT - tile0) : MOE_CH;
            if (nM > 0 && ch < MOE_NCH - 1) {
                pg8::Gemm g{(const bf16*)(ws + WS_H2), (const bf16*)(ws + W_MDN), DFE, DFE};
                ep::MoeOrder<D / 256> S{nM, F.G, cblk, tile0, mt + 32, (size_t)256 * DFE * 2, (size_t)D * DFE * 2, (size_t)256 * DFE * 2, true};
                ep::EpiMoeDown E{(bf16*)(ws + WS_Y), (const int*)(ws + WS_SDST), (const float*)(ws + WS_SW)};
                pg8::gemm_phase(F.lds + RING_OFF, g, S, E);
                if (BOTH(p2)) GRID_BAR(); }
            else if (nM > 0) {
                pg8::Gemm g{(const bf16*)(ws + WS_H2), (const bf16*)(ws + W_MDN), DFE, 512};
                ep::RemOrder S{nM, F.G, cblk, tile0, mt + 32, (size_t)D * DFE * 2};
                ep::EpiRemPart E{(float*)(ws + WS_XB)};
                pg8::gemm_phase(F.lds + RING_OFF, g, S, E);
                GRID_BAR();
                refresh(F); moe_rem_combine(F, tile0, nM);
                if (BOTH(p2)) GRID_BAR(); } }
    }
    if (IN(23)) for (int rep_ = 0; rep_ < REPS(23); ++rep_) { refresh(F); final_phase(F, R0, F.inp(I_LNG) + 3 * D, F.inp(I_LNB) + 3 * D, F.out); }
#undef IN
#undef BOTH
#undef GRID_BAR
}

extern "C" void kernel_launch(void* const* d_in, const int* in_sizes, int n_in, void* d_out, int out_size, void* d_ws, size_t ws_size, hipStream_t stream) {
    static int grid = 0;
    if (grid == 0) {
        if (n_in != 18 || in_sizes[0] != T * D || out_size != T * D || ws_size < WS_END) { fprintf(stderr, "kernel_launch: shape/workspace mismatch (n_in %d, ws %zu)\n", n_in, ws_size); grid = -1; return; }
        int dev = 0, cus = 0, per_cu = 0;
        if (hipGetDevice(&dev) != hipSuccess || hipDeviceGetAttribute(&cus, hipDeviceAttributeMultiprocessorCount, dev) != hipSuccess) { grid = -1; return; }
        if (hipFuncSetAttribute((const void*)fwd_kernel, hipFuncAttributeMaxDynamicSharedMemorySize, LDS_BYTES) != hipSuccess) { fprintf(stderr, "kernel_launch: hipFuncSetAttribute failed\n"); grid = -1; return; }
        if (hipOccupancyMaxActiveBlocksPerMultiprocessor(&per_cu, (const void*)fwd_kernel, NWAVES * 64, LDS_BYTES) != hipSuccess || per_cu < 1) { fprintf(stderr, "kernel_launch: occupancy query says %d blocks per CU\n", per_cu); }
        (void)hipGetLastError();
        if (cus != 256) { fprintf(stderr, "kernel_launch: built for 256 CUs, device has %d\n", cus); grid = -1; return; }
        grid = 256;
    }
    if (grid < 0) return;
    if (hipMemsetAsync((char*)d_ws + WS_CTL, 0, CTL_ZERO_BYTES, stream) != hipSuccess) return;
    Args a{};
    for (int i = 0; i < 18; ++i) a.in[i] = (const float*)d_in[i];
    a.out = (float*)d_out; a.ws = (unsigned char*)d_ws;
#if MK_PER_PHASE
    for (int p = 0; p < N_PHASES; ++p) { a.ph_lo = p; a.ph_hi = p + 1; a.li = p; hipLaunchKernelGGL(fwd_kernel, dim3(grid), dim3(NWAVES * 64), LDS_BYTES, stream, a); }
#else
    a.ph_lo = 0; a.ph_hi = N_PHASES; a.li = 0;
    hipLaunchKernelGGL(fwd_kernel, dim3(grid), dim3(NWAVES * 64), LDS_BYTES, stream, a);
#endif
}
```
